# Optimizing an MI355X kernel written in HIP

```python
import math
import jax
import jax.numpy as jnp
from jax import lax
import numpy as np


D_MODEL = 1024
BATCH = 1
SEQ = 16384
DEPTH = 2

GRID_W = 64
CTX_LEN = 256
ROPE_BASE = 10000.0
CONV_K = 5
CHUNK = 64
Q_BLOCK = 128
EPS = 1e-6
N_BRANCH = 4
BRANCH_W = D_MODEL // 2

DIFF_H = 4
DIFF_HD = 64
DIFF_QK = DIFF_H * 2 * DIFF_HD
DIFF_V = DIFF_H * 2 * DIFF_HD
ML_H = 4
ML_DK = 64
ML_DV = 128
ML_QK = 2 * ML_H * ML_DK
ML_V = ML_H * ML_DV
ML_GATES = 4 * ML_H
MLA_H = 4
MLA_Q_RANK = 384
MLA_KV_RANK = 256
MLA_NOPE = 64
MLA_ROPE = 32
MLA_V = 128
SSD_H = 8
SSD_P = 64
SSD_G = 2
SSD_N = 64
D_INNER = SSD_H * SSD_P
SSD_XBC = D_INNER + 2 * SSD_G * SSD_N
SSD_DT = 2 * SSD_H
D_FF = 4 * D_MODEL
DN_ALPHA = (2 * DEPTH) ** 0.25
DN_BETA = (8 * DEPTH) ** -0.25

IN_SPLITS = (DIFF_QK, DIFF_QK, DIFF_V,
             ML_QK, ML_V, ML_V, ML_GATES,
             MLA_Q_RANK, MLA_KV_RANK, MLA_ROPE,
             D_INNER, SSD_XBC, SSD_DT)
IN_COLS = sum(IN_SPLITS)

kernel_name = 'hybrid_gated_diffusion_block'


def layer_norm(x, g=None, b=None):
    xf = x.astype(jnp.float32)
    mu = jnp.mean(xf, -1, keepdims=True)
    var = jnp.mean(jnp.square(xf - mu), -1, keepdims=True)
    y = (xf - mu) * lax.rsqrt(var + EPS)
    if g is not None:
        y = y * g + b
    return y.astype(x.dtype)


def rms_norm(x, w):
    xf = x.astype(jnp.float32)
    y = xf * lax.rsqrt(jnp.mean(jnp.square(xf), -1, keepdims=True) + EPS) * w
    return y.astype(x.dtype)


def modulate(x, shift, scale):
    return layer_norm(x) * (1.0 + scale) + shift


def rope_axis(x, pos):
    d = x.shape[-1]
    half = d // 2
    inv = ROPE_BASE ** (-jnp.arange(half, dtype=jnp.float32) * 2.0 / d)
    ang = pos.astype(jnp.float32)[:, None] * inv[None, :]
    bshape = (pos.shape[0],) + (1,) * (x.ndim - 3) + (half,)
    cos = jnp.cos(ang).reshape(bshape)
    sin = jnp.sin(ang).reshape(bshape)
    xf = x.astype(jnp.float32)
    x1, x2 = xf[..., :half], xf[..., half:]
    return jnp.concatenate([x1 * cos - x2 * sin, x2 * cos + x1 * sin], -1).astype(x.dtype)


def rope_2d(x, row, col):
    half = x.shape[-1] // 2
    return jnp.concatenate([rope_axis(x[..., :half], row), rope_axis(x[..., half:], col)], -1)


def dwconv(x, w, b):
    ch = x.shape[-1]
    y = lax.conv_general_dilated(x, w[:, None, :].astype(x.dtype), window_strides=(1,),
                                 padding=[(CONV_K // 2, CONV_K // 2)],
                                 dimension_numbers=('NWC', 'WIO', 'NWC'), feature_group_count=ch)
    return y + b


def to_chunks(a):
    bsz, t = a.shape[:2]
    return jnp.moveaxis(a.reshape((bsz, t // CHUNK, CHUNK) + a.shape[2:]), 1, 0)


def from_chunks(a):
    a = jnp.moveaxis(a, 0, 1)
    return a.reshape((a.shape[0], a.shape[1] * a.shape[2]) + a.shape[3:])


def over_query_blocks(fn, *qs):
    bsz, t = qs[0].shape[:2]
    nb = t // Q_BLOCK
    blocks = tuple(jnp.moveaxis(q.reshape((bsz, nb, Q_BLOCK) + q.shape[2:]), 1, 0) for q in qs)
    out = lax.map(lambda a: fn(*a), blocks)
    out = jnp.moveaxis(out, 0, 1)
    return out.reshape((bsz, t) + out.shape[3:])


def softmax_attend(q, k, v, scale):
    s = jnp.einsum('bqhd,bkhd->bhqk', q, k).astype(jnp.float32) * scale
    p = jax.nn.softmax(s, axis=-1).astype(v.dtype)
    o = jnp.einsum('bhqk,bkhe->bqhe', p, v)
    return o.reshape(o.shape[:2] + (-1,))


def flip_t(a):
    return jnp.flip(a, axis=1)


def bidirectional_scan(scan_fn, ctx_dirs, lat_dirs, state0):
    y_ctx, y_lat = 0.0, 0.0
    for d in range(2):
        ca, la = ctx_dirs[d], lat_dirs[d]
        if d == 1:
            ca = tuple(flip_t(a) for a in ca)
            la = tuple(flip_t(a) for a in la)
        yc, st = scan_fn(*ca, state0)
        yl, _ = scan_fn(*la, st)
        if d == 1:
            yc, yl = flip_t(yc), flip_t(yl)
        y_ctx = y_ctx + yc
        y_lat = y_lat + yl
    return y_ctx, y_lat


def mlstm_chunk_scan(q, k, v, ig, lf, state):
    dtype = v.dtype
    causal = jnp.tril(jnp.ones((CHUNK, CHUNK), bool))[None, :, :, None]

    def body(carry, chunk):
        cmat, nvec, m = carry
        qc, kc, vc, ic, fc = chunk
        g = jnp.cumsum(fc, axis=1)
        logw = jnp.where(causal, g[:, :, None] - g[:, None] + ic[:, None], -jnp.inf)
        log_inter = g + m[:, None]
        m_j = jnp.maximum(log_inter, jnp.max(logw, axis=2))
        w = jnp.exp(logw - m_j[:, :, None]) * jnp.einsum('bjhd,bshd->bjsh', qc, kc)
        a_inter = jnp.exp(log_inter - m_j)
        num = jnp.einsum('bjsh,bshe->bjhe', w, vc) + a_inter[..., None] * jnp.einsum('bjhd,bhde->bjhe', qc, cmat)
        den = jnp.sum(w, axis=2) + a_inter * jnp.einsum('bjhd,bhd->bjh', qc, nvec)
        h = num / jnp.maximum(jnp.abs(den), jnp.exp(-m_j))[..., None]
        g_end = g[:, -1]
        log_s = g_end[:, None] - g + ic
        m_new = jnp.maximum(g_end + m, jnp.max(log_s, axis=1))
        ws = jnp.exp(log_s - m_new[:, None])
        decay = jnp.exp(g_end + m - m_new)
        cmat = decay[..., None, None] * cmat + jnp.einsum('bsh,bshd,bshe->bhde', ws, kc, vc)
        nvec = decay[..., None] * nvec + jnp.einsum('bsh,bshd->bhd', ws, kc)
        return (cmat, nvec, m_new), h

    chunks = tuple(to_chunks(a.astype(jnp.float32)) for a in (q, k, v, ig, lf))
    state, h = lax.scan(body, state, chunks)
    return from_chunks(h).astype(dtype), state


def ssd_chunk_scan(x, dt, a, bm, cm, h0):
    dtype = x.dtype
    causal = jnp.tril(jnp.ones((CHUNK, CHUNK), bool))[None, :, :, None]

    def body(h, chunk):
        xc, dtc, ac, bc, cc = chunk
        s = jnp.cumsum(ac, axis=1)
        decay = jnp.exp(jnp.where(causal, s[:, :, None] - s[:, None], -jnp.inf))
        scores = decay * jnp.einsum('bjhn,bihn->bjih', cc, bc)
        xdt = xc * dtc[..., None]
        y = jnp.einsum('bjih,bihp->bjhp', scores, xdt) + jnp.exp(s)[..., None] * jnp.einsum('bjhn,bhpn->bjhp', cc, h)
        s_end = s[:, -1]
        h = jnp.exp(s_end)[..., None, None] * h + jnp.einsum('bih,bihp,bihn->bhpn', jnp.exp(s_end[:, None] - s), xdt, bc)
        return h, y

    chunks = tuple(to_chunks(t.astype(jnp.float32)) for t in (x, dt, a, bm, cm))
    h, y = lax.scan(body, h0, chunks)
    return from_chunks(y).astype(dtype), h


def diff_attention(lat, ctx, lam, subln_w, lam_init, row, col, ctx_out):
    def heads(q, k, v, pos):
        bsz, t = q.shape[:2]
        q = q.reshape(bsz, t, DIFF_H, 2, DIFF_HD)
        k = k.reshape(bsz, t, DIFF_H, 2, DIFF_HD)
        if pos is not None:
            q = rope_2d(q, *pos)
            k = rope_2d(k, *pos)
        return q, k, v.reshape(bsz, t, DIFF_H, 2 * DIFF_HD)

    lam = lam.astype(jnp.float32)
    lam_full = jnp.exp(jnp.sum(lam[0] * lam[1])) - jnp.exp(jnp.sum(lam[2] * lam[3])) + lam_init
    scale = DIFF_HD ** -0.5

    def attend(q, k, v):
        s = jnp.einsum('bqhcd,bkhcd->bhcqk', q, k).astype(jnp.float32) * scale
        p = jax.nn.softmax(s, axis=-1)
        amap = (p[:, :, 0] - lam_full * p[:, :, 1]).astype(v.dtype)
        o = jnp.einsum('bhqk,bkhe->bqhe', amap, v)
        o = rms_norm(o, subln_w) * (1.0 - lam_init)
        return o.reshape(o.shape[:2] + (-1,))

    q_l, k_l, v_l = heads(*lat, (row, col))
    q_c, k_c, v_c = heads(*ctx, None)
    k_all = jnp.concatenate([k_l, k_c], 1)
    v_all = jnp.concatenate([v_l, v_c], 1)
    y_lat = over_query_blocks(lambda qb: attend(qb, k_all, v_all), q_l)
    y_ctx = attend(q_c, k_c, v_c) if ctx_out else None
    return y_lat, y_ctx


def mla_mixer(lat, ctx, q_norm, kv_norm, w_uq, w_ukv, row, col, ctx_out):
    def qkv(cq, ckv, kr, pos):
        bsz, t = cq.shape[:2]
        q = (rms_norm(cq, q_norm) @ w_uq).reshape(bsz, t, MLA_H, MLA_NOPE + MLA_ROPE)
        kv = (rms_norm(ckv, kv_norm) @ w_ukv).reshape(bsz, t, MLA_H, MLA_NOPE + MLA_V)
        q_nope, q_rope = q[..., :MLA_NOPE], q[..., MLA_NOPE:]
        k_nope, v = kv[..., :MLA_NOPE], kv[..., MLA_NOPE:]
        kr = kr[:, :, None, :]
        if pos is not None:
            q_rope = rope_2d(q_rope, *pos)
            kr = rope_2d(kr, *pos)
        q = jnp.concatenate([q_nope, q_rope], -1)
        k = jnp.concatenate([k_nope, jnp.broadcast_to(kr, (bsz, t, MLA_H, MLA_ROPE))], -1)
        return q, k, v

    q_l, k_l, v_l = qkv(*lat, (row, col))
    q_c, k_c, v_c = qkv(*ctx, None)
    scale = (MLA_NOPE + MLA_ROPE) ** -0.5
    k_all = jnp.concatenate([k_l, k_c], 1)
    v_all = jnp.concatenate([v_l, v_c], 1)
    y_lat = over_query_blocks(lambda qb: softmax_attend(qb, k_all, v_all, scale), q_l)
    y_ctx = softmax_attend(q_c, k_c, v_c, scale) if ctx_out else None
    return y_lat, y_ctx


def mlstm_mixer(lat, ctx, conv_w, conv_b, gate_b, norm_w, ctx_out):
    def directions(qk, v, gates):
        bsz, t = qk.shape[:2]
        qk = jax.nn.silu(dwconv(qk, conv_w, conv_b))
        q = qk[..., :ML_H * ML_DK].reshape(bsz, t, ML_H, ML_DK)
        k = qk[..., ML_H * ML_DK:].reshape(bsz, t, ML_H, ML_DK) * (ML_DK ** -0.5)
        v = v.reshape(bsz, t, ML_H, ML_DV)
        gt = gates.reshape(bsz, t, 4, ML_H).astype(jnp.float32) + gate_b
        return [(q, k, v, gt[:, :, 2 * d], jax.nn.log_sigmoid(gt[:, :, 2 * d + 1])) for d in range(2)]

    def finish(h, o):
        bsz, t = h.shape[:2]
        h = rms_norm(h, norm_w.reshape(ML_H, ML_DV)).reshape(bsz, t, ML_V)
        return h * jax.nn.sigmoid(o)

    bsz = lat[0].shape[0]
    state0 = (jnp.zeros((bsz, ML_H, ML_DK, ML_DV), jnp.float32),
              jnp.zeros((bsz, ML_H, ML_DK), jnp.float32),
              jnp.zeros((bsz, ML_H), jnp.float32))
    h_ctx, h_lat = bidirectional_scan(mlstm_chunk_scan, directions(ctx[0], ctx[1], ctx[3]),
                                      directions(lat[0], lat[1], lat[3]), state0)
    y_lat = finish(h_lat, lat[2])
    y_ctx = finish(h_ctx, ctx[2]) if ctx_out else None
    return y_lat, y_ctx


def ssd_mixer(lat, ctx, conv_w, conv_b, dt_bias, a_log, d_skip, norm_w, ctx_out):
    a_mat = -jnp.exp(a_log.astype(jnp.float32))
    rep = SSD_H // SSD_G

    def prep(xbc, dt):
        bsz, t = xbc.shape[:2]
        xbc = jax.nn.silu(dwconv(xbc, conv_w, conv_b))
        xs = xbc[..., :D_INNER].reshape(bsz, t, SSD_H, SSD_P)
        bm = jnp.repeat(xbc[..., D_INNER:D_INNER + SSD_G * SSD_N].reshape(bsz, t, SSD_G, SSD_N), rep, axis=2)
        cm = jnp.repeat(xbc[..., D_INNER + SSD_G * SSD_N:].reshape(bsz, t, SSD_G, SSD_N), rep, axis=2)
        dt = jax.nn.softplus(dt.reshape(bsz, t, 2, SSD_H).astype(jnp.float32) + dt_bias)
        dirs = [(xs, dt[:, :, d], dt[:, :, d] * a_mat[d], bm, cm) for d in range(2)]
        return xs, dirs

    def finish(y, xs, z):
        bsz, t = y.shape[:2]
        y = (y + d_skip[:, None] * xs).reshape(bsz, t, D_INNER) * jax.nn.silu(z)
        y = rms_norm(y.reshape(bsz, t, SSD_G, D_INNER // SSD_G), norm_w.reshape(SSD_G, D_INNER // SSD_G))
        return y.reshape(bsz, t, D_INNER)

    xs_l, dirs_l = prep(lat[1], lat[2])
    xs_c, dirs_c = prep(ctx[1], ctx[2])
    h0 = jnp.zeros((lat[0].shape[0], SSD_H, SSD_P, SSD_N), jnp.float32)
    y_ctx, y_lat = bidirectional_scan(ssd_chunk_scan, dirs_c, dirs_l, h0)
    out_lat = finish(y_lat, xs_l, lat[0])
    out_ctx = finish(y_ctx, xs_c, ctx[0]) if ctx_out else None
    return out_lat, out_ctx


def gated_merge(h, branches, w_gate, b_gate, w_branch, w_o):
    y = 0.0
    for k, br in enumerate(branches):
        y = y + jax.nn.sigmoid(h @ w_gate[k] + b_gate[k]) * (br @ w_branch[k])
    return y @ w_o


def sq_relu_mlp(h, w_up, b_up, w_down, b_down):
    u = jax.nn.relu(h @ w_up + b_up)
    return (u * u) @ w_down + b_down


def setup_inputs(seed: int = 0) -> dict:
    key = jax.random.key(seed)
    ks = iter(jax.random.split(key, 48))
    f32 = jnp.float32
    L, D = DEPTH, D_MODEL

    def nrm(shape, std):
        return std * jax.random.normal(next(ks), shape, f32)

    def gain(shape):
        return 1.0 + nrm(shape, 0.02)

    fb = jnp.linspace(3.0, 6.0, ML_H, dtype=f32)
    zb = jnp.zeros((ML_H,), f32)
    dt0 = jnp.exp(jax.random.uniform(next(ks), (L, 2, SSD_H), f32, math.log(1e-3), math.log(1e-1)))
    return {
        'x': nrm((BATCH, SEQ, D), 1.0),
        'c': nrm((BATCH, D), 1.0),
        'ctx': nrm((BATCH, CTX_LEN, D), 1.0),
        'c_ctx': nrm((D,), 1.0),
        'w_mod': nrm((L, D, 6 * D), 0.5 * D ** -0.5),
        'b_mod': nrm((L, 6 * D), 0.01),
        'w_in': nrm((L, D, IN_COLS), D ** -0.5),
        'diff_lambda': nrm((L, 4, DIFF_HD), 0.1),
        'diff_subln': gain((L, 2 * DIFF_HD)),
        'ml_conv_w': nrm((L, CONV_K, ML_QK), CONV_K ** -0.5),
        'ml_conv_b': nrm((L, ML_QK), 0.02),
        'ml_gate_b': jnp.stack([zb, fb, zb, fb])[None] + nrm((L, 4, ML_H), 0.1),
        'ml_norm': gain((L, ML_V)),
        'mla_q_norm': gain((L, MLA_Q_RANK)),
        'mla_kv_norm': gain((L, MLA_KV_RANK)),
        'mla_w_uq': nrm((L, MLA_Q_RANK, MLA_H * (MLA_NOPE + MLA_ROPE)), MLA_Q_RANK ** -0.5),
        'mla_w_ukv': nrm((L, MLA_KV_RANK, MLA_H * (MLA_NOPE + MLA_V)), MLA_KV_RANK ** -0.5),
        'ssd_conv_w': nrm((L, CONV_K, SSD_XBC), CONV_K ** -0.5),
        'ssd_conv_b': nrm((L, SSD_XBC), 0.02),
        'ssd_dt_bias': dt0 + jnp.log(-jnp.expm1(-dt0)),
        'ssd_a_log': jnp.log(jax.random.uniform(next(ks), (L, 2, SSD_H), f32, 1.0, 16.0)),
        'ssd_d': gain((L, SSD_H)),
        'ssd_norm': gain((L, D_INNER)),
        'w_gate': nrm((L, N_BRANCH, D, D), D ** -0.5),
        'b_gate': nrm((L, N_BRANCH, D), 0.01),
        'w_branch': nrm((L, N_BRANCH, BRANCH_W, D), BRANCH_W ** -0.5),
        'w_o': nrm((L, D, D), DN_BETA * D ** -0.5),
        'ln1_g': gain((L, D)),
        'ln1_b': nrm((L, D), 0.01),
        'w_up': nrm((L, D, D_FF), D ** -0.5),
        'b_up': nrm((L, D_FF), 0.01),
        'w_down': nrm((L, D_FF, D), DN_BETA * D_FF ** -0.5),
        'b_down': nrm((L, D), 0.01),
        'ln2_g': gain((L, D)),
        'ln2_b': nrm((L, D), 0.01),
    }


def reference(x, c, ctx, c_ctx, w_mod, b_mod, w_in, diff_lambda, diff_subln, ml_conv_w, ml_conv_b,
              ml_gate_b, ml_norm, mla_q_norm, mla_kv_norm, mla_w_uq, mla_w_ukv, ssd_conv_w, ssd_conv_b,
              ssd_dt_bias, ssd_a_log, ssd_d, ssd_norm, w_gate, b_gate, w_branch, w_o, ln1_g, ln1_b,
              w_up, b_up, w_down, b_down, ln2_g, ln2_b):
    t = x.shape[1]
    rows = t // GRID_W
    row = jnp.repeat(jnp.arange(rows, dtype=jnp.int32), GRID_W)
    col = jnp.arange(t, dtype=jnp.int32) % GRID_W
    split_at = [int(s) for s in np.cumsum(IN_SPLITS)[:-1]]
    xc = ctx
    for l in range(DEPTH):
        ctx_out = l < DEPTH - 1
        lam_init = 0.8 - 0.6 * math.exp(-0.3 * l)
        mod_l = jax.nn.silu(c) @ w_mod[l] + b_mod[l]
        mod_c = jax.nn.silu(c_ctx) @ w_mod[l] + b_mod[l]
        sh_a, sc_a, g_a, sh_m, sc_m, g_m = jnp.split(mod_l[:, None, :], 6, axis=-1)
        csh_a, csc_a, cg_a, csh_m, csc_m, cg_m = jnp.split(mod_c, 6, axis=-1)

        h_l = modulate(x, sh_a, sc_a)
        h_c = modulate(xc, csh_a, csc_a)
        p_l = jnp.split(h_l @ w_in[l], split_at, axis=-1)
        p_c = jnp.split(h_c @ w_in[l], split_at, axis=-1)
        a_l, a_c = diff_attention(tuple(p_l[0:3]), tuple(p_c[0:3]), diff_lambda[l], diff_subln[l],
                                  lam_init, row, col, ctx_out)
        b_l, b_c = mlstm_mixer(tuple(p_l[3:7]), tuple(p_c[3:7]), ml_conv_w[l], ml_conv_b[l],
                               ml_gate_b[l], ml_norm[l], ctx_out)
        m_l, m_c = mla_mixer(tuple(p_l[7:10]), tuple(p_c[7:10]), mla_q_norm[l], mla_kv_norm[l],
                             mla_w_uq[l], mla_w_ukv[l], row, col, ctx_out)
        s_l, s_c = ssd_mixer(tuple(p_l[10:13]), tuple(p_c[10:13]), ssd_conv_w[l], ssd_conv_b[l],
                             ssd_dt_bias[l], ssd_a_log[l], ssd_d[l], ssd_norm[l], ctx_out)
        y_l = gated_merge(h_l, (a_l, b_l, m_l, s_l), w_gate[l], b_gate[l], w_branch[l], w_o[l])
        x = layer_norm(DN_ALPHA * x + g_a * y_l, ln1_g[l], ln1_b[l])
        f_l = sq_relu_mlp(modulate(x, sh_m, sc_m), w_up[l], b_up[l], w_down[l], b_down[l])
        x = layer_norm(DN_ALPHA * x + g_m * f_l, ln2_g[l], ln2_b[l])

        if ctx_out:
            y_c = gated_merge(h_c, (a_c, b_c, m_c, s_c), w_gate[l], b_gate[l], w_branch[l], w_o[l])
            xc = layer_norm(DN_ALPHA * xc + cg_a * y_c, ln1_g[l], ln1_b[l])
            f_c = sq_relu_mlp(modulate(xc, csh_m, csc_m), w_up[l], b_up[l], w_down[l], b_down[l])
            xc = layer_norm(DN_ALPHA * xc + cg_m * f_c, ln2_g[l], ln2_b[l])
    return x
```

```cpp
#include <hip/hip_runtime.h>
#include <hip/hip_cooperative_groups.h>
#include <cstdio>
#include <cstdint>
namespace cg = cooperative_groups;
#define DI __device__ __forceinline__
#define LAS __attribute__((address_space(3)))
typedef unsigned short bf16_t;
typedef short bf16x8 __attribute__((ext_vector_type(8)));
typedef short s16x4 __attribute__((ext_vector_type(4)));
typedef float f32x4 __attribute__((ext_vector_type(4)));
typedef float f32x16 __attribute__((ext_vector_type(16)));
typedef unsigned u32x4 __attribute__((ext_vector_type(4)));
typedef unsigned u32x2 __attribute__((ext_vector_type(2)));

constexpr int TL = 16384, TC = 256, T = TL + TC, D = 1024, FF = 4096;
constexpr int NCH = T / 64;
constexpr float ALPHA = 1.4142135623730951f;
constexpr float EPS = 1e-6f;
constexpr int NB_B = 1792, NB_D = 1536, NB_AC = 2304;
constexpr int LDS_PHASE = 156672;
constexpr int LDS_BYTES = LDS_PHASE + 16;
constexpr int MLROW = 8192 + 64;

constexpr size_t al256(size_t x) { return (x + 255) / 256 * 256; }
constexpr size_t WS_TAB32 = 0;
constexpr size_t WS_TAB16 = WS_TAB32 + 256 * 16 * 2 * 4;
constexpr size_t WS_LAM = WS_TAB16 + 256 * 8 * 2 * 4;
constexpr size_t WS_MOD = WS_LAM + 256;
constexpr size_t WS_BAR = al256(WS_MOD + 2 * 2 * 6144 * 4);
constexpr size_t WS_XC = al256(WS_BAR + 16384);
constexpr size_t WS_ACC = al256(WS_XC + (size_t)TC * D * 4);
constexpr size_t WS_WA = al256(WS_ACC + (size_t)2 * TC * D * 4);
constexpr size_t WS_WB = al256(WS_WA + (size_t)5632 * 1024 * 2);
constexpr size_t WS_H = al256(WS_WB + (size_t)4096 * 1024 * 2);
constexpr size_t WS_BR = al256(WS_H + (size_t)T * D * 2);
constexpr size_t WS_BIG = al256(WS_BR + (size_t)4 * T * 512 * 2);
constexpr size_t BIG_BYTES = (size_t)T * 4096 * 2;
constexpr size_t WS_END = WS_BIG + BIG_BYTES;
constexpr size_t BG_PB = 0;
constexpr size_t BG_UC = al256(BG_PB + (size_t)T * NB_B * 2);
constexpr size_t BG_SC = al256(BG_UC + (size_t)8 * NCH * MLROW * 2);
constexpr size_t BG_MSC = al256(BG_SC + (size_t)8 * NCH * MLROW * 2);
constexpr size_t BG_ML_END = BG_MSC + 3 * 8 * NCH * 4;
static_assert(BG_ML_END <= BIG_BYTES, "mlstm overlay");
constexpr size_t BG_PD = 0;
constexpr size_t BG_UH = al256(BG_PD + (size_t)T * NB_D * 2);
constexpr size_t BG_SH = al256(BG_UH + (size_t)16 * NCH * 4096 * 2);
constexpr size_t BG_DE = al256(BG_SH + (size_t)16 * NCH * 4096 * 2);
constexpr size_t BG_SSD_END = BG_DE + 16 * NCH * 4;
static_assert(BG_SSD_END <= BIG_BYTES, "ssd overlay");
constexpr size_t BG_PAC = 0;
constexpr size_t BG_QUP = al256(BG_PAC + (size_t)T * NB_AC * 2);
constexpr size_t BG_KVUP = al256(BG_QUP + (size_t)T * 384 * 2);
static_assert(BG_KVUP + (size_t)T * 768 * 2 <= BIG_BYTES, "attn overlay");
constexpr size_t WB_UQ = 0, WB_UKV = 512 * 384 * 2, WB_BR = WB_UKV + 768 * 256 * 2, WB_WO = WB_BR + (size_t)4 * 1024 * 512 * 2;
static_assert(WB_WO + 1024 * 1024 * 2 <= (size_t)4096 * 1024 * 2, "slot B");
constexpr size_t WA_B = 0, WA_D = (size_t)NB_B * 1024 * 2, WA_AC = WA_D + (size_t)NB_D * 1024 * 2;

struct Params { const float* in[35]; float* out; unsigned char* ws; };

typedef __bf16 bf16x2_t __attribute__((ext_vector_type(2)));
typedef float f32x2_t __attribute__((ext_vector_type(2)));
DI unsigned cvtpk(float lo, float hi) { f32x2_t v = {lo, hi}; bf16x2_t b = __builtin_convertvector(v, bf16x2_t); return __builtin_bit_cast(unsigned, b); }
DI bf16_t f2bf(float x) { return (bf16_t)(cvtpk(x, 0.f) & 0xffffu); }
DI float bf2f(bf16_t v) { return __uint_as_float((unsigned)v << 16); }
DI float bflo(unsigned w) { return __uint_as_float(w << 16); }
DI float bfhi(unsigned w) { return __uint_as_float(w & 0xffff0000u); }
DI float wave_sum(float v) {
#pragma unroll
  for (int o = 1; o < 64; o <<= 1) v += __shfl_xor(v, o);
  return v;
}
DI float wave_max(float v) {
#pragma unroll
  for (int o = 1; o < 64; o <<= 1) v = fmaxf(v, __shfl_xor(v, o));
  return v;
}
DI float sigmoidf(float x) { return __builtin_amdgcn_rcpf(1.f + __expf(-x)); }
DI float siluf(float x) { return x / (1.f + __expf(-x)); }
DI int tidx() { int t = (int)__builtin_amdgcn_workitem_id_x(); asm volatile("" : "+v"(t)); return t; }
#define LDS_WAIT() asm volatile("s_waitcnt lgkmcnt(0)" ::: "memory")

namespace pg8 {
constexpr int BM = 256, BK = 64, HALF = 128, HTB = HALF * BK * 2, STAGE_BYTES = 8 * HTB, NXCD = 8, WGM = 8;
DI int lds_byte(int r, int c) { const int st = (r >> 4) * 2 + (c >> 5), rr = r & 15, cc = c & 31, ob = rr * 64 + cc * 2; return st * 1024 + (ob ^ (((ob >> 9) & 1) << 5)); }
DI void stage_rc(int b, int& R, int& C) { const int st = b / 1024, sb = b % 1024, swz = sb ^ (((sb >> 9) & 1) << 5); R = (st >> 1) * 16 + swz / 64; C = (st & 1) * 32 + (swz % 64) / 2; }
DI int perm32(int rho) { const int n = rho >> 4, i = rho & 15; return 8 * (i >> 2) + 4 * n + (i & 3); }
struct Unit { int pm, pn, k; };
DI void tile_order(int L, int nM, int nN, int& pm, int& pn) {
  const int nwg = nM * nN; int wgid = L;
  { const int q = nwg / NXCD, r = nwg % NXCD, xcd = wgid % NXCD, off = wgid / NXCD; wgid = (xcd < r ? xcd * (q + 1) : r * (q + 1) + (xcd - r) * q) + off; }
  const int nig = WGM * nN, gid = wgid / nig, fm = gid * WGM, gsz = (nM - fm) < WGM ? (nM - fm) : WGM;
  pm = fm + ((wgid % nig) % gsz); pn = (wgid % nig) / gsz;
}
struct Sched {
  const char* A; size_t lda_b; const char* Bt; int K; int nM, nN, G, c;
  DI bool next(int i, Unit& u) const { const long L = (long)i * G + c; if (L >= (long)nM * nN) return false; tile_order((int)L, nM, nN, u.pm, u.pn); u.k = 0; return true; }
  DI const char* a_ptr(const Unit& u) const { return A + (size_t)u.pm * BM * lda_b; }
  DI const char* b_ptr(const Unit& u) const { return Bt + (size_t)u.pn * BM * K * 2; }
  DI int ldb_e() const { return K; }
};
struct HSched {
  const char* A; size_t lda_b; size_t a_ks; const char* Bt; size_t b_ks; int K; int nM, nN, G, c;
  DI bool next(int i, Unit& u) const { const long L = (long)(i >> 2) * G + c; if (L >= (long)nM * nN) return false; tile_order((int)L, nM, nN, u.pm, u.pn); u.k = i & 3; return true; }
  DI const char* a_ptr(const Unit& u) const { return A + (size_t)u.k * a_ks + (size_t)u.pm * BM * lda_b; }
  DI const char* b_ptr(const Unit& u) const { return Bt + (size_t)u.k * b_ks + (size_t)u.pn * BM * K * 2; }
  DI int ldb_e() const { return K; }
};
struct KSched {
  const char* A; size_t lda_b; const char* Bt; int ldb; int K; int nks, nN, G, c;
  DI bool next(int i, Unit& u) const { const long L = (long)i * G + c; if (L >= (long)nN * nks) return false; u.pm = 0; u.pn = (int)(L % nN); u.k = (int)(L / nN); return true; }
  DI const char* a_ptr(const Unit& u) const { return A + (size_t)u.k * K * 2; }
  DI const char* b_ptr(const Unit& u) const { return Bt + ((size_t)u.pn * BM * ldb + (size_t)u.k * K) * 2; }
  DI int ldb_e() const { return ldb; }
};

template <class Epi, class SchedT>
DI void gemm_phase(LAS unsigned char* lds, const SchedT& S, const Epi& E) {
  const int tid = tidx(), wid = __builtin_amdgcn_readfirstlane(tid >> 6), lane = tid & 63, wr = wid >> 2, wc = wid & 3, fr = lane & 15, fq = lane >> 4;
  const int K = S.K, nt = K / BK, ldb = S.ldb_e();
  unsigned voffA[2], voffB[2];
#pragma unroll
  for (int i = 0; i < 2; ++i) { int R, C; stage_rc(tid * 16 + i * 8192, R, C); const int Rb = Epi::PERM ? ((R & ~31) + perm32(R & 31)) : R;
    voffA[i] = (unsigned)(R * (int)S.lda_b + C * 2); voffB[i] = (unsigned)(Rb * ldb + C) * 2u; }
  const size_t kstep = (size_t)(BK * 2);
  const size_t hsA = (size_t)HALF * S.lda_b, hsB = (size_t)HALF * ldb * 2;
  const unsigned ldsw = (unsigned)wid * 1024u;
  const int aoff = lds_byte(wr * 64 + fr, fq * 8), boff = lds_byte(wc * 32 + fr, fq * 8);
#define PG8_SA(b, h) (((b) * 2 + (h)) * HTB)
#define PG8_SB(b, h) ((4 + (b) * 2 + (h)) * HTB)
#define PG8_STAGE(bufoff, gbase, voff) do { _Pragma("unroll") for (int _i = 0; _i < 2; ++_i) \
    __builtin_amdgcn_global_load_lds((const unsigned*)((const char*)(gbase) + (voff)[_i]), (LAS unsigned*)(lds + (bufoff) + ldsw + _i * 8192), 16, 0, 0); } while (0)
#define PG8_LDA(dst, b, h) do { _Pragma("unroll") for (int m = 0; m < 4; ++m) _Pragma("unroll") for (int k = 0; k < 2; ++k) dst[m][k] = *(const LAS bf16x8*)(lds + PG8_SA(b, h) + aoff + m * 2048 + k * 1024); } while (0)
#define PG8_LDB(dst, b, h) do { _Pragma("unroll") for (int n = 0; n < 2; ++n) _Pragma("unroll") for (int k = 0; k < 2; ++k) dst[n][k] = *(const LAS bf16x8*)(lds + PG8_SB(b, h) + boff + n * 2048 + k * 1024); } while (0)
#define PG8_MMA(ai, bj, At, Bt) do { __builtin_amdgcn_s_setprio(1); _Pragma("unroll") for (int m = 0; m < 4; ++m) _Pragma("unroll") for (int n = 0; n < 2; ++n) _Pragma("unroll") for (int k = 0; k < 2; ++k) \
    acc[ai][bj][m][n] = __builtin_amdgcn_mfma_f32_16x16x32_bf16(Bt[n][k], At[m][k], acc[ai][bj][m][n], 0, 0, 0); __builtin_amdgcn_s_setprio(0); } while (0)
#define PG8_WAIT_V(n) asm volatile("s_waitcnt vmcnt(" #n ")" ::: "memory")
#define PG8_WAIT_L(n) asm volatile("s_waitcnt lgkmcnt(" #n ")" ::: "memory")
#define PG8_BAR __builtin_amdgcn_s_barrier()
#define PG8_SCHED __builtin_amdgcn_sched_barrier(0)
  Unit cur, nxt; int ui = 0;
  if (!S.next(0, cur)) return;
  f32x4 acc[2][2][4][2];
#pragma unroll
  for (int a = 0; a < 2; ++a)
#pragma unroll
    for (int b = 0; b < 2; ++b)
#pragma unroll
      for (int m = 0; m < 4; ++m)
#pragma unroll
        for (int n = 0; n < 2; ++n) acc[a][b][m][n] = (f32x4){0.f, 0.f, 0.f, 0.f};
  bf16x8 At[4][2], B0[2][2], B1[2][2];
  const char* cA = S.a_ptr(cur); const char* cB = S.b_ptr(cur);
  PG8_STAGE(PG8_SB(0, 0), cB, voffB); PG8_STAGE(PG8_SA(0, 0), cA, voffA); PG8_STAGE(PG8_SB(0, 1), cB + hsB, voffB); PG8_STAGE(PG8_SA(0, 1), cA + hsA, voffA);
  if (wr == 1) PG8_BAR;
  PG8_WAIT_V(4); PG8_BAR;
  PG8_STAGE(PG8_SB(1, 0), cB + kstep, voffB); PG8_STAGE(PG8_SA(1, 0), cA + kstep, voffA); PG8_STAGE(PG8_SB(1, 1), cB + hsB + kstep, voffB);
  PG8_WAIT_V(6); PG8_BAR;
  for (;;) {
    const bool has_next = S.next(ui + 1, nxt);
    const char* nA = has_next ? S.a_ptr(nxt) : cA; const char* nB = has_next ? S.b_ptr(nxt) : cB;
    for (int t = 0; t < nt; t += 2) {
      const bool last = (t == nt - 2);
      const char* a1 = cA + (size_t)(t + 1) * kstep;
      const char* a2 = last ? nA : cA + (size_t)(t + 2) * kstep; const char* b2 = last ? nB : cB + (size_t)(t + 2) * kstep;
      const char* a3 = a2 + kstep; const char* b3 = b2 + kstep;
      PG8_LDB(B0, 0, 0); PG8_SCHED; PG8_LDA(At, 0, 0); PG8_STAGE(PG8_SA(1, 1), a1 + hsA, voffA);
      PG8_WAIT_L(8); PG8_BAR; PG8_WAIT_L(0); PG8_MMA(0, 0, At, B0); PG8_BAR; PG8_SCHED;
      PG8_LDB(B1, 0, 1); PG8_STAGE(PG8_SB(0, 0), b2, voffB);
      PG8_BAR; PG8_WAIT_L(0); PG8_MMA(0, 1, At, B1); PG8_BAR;
      PG8_LDA(At, 0, 1); PG8_STAGE(PG8_SA(0, 0), a2, voffA);
      PG8_BAR; PG8_WAIT_L(0); PG8_MMA(1, 0, At, B0); PG8_BAR; PG8_SCHED;
      PG8_STAGE(PG8_SB(0, 1), b2 + hsB, voffB);
      PG8_WAIT_V(6); PG8_BAR; PG8_MMA(1, 1, At, B1); PG8_BAR;
      PG8_LDB(B0, 1, 0); PG8_SCHED; PG8_LDA(At, 1, 0); PG8_STAGE(PG8_SA(0, 1), a2 + hsA, voffA);
      PG8_WAIT_L(8); PG8_BAR; PG8_WAIT_L(0); PG8_MMA(0, 0, At, B0); PG8_BAR; PG8_SCHED;
      PG8_LDB(B1, 1, 1); PG8_STAGE(PG8_SB(1, 0), b3, voffB);
      PG8_BAR; PG8_WAIT_L(0); PG8_MMA(0, 1, At, B1); PG8_BAR;
      PG8_LDA(At, 1, 1); PG8_STAGE(PG8_SA(1, 0), a3, voffA);
      PG8_BAR; PG8_WAIT_L(0); PG8_MMA(1, 0, At, B0); PG8_BAR; PG8_SCHED;
      PG8_STAGE(PG8_SB(1, 1), b3 + hsB, voffB);
      PG8_WAIT_V(6); PG8_BAR; PG8_MMA(1, 1, At, B1); PG8_BAR;
    }
    const bool zero = E(acc, cur, wr, wc, fr, fq);
    if (zero) {
#pragma unroll
      for (int a = 0; a < 2; ++a)
#pragma unroll
        for (int b = 0; b < 2; ++b)
#pragma unroll
          for (int m = 0; m < 4; ++m)
#pragma unroll
            for (int n = 0; n < 2; ++n) acc[a][b][m][n] = (f32x4){0.f, 0.f, 0.f, 0.f};
    }
    if (!has_next) break;
    cur = nxt; cA = nA; cB = nB; ++ui;
  }
  PG8_WAIT_V(0);
  if (wr == 0) PG8_BAR;
  PG8_BAR;
#undef PG8_SA
#undef PG8_SB
#undef PG8_STAGE
#undef PG8_LDA
#undef PG8_LDB
#undef PG8_MMA
#undef PG8_WAIT_V
#undef PG8_WAIT_L
#undef PG8_BAR
#undef PG8_SCHED
}

typedef f32x4 Acc[2][2][4][2];
struct EpiStore {
  static constexpr bool PERM = true;
  bf16_t* O; int ldc; int ncols;
  DI bool operator()(Acc& acc, const Unit& u, int wr, int wc, int fr, int fq) const {
    const int row0 = u.pm * BM + wr * 64 + fr, col0 = u.pn * BM + wc * 32 + 8 * fq;
#pragma unroll
    for (int ai = 0; ai < 2; ++ai)
#pragma unroll
      for (int m = 0; m < 4; ++m) { bf16_t* rowp = O + (size_t)(row0 + ai * HALF + m * 16) * ldc;
#pragma unroll
        for (int bj = 0; bj < 2; ++bj) { const int col = col0 + bj * HALF; const f32x4 v0 = acc[ai][bj][m][0], v1 = acc[ai][bj][m][1];
          u32x4 w; w.x = cvtpk(v0[0], v0[1]); w.y = cvtpk(v0[2], v0[3]); w.z = cvtpk(v1[0], v1[1]); w.w = cvtpk(v1[2], v1[3]);
          if (col < ncols) *(u32x4*)(rowp + col) = w; } }
    return true;
  }
};
template <int ACT> struct EpiAct {
  static constexpr bool PERM = true;
  bf16_t* O; int ldc; const float* bias;
  DI bool operator()(Acc& acc, const Unit& u, int wr, int wc, int fr, int fq) const {
    const int row0 = u.pm * BM + wr * 64 + fr, col0 = u.pn * BM + wc * 32 + 8 * fq;
    f32x4 bv[2][2];
#pragma unroll
    for (int bj = 0; bj < 2; ++bj)
#pragma unroll
      for (int n = 0; n < 2; ++n) bv[bj][n] = *(const f32x4*)(bias + col0 + bj * HALF + 4 * n);
#pragma unroll
    for (int ai = 0; ai < 2; ++ai)
#pragma unroll
      for (int m = 0; m < 4; ++m) { bf16_t* rowp = O + (size_t)(row0 + ai * HALF + m * 16) * ldc + col0;
#pragma unroll
        for (int bj = 0; bj < 2; ++bj) { f32x4 v0 = acc[ai][bj][m][0] + bv[bj][0], v1 = acc[ai][bj][m][1] + bv[bj][1];
#pragma unroll
          for (int j = 0; j < 4; ++j) {
            if (ACT == 0) { v0[j] = sigmoidf(v0[j]); v1[j] = sigmoidf(v1[j]); }
            else { const float a = fmaxf(v0[j], 0.f), b = fmaxf(v1[j], 0.f); v0[j] = a * a; v1[j] = b * b; } }
          u32x4 w; w.x = cvtpk(v0[0], v0[1]); w.y = cvtpk(v0[2], v0[3]); w.z = cvtpk(v1[0], v1[1]); w.w = cvtpk(v1[2], v1[3]);
          *(u32x4*)(rowp + bj * HALF) = w; } }
    return true;
  }
};
struct EpiHorner {
  static constexpr bool PERM = true;
  const bf16_t* G; bf16_t* Z;
  DI bool operator()(Acc& acc, const Unit& u, int wr, int wc, int fr, int fq) const {
    const int row0 = u.pm * BM + wr * 64 + fr, col0 = u.pn * BM + wc * 32 + 8 * fq, k = u.k;
#pragma unroll
    for (int ai = 0; ai < 2; ++ai)
#pragma unroll
      for (int m = 0; m < 4; ++m) { const size_t row = (size_t)(row0 + ai * HALF + m * 16);
#pragma unroll
        for (int bj = 0; bj < 2; ++bj) { const int col = col0 + bj * HALF;
          const u32x4 s0 = *(const u32x4*)(G + row * 4096 + k * 1024 + col);
          float f[8] = {bflo(s0.x), bfhi(s0.x), bflo(s0.y), bfhi(s0.y), bflo(s0.z), bfhi(s0.z), bflo(s0.w), bfhi(s0.w)};
          if (k < 3) { const u32x4 s1 = *(const u32x4*)(G + row * 4096 + (k + 1) * 1024 + col);
            const float d[8] = {bflo(s1.x), bfhi(s1.x), bflo(s1.y), bfhi(s1.y), bflo(s1.z), bfhi(s1.z), bflo(s1.w), bfhi(s1.w)};
#pragma unroll
            for (int j = 0; j < 8; ++j) f[j] = f[j] * __builtin_amdgcn_rcpf(d[j]); }
          f32x4 v0 = acc[ai][bj][m][0], v1 = acc[ai][bj][m][1];
#pragma unroll
          for (int j = 0; j < 4; ++j) { v0[j] *= f[j]; v1[j] *= f[4 + j]; }
          acc[ai][bj][m][0] = v0; acc[ai][bj][m][1] = v1;
          if (k == 3) { u32x4 w; w.x = cvtpk(v0[0], v0[1]); w.y = cvtpk(v0[2], v0[3]); w.z = cvtpk(v1[0], v1[1]); w.w = cvtpk(v1[2], v1[3]);
            *(u32x4*)(Z + row * 1024 + col) = w; } } }
    return k == 3;
  }
};
struct EpiResid {
  static constexpr bool PERM = false;
  const float* xin_l; const float* xin_c; float* out_l; float* out_c; const float* g_l; const float* g_c; const float* bias;
  DI bool operator()(Acc& acc, const Unit& u, int wr, int wc, int fr, int fq) const {
    const bool isc = u.pm >= TL / BM;
    const float* xin = isc ? xin_c - (size_t)TL * D : xin_l; float* out = isc ? out_c - (size_t)TL * D : out_l; const float* g = isc ? g_c : g_l;
    const int row0 = u.pm * BM + wr * 64 + fr, col0 = u.pn * BM + wc * 32 + 4 * fq;
    f32x4 gv[2][2], bv[2][2];
#pragma unroll
    for (int bj = 0; bj < 2; ++bj)
#pragma unroll
      for (int n = 0; n < 2; ++n) { gv[bj][n] = *(const f32x4*)(g + col0 + bj * HALF + n * 16); bv[bj][n] = bias ? *(const f32x4*)(bias + col0 + bj * HALF + n * 16) : (f32x4){0.f, 0.f, 0.f, 0.f}; }
#pragma unroll
    for (int ai = 0; ai < 2; ++ai)
#pragma unroll
      for (int m = 0; m < 4; ++m) { const size_t off = (size_t)(row0 + ai * HALF + m * 16) * D + col0;
#pragma unroll
        for (int bj = 0; bj < 2; ++bj)
#pragma unroll
          for (int n = 0; n < 2; ++n) { const f32x4 xv = *(const f32x4*)(xin + off + bj * HALF + n * 16);
            *(f32x4*)(out + off + bj * HALF + n * 16) = xv * ALPHA + gv[bj][n] * (acc[ai][bj][m][n] + bv[bj][n]); } }
    return true;
  }
};
struct EpiAtomic {
  static constexpr bool PERM = false;
  float* ACC;
  DI bool operator()(Acc& acc, const Unit& u, int wr, int wc, int fr, int fq) const {
    const int row0 = wr * 64 + fr, col0 = u.pn * BM + wc * 32 + 4 * fq;
#pragma unroll
    for (int ai = 0; ai < 2; ++ai)
#pragma unroll
      for (int m = 0; m < 4; ++m) { float* rp = ACC + (size_t)(row0 + ai * HALF + m * 16) * D + col0;
#pragma unroll
        for (int bj = 0; bj < 2; ++bj)
#pragma unroll
          for (int n = 0; n < 2; ++n)
#pragma unroll
            for (int e = 0; e < 4; ++e) (void)__hip_atomic_fetch_add(rp + bj * HALF + n * 16 + e, acc[ai][bj][m][n][e], __ATOMIC_RELAXED, __HIP_MEMORY_SCOPE_AGENT); }
    return true;
  }
};
}

namespace att {
constexpr int QBLK = 32, KVBLK = 64;
constexpr float THR = 8.f;
constexpr size_t SHM_V = KVBLK * 128 * 2;
constexpr size_t OFF_K = 3 * SHM_V, OFF_WS = OFF_K + 3 * 64 * 208, OFF_O1 = OFF_WS + 8 * 64 * 4;
static_assert(OFF_O1 + 65536 <= LDS_PHASE, "attn lds");
#define SBAR() __builtin_amdgcn_sched_barrier(0)
DI int crow(int r, int hi) { return (r & 3) + 8 * (r >> 2) + 4 * hi; }
DI bf16x8 ld8(const bf16_t* p) { return *reinterpret_cast<const bf16x8*>(p); }

DI void partialSM(f32x16& p0, f32x16& p1, float& m_reg, float& mn, float& alpha, const float C, const float thr_raw) {
  float pmax = p0[0];
#pragma unroll
  for (int r = 1; r < 16; ++r) pmax = fmaxf(pmax, p0[r]);
#pragma unroll
  for (int r = 0; r < 16; ++r) pmax = fmaxf(pmax, p1[r]);
  { auto rr = __builtin_amdgcn_permlane32_swap(__float_as_uint(pmax), __float_as_uint(pmax), false, false);
    pmax = fmaxf(__uint_as_float(rr[0]), __uint_as_float(rr[1])); }
  if (__builtin_expect(__all(pmax - m_reg <= thr_raw), 1)) { mn = m_reg; alpha = 1.f; }
  else { mn = fmaxf(m_reg, pmax); alpha = __builtin_amdgcn_exp2f((m_reg - mn) * C); m_reg = mn; }
  const float mnC = -mn * C;
#pragma unroll
  for (int r = 0; r < 16; ++r) p0[r] = fmaf(p0[r], C, mnC);
#pragma unroll
  for (int r = 0; r < 16; ++r) p1[r] = fmaf(p1[r], C, mnC);
#pragma unroll
  for (int r = 0; r < 16; ++r) p0[r] = __builtin_amdgcn_exp2f(p0[r]);
}
DI void finishSM(f32x16& p0, f32x16& p1, float alpha, float& l_reg, bf16x8& pa0, bf16x8& pa1, bf16x8& pa2, bf16x8& pa3) {
#pragma unroll
  for (int r = 0; r < 16; ++r) p1[r] = __builtin_amdgcn_exp2f(p1[r]);
  float ps = 0;
#pragma unroll
  for (int r = 0; r < 16; ++r) ps += p0[r];
#pragma unroll
  for (int r = 0; r < 16; ++r) ps += p1[r];
  { auto rr = __builtin_amdgcn_permlane32_swap(__float_as_uint(ps), __float_as_uint(ps), false, false);
    ps = __uint_as_float(rr[0]) + __uint_as_float(rr[1]); }
  l_reg = l_reg * alpha + ps;
#define PK4(P, BASE, OUT) do { unsigned a0 = cvtpk(P[BASE + 0], P[BASE + 1]), a1 = cvtpk(P[BASE + 2], P[BASE + 3]);   \
    unsigned b0 = cvtpk(P[BASE + 4], P[BASE + 5]), b1 = cvtpk(P[BASE + 6], P[BASE + 7]);                              \
    auto r0 = __builtin_amdgcn_permlane32_swap(a0, b0, false, false); auto r1 = __builtin_amdgcn_permlane32_swap(a1, b1, false, false); \
    u32x4 w = {r0[0], r1[0], r0[1], r1[1]}; OUT = *reinterpret_cast<bf16x8*>(&w); } while (0)
  PK4(p0, 0, pa0); PK4(p0, 8, pa1); PK4(p1, 0, pa2); PK4(p1, 8, pa3);
#undef PK4
}
template <int DQK>
DI void qkt(f32x16& p0, f32x16& p1, const char* Ks, const bf16x8* qr, int r32, int hi) {
  constexpr int KP = DQK * 2 + 16;
  p0 = f32x16{}; p1 = f32x16{};
#pragma unroll
  for (int d0 = 0; d0 < DQK / 16; ++d0) { const int cb = (d0 * 16 + hi * 8) * 2;
    bf16x8 b0 = *reinterpret_cast<const bf16x8*>(Ks + r32 * KP + cb);
    bf16x8 b1 = *reinterpret_cast<const bf16x8*>(Ks + (32 + r32) * KP + cb);
    p0 = __builtin_amdgcn_mfma_f32_32x32x16_bf16(b0, qr[d0], p0, 0, 0, 0);
    p1 = __builtin_amdgcn_mfma_f32_32x32x16_bf16(b1, qr[d0], p1, 0, 0, 0); }
}
DI int v_st(int k, int c) { const int kk = (k & ~0xC) | ((k & 4) << 1) | ((k & 8) >> 1); return ((kk >> 3) * 4 + (c >> 5)) * 512 + ((kk & 7) * 32 + (c & 31)) * 2; }
DI int v_rd_base(int lane) { return ((lane & 3) << 3) | (((lane >> 2) & 3) << 6) | (((lane >> 4) & 1) << 5) | (((lane >> 5) & 1) << 8); }
constexpr int v_rd_off(int d0, int ks, int half) { return d0 * 512 + ks * 4096 + half * 2048; }
template <int OFF> DI s16x4 tr_read(int vb) {
  s16x4 r; asm volatile("ds_read_b64_tr_b16 %0, %1 offset:%2" : "=&v"(r) : "v"(vb), "i"(OFF) : "memory"); return r;
}
template <int D0> DI void pv_one(f32x16& od, int vb, bf16x8 pa0, bf16x8 pa1, bf16x8 pa2, bf16x8 pa3) {
  const s16x4 l0 = tr_read<v_rd_off(D0, 0, 0)>(vb), h0 = tr_read<v_rd_off(D0, 0, 1)>(vb), l1 = tr_read<v_rd_off(D0, 1, 0)>(vb), h1 = tr_read<v_rd_off(D0, 1, 1)>(vb);
  const s16x4 l2 = tr_read<v_rd_off(D0, 2, 0)>(vb), h2 = tr_read<v_rd_off(D0, 2, 1)>(vb), l3 = tr_read<v_rd_off(D0, 3, 0)>(vb), h3 = tr_read<v_rd_off(D0, 3, 1)>(vb);
  asm volatile("s_waitcnt lgkmcnt(0)" ::: "memory"); SBAR();
#define PK(L, H) (bf16x8){L[0], L[1], L[2], L[3], H[0], H[1], H[2], H[3]}
  od = __builtin_amdgcn_mfma_f32_32x32x16_bf16(pa0, PK(l0, h0), od, 0, 0, 0);
  od = __builtin_amdgcn_mfma_f32_32x32x16_bf16(pa1, PK(l1, h1), od, 0, 0, 0);
  od = __builtin_amdgcn_mfma_f32_32x32x16_bf16(pa2, PK(l2, h2), od, 0, 0, 0);
  od = __builtin_amdgcn_mfma_f32_32x32x16_bf16(pa3, PK(l3, h3), od, 0, 0, 0);
#undef PK
}
template <int KS> DI void pv_step(f32x16* o, int vb, bf16x8 pa) {
  const s16x4 l0 = tr_read<v_rd_off(0, KS, 0)>(vb), h0 = tr_read<v_rd_off(0, KS, 1)>(vb), l1 = tr_read<v_rd_off(1, KS, 0)>(vb), h1 = tr_read<v_rd_off(1, KS, 1)>(vb);
  const s16x4 l2 = tr_read<v_rd_off(2, KS, 0)>(vb), h2 = tr_read<v_rd_off(2, KS, 1)>(vb), l3 = tr_read<v_rd_off(3, KS, 0)>(vb), h3 = tr_read<v_rd_off(3, KS, 1)>(vb);
  asm volatile("s_waitcnt lgkmcnt(0)" ::: "memory"); SBAR();
#define PK(L, H) (bf16x8){L[0], L[1], L[2], L[3], H[0], H[1], H[2], H[3]}
  o[0] = __builtin_amdgcn_mfma_f32_32x32x16_bf16(pa, PK(l0, h0), o[0], 0, 0, 0);
  o[1] = __builtin_amdgcn_mfma_f32_32x32x16_bf16(pa, PK(l1, h1), o[1], 0, 0, 0);
  o[2] = __builtin_amdgcn_mfma_f32_32x32x16_bf16(pa, PK(l2, h2), o[2], 0, 0, 0);
  o[3] = __builtin_amdgcn_mfma_f32_32x32x16_bf16(pa, PK(l3, h3), o[3], 0, 0, 0);
#undef PK
}
DI void pv_d0(f32x16* o, int vb, bf16x8 pa0, bf16x8 pa1, bf16x8 pa2, bf16x8 pa3) {
  pv_step<0>(o, vb, pa0); pv_step<1>(o, vb, pa1); pv_step<2>(o, vb, pa2); pv_step<3>(o, vb, pa3);
}

DI void pv_psm(f32x16* o, int vb, bf16x8 pa0, bf16x8 pa1, bf16x8 pa2, bf16x8 pa3,
               f32x16& p0, f32x16& p1, float& m_reg, float& mn, float& alpha, const float C, const float thr_raw) {
  pv_step<0>(o, vb, pa0);
  float pmax = p0[0];
#pragma unroll
  for (int r = 1; r < 16; ++r) pmax = fmaxf(pmax, p0[r]);
#pragma unroll
  for (int r = 0; r < 16; ++r) pmax = fmaxf(pmax, p1[r]);
  { auto rr = __builtin_amdgcn_permlane32_swap(__float_as_uint(pmax), __float_as_uint(pmax), false, false);
    pmax = fmaxf(__uint_as_float(rr[0]), __uint_as_float(rr[1])); }
  if (__builtin_expect(__all(pmax - m_reg <= thr_raw), 1)) { mn = m_reg; alpha = 1.f; }
  else { mn = fmaxf(m_reg, pmax); alpha = __builtin_amdgcn_exp2f((m_reg - mn) * C); m_reg = mn; }
  const float mnC = -mn * C;
  pv_step<1>(o, vb, pa1);
#pragma unroll
  for (int r = 0; r < 16; ++r) p0[r] = fmaf(p0[r], C, mnC);
  pv_step<2>(o, vb, pa2);
#pragma unroll
  for (int r = 0; r < 16; ++r) p1[r] = fmaf(p1[r], C, mnC);
  pv_step<3>(o, vb, pa3);
#pragma unroll
  for (int r = 0; r < 16; ++r) p0[r] = __builtin_amdgcn_exp2f(p0[r]);
}

template <int DQK>
DI void attn_body(const bf16_t* __restrict__ Qb, int ldq, const bf16_t* __restrict__ K0, int ldk0, const bf16_t* __restrict__ K1, int ldk1,
                  const bf16_t* __restrict__ Vh, int ldv, int seq, float scale, char* lds, f32x16 (&o)[4], float (&rli)[16]) {
  constexpr int KP = DQK * 2 + 16, SHM_K = 64 * KP, CPR = DQK / 8;
  const float C = scale * 1.4426950408889634f, thr_raw = THR / scale;
  const int tid = tidx(), wid = tid >> 6, lane = tid & 63, r32 = lane & 31, hi = lane >> 5;
  char* V_lds = lds; char* K_lds = lds + OFF_K;
  float* wsl = (float*)(lds + OFF_WS) + wid * 64; float* li_l = wsl; float* al_l = wsl + 32;
  float m_reg = -1e30f, l_reg = 0; bf16x8 qr[DQK / 16];
#pragma unroll
  for (int d = 0; d < 4; ++d) o[d] = f32x16{};
  const bf16_t* Qw = Qb + (long)(wid * QBLK + r32) * ldq + hi * 8;
#pragma unroll
  for (int d0 = 0; d0 < DQK / 16; ++d0) qr[d0] = ld8(Qw + d0 * 16);
  const int sr = tid >> 4, sc = (tid & 15) * 8, vst0 = v_st(sr, sc), vst1 = v_st(32 + sr, sc);
  const int vb0 = (int)(uintptr_t)V_lds + v_rd_base(lane);
  const int kc0 = tid, kc1 = 512 + (tid & 255);
  const int kr0 = kc0 / CPR, kcc0 = kc0 % CPR, kr1 = (DQK == 96) ? kc1 / CPR : 0, kcc1 = (DQK == 96) ? kc1 % CPR : 0;
  const bf16_t* kp0 = (kcc0 < 8) ? K0 + (long)kr0 * ldk0 + kcc0 * 8 : K1 + (long)kr0 * ldk1 + (kcc0 - 8) * 8;
  const long kst0 = (kcc0 < 8) ? (long)64 * ldk0 : (long)64 * ldk1;
  const bf16_t* kp1 = (kcc1 < 8) ? K0 + (long)kr1 * ldk0 + kcc1 * 8 : K1 + (long)kr1 * ldk1 + (kcc1 - 8) * 8;
  const long kst1 = (kcc1 < 8) ? (long)64 * ldk0 : (long)64 * ldk1;
  const int kw0 = kr0 * KP + kcc0 * 16, kw1 = kr1 * KP + kcc1 * 16;
  struct { bf16x8 vs0, vs1, ks0, ks1; } sr_[2];
#define SLOAD(i, t) do { sr_[i].vs0 = ld8(&Vh[(long)((t) * 64 + sr) * ldv + sc]); sr_[i].vs1 = ld8(&Vh[(long)((t) * 64 + 32 + sr) * ldv + sc]); \
    sr_[i].ks0 = ld8(kp0 + (long)(t) * kst0); if (DQK == 96) sr_[i].ks1 = ld8(kp1 + (long)(t) * kst1); } while (0)
#define SWRITE(b, i) do { *(bf16x8*)(V_lds + (b) * SHM_V + vst0) = sr_[i].vs0; *(bf16x8*)(V_lds + (b) * SHM_V + vst1) = sr_[i].vs1; \
    *(bf16x8*)(K_lds + (b) * SHM_K + kw0) = sr_[i].ks0; if (DQK == 96) *(bf16x8*)(K_lds + (b) * SHM_K + kw1) = sr_[i].ks1; } while (0)
#define SWAIT() do { if (DQK == 96) asm volatile("s_waitcnt vmcnt(4)" ::: "memory"); else asm volatile("s_waitcnt vmcnt(3)" ::: "memory"); } while (0)
#define RESC(a) do { if (__any((a) < 1.f)) { if (hi == 0) al_l[r32] = (a); asm volatile("s_waitcnt lgkmcnt(0)" ::: "memory"); \
    _Pragma("unroll") for (int d = 0; d < 4; ++d) _Pragma("unroll") for (int r = 0; r < 16; ++r) o[d][r] *= al_l[crow(r, hi)]; } } while (0)
  f32x16 pA0, pA1, pB0, pB1; float mnA, mnB, alA, alB; bf16x8 pa0, pa1, pa2, pa3; const int NT = seq / KVBLK;
  constexpr int SE = 0, SO = 1;
  SLOAD(SE, 0); asm volatile("s_waitcnt vmcnt(0)" ::: "memory"); SWRITE(0, SE); __syncthreads();
  qkt<DQK>(pA0, pA1, K_lds, qr, r32, hi); partialSM(pA0, pA1, m_reg, mnA, alA, C, thr_raw);
  SLOAD(SO, 1); if (2 < NT) SLOAD(SE, 2);
  SWAIT(); SWRITE(1, SO); __syncthreads();
  int b = 1;
  for (int j = 1; j + 1 < NT; j += 2) {
    const int b1 = (b == 2) ? 0 : b + 1, b2 = (b == 0) ? 2 : b - 1;
    SBAR(); qkt<DQK>(pB0, pB1, K_lds + b * SHM_K, qr, r32, hi);
    finishSM(pA0, pA1, alA, l_reg, pa0, pa1, pa2, pa3); SBAR();
    SLOAD(SO, j + 2); SBAR();
    pv_psm(o, vb0 + b2 * (int)SHM_V, pa0, pa1, pa2, pa3, pB0, pB1, m_reg, mnB, alB, C, thr_raw);
    SWAIT(); SWRITE(b1, SE);
    RESC(alB); __syncthreads();
    SBAR(); qkt<DQK>(pA0, pA1, K_lds + b1 * SHM_K, qr, r32, hi);
    finishSM(pB0, pB1, alB, l_reg, pa0, pa1, pa2, pa3); SBAR();
    if (j + 3 < NT) SLOAD(SE, j + 3); SBAR();
    pv_psm(o, vb0 + b * (int)SHM_V, pa0, pa1, pa2, pa3, pA0, pA1, m_reg, mnA, alA, C, thr_raw);
    SWAIT(); SWRITE(b2, SO);
    RESC(alA); __syncthreads();
    b = b2;
  }
  { const int b2 = (b == 0) ? 2 : b - 1;
    SBAR(); qkt<DQK>(pB0, pB1, K_lds + b * SHM_K, qr, r32, hi);
    finishSM(pA0, pA1, alA, l_reg, pa0, pa1, pa2, pa3); SBAR();
    pv_psm(o, vb0 + b2 * (int)SHM_V, pa0, pa1, pa2, pa3, pB0, pB1, m_reg, mnB, alB, C, thr_raw);
    RESC(alB);
    finishSM(pB0, pB1, alB, l_reg, pa0, pa1, pa2, pa3); SBAR();
    pv_d0(o, vb0 + b * (int)SHM_V, pa0, pa1, pa2, pa3); }
  if (hi == 0) li_l[r32] = l_reg; asm volatile("s_waitcnt lgkmcnt(0)" ::: "memory");
#pragma unroll
  for (int r = 0; r < 16; ++r) rli[r] = 1.f / li_l[crow(r, hi)];
  __syncthreads();
#undef SLOAD
#undef SWRITE
#undef SWAIT
#undef RESC
}

constexpr int D2_KT = 64 * 144, D2_KBUF = 2 * D2_KT, D2_OFF_K = 2 * (int)SHM_V, D2_OFF_Q = D2_OFF_K + 2 * D2_KBUF, D2_QM = 256 * 144, D2_OFF_WS = D2_OFF_Q + 2 * D2_QM;
static_assert(D2_OFF_WS + 8 * 512 <= LDS_PHASE, "diff2 lds");
DI void qkt_l(f32x16& p0, f32x16& p1, const char* Ks, const char* Qrow, int r32, int hi) {
  p0 = f32x16{}; p1 = f32x16{};
#pragma unroll
  for (int d0 = 0; d0 < 4; ++d0) { const int cb = (d0 * 16 + hi * 8) * 2;
    const bf16x8 qf = *reinterpret_cast<const bf16x8*>(Qrow + cb);
    const bf16x8 b0 = *reinterpret_cast<const bf16x8*>(Ks + r32 * 144 + cb);
    const bf16x8 b1 = *reinterpret_cast<const bf16x8*>(Ks + (32 + r32) * 144 + cb);
    p0 = __builtin_amdgcn_mfma_f32_32x32x16_bf16(b0, qf, p0, 0, 0, 0);
    p1 = __builtin_amdgcn_mfma_f32_32x32x16_bf16(b1, qf, p1, 0, 0, 0); }
}
template <int KS> DI void pv2_step(f32x16* o1, f32x16* o2, int vb, bf16x8 pa, bf16x8 pb) {
  const s16x4 l0 = tr_read<v_rd_off(0, KS, 0)>(vb), h0 = tr_read<v_rd_off(0, KS, 1)>(vb), l1 = tr_read<v_rd_off(1, KS, 0)>(vb), h1 = tr_read<v_rd_off(1, KS, 1)>(vb);
  const s16x4 l2 = tr_read<v_rd_off(2, KS, 0)>(vb), h2 = tr_read<v_rd_off(2, KS, 1)>(vb), l3 = tr_read<v_rd_off(3, KS, 0)>(vb), h3 = tr_read<v_rd_off(3, KS, 1)>(vb);
  asm volatile("s_waitcnt lgkmcnt(0)" ::: "memory"); SBAR();
#define PK(L, H) (bf16x8){L[0], L[1], L[2], L[3], H[0], H[1], H[2], H[3]}
  const bf16x8 v0 = PK(l0, h0), v1 = PK(l1, h1), v2 = PK(l2, h2), v3 = PK(l3, h3);
#undef PK
  o1[0] = __builtin_amdgcn_mfma_f32_32x32x16_bf16(pa, v0, o1[0], 0, 0, 0); o2[0] = __builtin_amdgcn_mfma_f32_32x32x16_bf16(pb, v0, o2[0], 0, 0, 0);
  o1[1] = __builtin_amdgcn_mfma_f32_32x32x16_bf16(pa, v1, o1[1], 0, 0, 0); o2[1] = __builtin_amdgcn_mfma_f32_32x32x16_bf16(pb, v1, o2[1], 0, 0, 0);
  o1[2] = __builtin_amdgcn_mfma_f32_32x32x16_bf16(pa, v2, o1[2], 0, 0, 0); o2[2] = __builtin_amdgcn_mfma_f32_32x32x16_bf16(pb, v2, o2[2], 0, 0, 0);
  o1[3] = __builtin_amdgcn_mfma_f32_32x32x16_bf16(pa, v3, o1[3], 0, 0, 0); o2[3] = __builtin_amdgcn_mfma_f32_32x32x16_bf16(pb, v3, o2[3], 0, 0, 0);
}
DI void attn_diff2(const bf16_t* __restrict__ Qg, int ldq, const bf16_t* __restrict__ Kg, int ldk, const bf16_t* __restrict__ Vg, int ldv, int seq, float scale,
                   char* lds, f32x16 (&o1)[4], f32x16 (&o2)[4], float (&rli1)[16], float (&rli2)[16]) {
  const float C = scale * 1.4426950408889634f, thr_raw = THR / scale;
  const int tid = tidx(), wid = tid >> 6, lane = tid & 63, r32 = lane & 31, hi = lane >> 5;
  char* V_lds = lds; char* K_lds = lds + D2_OFF_K; char* Q_lds = lds + D2_OFF_Q;
  float* wsl = (float*)(lds + D2_OFF_WS) + wid * 128; float* li1 = wsl; float* li2 = wsl + 32; float* al_l = wsl + 64;
#pragma unroll
  for (int i = 0; i < 8; ++i) { const int ch = tid + 512 * i, row = ch >> 4, cc = ch & 15;
    *(bf16x8*)(Q_lds + (cc >> 3) * D2_QM + row * 144 + (cc & 7) * 16) = ld8(Qg + (long)row * ldq + cc * 8); }
  const char* Q1row = Q_lds + (wid * 32 + r32) * 144; const char* Q2row = Q1row + D2_QM;
  const int sr = tid >> 4, sc = (tid & 15) * 8, vst0 = v_st(sr, sc), vst1 = v_st(32 + sr, sc);
  const int vb0 = (int)(uintptr_t)V_lds + v_rd_base(lane);
  const int kr = tid >> 3, kc = tid & 7, kw = kr * 144 + kc * 16;
  const bf16_t* kp = Kg + (long)kr * ldk + kc * 8;
  bf16x8 sv0, sv1, sk0, sk1;
#define SLOAD2(t) do { sv0 = ld8(&Vg[(long)((t) * 64 + sr) * ldv + sc]); sv1 = ld8(&Vg[(long)((t) * 64 + 32 + sr) * ldv + sc]); \
    sk0 = ld8(kp + (long)(t) * 64 * ldk); sk1 = ld8(kp + (long)(t) * 64 * ldk + 64); } while (0)
#define SWRITE2(b) do { *(bf16x8*)(V_lds + (b) * SHM_V + vst0) = sv0; *(bf16x8*)(V_lds + (b) * SHM_V + vst1) = sv1; \
    *(bf16x8*)(K_lds + (b) * D2_KBUF + kw) = sk0; *(bf16x8*)(K_lds + (b) * D2_KBUF + D2_KT + kw) = sk1; } while (0)
#define RESC2(o, a) do { if (__any((a) < 1.f)) { if (hi == 0) al_l[r32] = (a); asm volatile("s_waitcnt lgkmcnt(0)" ::: "memory"); \
    _Pragma("unroll") for (int d = 0; d < 4; ++d) _Pragma("unroll") for (int r = 0; r < 16; ++r) o[d][r] *= al_l[crow(r, hi)]; } } while (0)
  float m1 = -1e30f, m2 = -1e30f, l1 = 0.f, l2 = 0.f;
#pragma unroll
  for (int d = 0; d < 4; ++d) { o1[d] = f32x16{}; o2[d] = f32x16{}; }
  const int NT = seq / KVBLK;
  SLOAD2(0); asm volatile("s_waitcnt vmcnt(0)" ::: "memory"); SWRITE2(0); __syncthreads();
  if (1 < NT) SLOAD2(1);
  for (int t = 0; t < NT; ++t) {
    const int cur = t & 1;
    f32x16 p0, p1, q0, q1; float mn, al1, al2; bf16x8 a0, a1, a2, a3, b0, b1, b2, b3;
    qkt_l(p0, p1, K_lds + cur * D2_KBUF, Q1row, r32, hi);
    qkt_l(q0, q1, K_lds + cur * D2_KBUF + D2_KT, Q2row, r32, hi);
    partialSM(p0, p1, m1, mn, al1, C, thr_raw); finishSM(p0, p1, al1, l1, a0, a1, a2, a3);
    partialSM(q0, q1, m2, mn, al2, C, thr_raw); finishSM(q0, q1, al2, l2, b0, b1, b2, b3);
    RESC2(o1, al1); RESC2(o2, al2);
    if (t + 1 < NT) { SWRITE2(cur ^ 1); if (t + 2 < NT) SLOAD2(t + 2); }
    const int vb = vb0 + cur * (int)SHM_V;
    pv2_step<0>(o1, o2, vb, a0, b0); pv2_step<1>(o1, o2, vb, a1, b1); pv2_step<2>(o1, o2, vb, a2, b2); pv2_step<3>(o1, o2, vb, a3, b3);
    __syncthreads();
  }
  if (hi == 0) { li1[r32] = l1; li2[r32] = l2; } asm volatile("s_waitcnt lgkmcnt(0)" ::: "memory");
#pragma unroll
  for (int r = 0; r < 16; ++r) { rli1[r] = 1.f / li1[crow(r, hi)]; rli2[r] = 1.f / li2[crow(r, hi)]; }
  __syncthreads();
#undef SLOAD2
#undef SWRITE2
#undef RESC2
}
}

DI f32x4 mm16(const bf16_t* A, int lda, const bf16_t* Bt, int ldb, int K, f32x4 acc, int lane) {
  const bf16_t* ap = A + (lane & 15) * lda + 8 * (lane >> 4);
  const bf16_t* bp = Bt + (lane & 15) * ldb + 8 * (lane >> 4);
  for (int k0 = 0; k0 < K; k0 += 32) {
    const bf16x8 a = *(const bf16x8*)(ap + k0), b = *(const bf16x8*)(bp + k0);
    acc = __builtin_amdgcn_mfma_f32_16x16x32_bf16(a, b, acc, 0, 0, 0);
  }
  return acc;
}
constexpr int LP = 72;

DI int chunk_row0(int tc) { return tc * 64; }
DI int scan_idx(int tc, int dir) { return tc < 256 ? (dir == 0 ? 4 + tc : 4 + (255 - tc)) : (dir == 0 ? tc - 256 : 3 - (tc - 256)); }
DI void stream_bounds(int row0, int& lo, int& hi) { if (row0 < TL) { lo = 0; hi = TL; } else { lo = TL; hi = T; } }

DI void sincos_d(double a, float& c, float& s) {
  const double TWO_PI = 6.283185307179586476925287;
  const double k = rint(a / TWO_PI); const double r = a - k * TWO_PI; const double r2 = r * r;
  double ss = 1.0, cc = 1.0;
#pragma unroll
  for (int n = 13; n >= 1; --n) { ss = 1.0 - r2 / (double)((2 * n) * (2 * n + 1)) * ss; cc = 1.0 - r2 / (double)((2 * n - 1) * (2 * n)) * cc; }
  s = (float)(r * ss); c = (float)cc;
}
DI void phase_setup(const Params& p, unsigned char* lds) {
  const int tid = tidx();
  float* sx = (float*)lds;
  float* red = sx + 2048;
  float* MOD = (float*)(p.ws + WS_MOD);
  for (int i = tid; i < 1024; i += 512) { sx[i] = siluf(p.in[1][i]); sx[1024 + i] = siluf(p.in[3][i]); }
  __syncthreads();
  for (int item = blockIdx.x; item < 384; item += gridDim.x) {
    const int l = item / 192, cb = item % 192, cl = tid & 31, ks = tid >> 5;
    const float* w = p.in[4] + (size_t)l * 1024 * 6144 + cb * 32 + cl;
    float a0 = 0.f, a1 = 0.f;
    for (int k = ks * 64; k < ks * 64 + 64; ++k) { const float wv = w[(size_t)k * 6144]; a0 += sx[k] * wv; a1 += sx[1024 + k] * wv; }
    red[(0 * 16 + ks) * 32 + cl] = a0; red[(1 * 16 + ks) * 32 + cl] = a1;
    __syncthreads();
    if (tid < 64) { const int s = tid >> 5; float sum = 0.f;
      for (int q = 0; q < 16; ++q) sum += red[(s * 16 + q) * 32 + cl];
      MOD[(size_t)(l * 2 + s) * 6144 + cb * 32 + cl] = sum + p.in[5][l * 6144 + cb * 32 + cl]; }
    __syncthreads();
  }
  { float* acc = (float*)(p.ws + WS_ACC); for (int i = blockIdx.x * 512 + tid; i < 2 * TC * D; i += gridDim.x * 512) acc[i] = 0.f; }
  const int gt = blockIdx.x * 512 + tid;
  if (gt < 256 * 16) { const int pos = gt >> 4, i = gt & 15; const double inv = exp2(-(double)i / 16.0 * 13.287712379549449);
    float c, s; sincos_d((double)pos * inv, c, s); float* t = (float*)(p.ws + WS_TAB32) + gt * 2; t[0] = c; t[1] = s; }
  else if (gt < 256 * 16 + 256 * 8) { const int g2 = gt - 256 * 16; const int pos = g2 >> 3, i = g2 & 7; const double inv = exp2(-(double)i / 8.0 * 13.287712379549449);
    float c, s; sincos_d((double)pos * inv, c, s); float* t = (float*)(p.ws + WS_TAB16) + g2 * 2; t[0] = c; t[1] = s; }
  if (blockIdx.x == gridDim.x - 1 && tid < 128) {
    const int l = tid >> 6, lane = tid & 63; const float* lam = p.in[7] + l * 4 * 64;
    const float s1 = wave_sum(lam[lane] * lam[64 + lane]), s2 = wave_sum(lam[128 + lane] * lam[192 + lane]);
    const float lam_init = 0.8f - 0.6f * expf(-0.3f * (float)l);
    if (lane == 0) ((float*)(p.ws + WS_LAM))[l] = expf(s1) - expf(s2) + lam_init;
  }
}

DI void transpose_job(const float* __restrict__ src, int ld, int K, int nvalid, int npad, bf16_t* __restrict__ dst, unsigned char* lds, int wg0 = 0) {
  const int wave = tidx() >> 6, lane = tidx() & 63;
  float* scr = (float*)lds + wave * (64 * 33);
  if ((int)blockIdx.x < wg0) return;
  const int gw = ((int)blockIdx.x - wg0) * 8 + wave, NGW = ((int)gridDim.x - wg0) * 8;
  const int nblk = npad / 32, nitems = (K / 64) * nblk;
  for (int item = gw; item < nitems; item += NGW) {
    const int kb = item / nblk, nb = item % nblk, k0 = 64 * kb, n0 = 32 * nb;
    const int nn = n0 + (lane & 31); const bool ok = nn < nvalid;
#pragma unroll 8
    for (int i = 0; i < 32; ++i) { const int kk = 2 * i + (lane >> 5); scr[kk * 33 + (lane & 31)] = ok ? src[(size_t)(k0 + kk) * ld + nn] : 0.f; }
    LDS_WAIT();
    const int c = lane & 7;
#pragma unroll
    for (int j = 0; j < 4; ++j) { const int n = (lane >> 3) + 8 * j; const float* s = scr + (8 * c) * 33 + n;
      u32x4 o; o.x = cvtpk(s[0 * 33], s[1 * 33]); o.y = cvtpk(s[2 * 33], s[3 * 33]); o.z = cvtpk(s[4 * 33], s[5 * 33]); o.w = cvtpk(s[6 * 33], s[7 * 33]);
      *(u32x4*)(dst + (size_t)(n0 + n) * K + k0 + 8 * c) = o; }
    LDS_WAIT();
  }
}
DI void convert_layer_start(const Params& p, int l, unsigned char* lds) {
  const float* w_in = p.in[6] + (size_t)l * 1024 * 5056;
  bf16_t* wa = (bf16_t*)(p.ws + WS_WA);
  transpose_job(w_in + 1536, 5056, 1024, 1552, NB_B, (bf16_t*)((unsigned char*)wa + WA_B), lds);
}
DI void convert_layer_rest(const Params& p, int l, unsigned char* lds, int wg0) {
  const float* w_in = p.in[6] + (size_t)l * 1024 * 5056;
  bf16_t* wa = (bf16_t*)(p.ws + WS_WA); unsigned char* wb = p.ws + WS_WB;
  transpose_job(w_in + 3760, 5056, 1024, 1296, NB_D, (bf16_t*)((unsigned char*)wa + WA_D), lds, wg0);
  transpose_job(w_in + 0, 5056, 1024, 1536, 1536, (bf16_t*)((unsigned char*)wa + WA_AC), lds, wg0);
  transpose_job(w_in + 3088, 5056, 1024, 672, 768, (bf16_t*)((unsigned char*)wa + WA_AC) + (size_t)1536 * 1024, lds, wg0);
  transpose_job(p.in[15] + (size_t)l * 384 * 384, 384, 384, 384, 512, (bf16_t*)(wb + WB_UQ), lds, wg0);
  transpose_job(p.in[16] + (size_t)l * 256 * 768, 768, 256, 768, 768, (bf16_t*)(wb + WB_UKV), lds, wg0);
  for (int k = 0; k < 4; ++k) transpose_job(p.in[25] + ((size_t)l * 4 + k) * 512 * 1024, 1024, 512, 1024, 1024, (bf16_t*)(wb + WB_BR) + (size_t)k * 1024 * 512, lds, wg0);
  transpose_job(p.in[26] + (size_t)l * 1024 * 1024, 1024, 1024, 1024, 1024, (bf16_t*)(wb + WB_WO), lds, wg0);
}

DI void ln_stats(const f32x4 (&v)[4], float& mean, float& rstd) {
  float s = 0.f;
#pragma unroll
  for (int j = 0; j < 4; ++j) s += (v[j].x + v[j].y) + (v[j].z + v[j].w);
  mean = wave_sum(s) * (1.f / D); float s2 = 0.f;
#pragma unroll
  for (int j = 0; j < 4; ++j) { const f32x4 d = v[j] - mean; s2 += (d.x * d.x + d.y * d.y) + (d.z * d.z + d.w * d.w); }
  rstd = 1.f / sqrtf(wave_sum(s2) * (1.f / D) + EPS);
}
DI void phase_ln_mod(const float* xl, const float* xc, const float* mod_l, const float* mod_c, int sh_off, int sc_off, bf16_t* H, int nrows) {
  const int wave = tidx() >> 6, lane = tidx() & 63, stride = gridDim.x * 8;
  auto load_row = [&](int row, f32x4 (&v)[4]) { const float* xr = row >= TL ? xc + (size_t)(row - TL) * D : xl + (size_t)row * D;
#pragma unroll
    for (int j = 0; j < 4; ++j) v[j] = *(const f32x4*)(xr + 4 * lane + 256 * j); };
  int row = blockIdx.x * 8 + wave; f32x4 v[4];
  if (row < nrows) load_row(row, v);
  while (row < nrows) {
    const int nrow = row + stride; f32x4 vn[4];
    if (nrow < nrows) load_row(nrow, vn);
    const float* mod = row >= TL ? mod_c : mod_l;
    float mean, rstd; ln_stats(v, mean, rstd);
#pragma unroll
    for (int j = 0; j < 4; ++j) { const int c = 4 * lane + 256 * j; const f32x4 sh = *(const f32x4*)(mod + sh_off + c), sc = *(const f32x4*)(mod + sc_off + c);
      const f32x4 y = (v[j] - mean) * rstd * (sc + 1.f) + sh; u32x2 w; w.x = cvtpk(y.x, y.y); w.y = cvtpk(y.z, y.w);
      *(u32x2*)(H + (size_t)row * D + c) = w; }
#pragma unroll
    for (int j = 0; j < 4; ++j) v[j] = vn[j];
    row = nrow;
  }
}
DI void phase_ln_affine_mod(float* xl, float* xc, const float* g, const float* b, const float* mod_l, const float* mod_c, int sh_off, int sc_off, bf16_t* H, int nrows,
                            const float* cx = nullptr, const float* cacc = nullptr, const float* cg = nullptr, const float* cb = nullptr) {
  const int wave = tidx() >> 6, lane = tidx() & 63, stride = gridDim.x * 8;
  auto load_row = [&](int row, f32x4 (&v)[4]) {
    if (row >= TL && cacc) {
#pragma unroll
      for (int j = 0; j < 4; ++j) { const int c = 4 * lane + 256 * j; const size_t o = (size_t)(row - TL) * D + c;
        const f32x4 bb = cb ? *(const f32x4*)(cb + c) : (f32x4){0.f, 0.f, 0.f, 0.f};
        v[j] = *(const f32x4*)(cx + o) * ALPHA + *(const f32x4*)(cg + c) * (*(const f32x4*)(cacc + o) + bb); }
    } else { const float* xr = row >= TL ? xc + (size_t)(row - TL) * D : xl + (size_t)row * D;
#pragma unroll
      for (int j = 0; j < 4; ++j) v[j] = *(const f32x4*)(xr + 4 * lane + 256 * j); } };
  int row = blockIdx.x * 8 + wave; f32x4 v[4];
  if (row < nrows) load_row(row, v);
  while (row < nrows) {
    const int nrow = row + stride; f32x4 vn[4];
    if (nrow < nrows) load_row(nrow, vn);
    const bool isc = row >= TL; float* xr = isc ? xc + (size_t)(row - TL) * D : xl + (size_t)row * D; const float* mod = isc ? mod_c : mod_l;
    float mean, rstd; ln_stats(v, mean, rstd);
#pragma unroll
    for (int j = 0; j < 4; ++j) { const int c = 4 * lane + 256 * j; v[j] = (v[j] - mean) * rstd * *(const f32x4*)(g + c) + *(const f32x4*)(b + c); *(f32x4*)(xr + c) = v[j]; }
    if (H) {
      ln_stats(v, mean, rstd);
#pragma unroll
      for (int j = 0; j < 4; ++j) { const int c = 4 * lane + 256 * j; const f32x4 sh = *(const f32x4*)(mod + sh_off + c), sc = *(const f32x4*)(mod + sc_off + c);
        const f32x4 y = (v[j] - mean) * rstd * (sc + 1.f) + sh; u32x2 w; w.x = cvtpk(y.x, y.y); w.y = cvtpk(y.z, y.w);
        *(u32x2*)(H + (size_t)row * D + c) = w; }
    }
#pragma unroll
    for (int j = 0; j < 4; ++j) v[j] = vn[j];
    row = nrow;
  }
}

DI void phase_attn_prep(const Params& p, int l) {
  const int wave = tidx() >> 6, lane = tidx() & 63;
  bf16_t* PAC = (bf16_t*)(p.ws + WS_BIG + BG_PAC);
  const float* tab32 = (const float*)(p.ws + WS_TAB32); const float* tab16 = (const float*)(p.ws + WS_TAB16);
  const float* qn = p.in[13] + l * 384; const float* kvn = p.in[14] + l * 256;
  for (int row = blockIdx.x * 8 + wave; row < T; row += gridDim.x * 8) {
    bf16_t* pr = PAC + (size_t)row * NB_AC;
    if (row < TL) {
      const int prow = row >> 6, pcol = row & 63;
#pragma unroll
      for (int it = 0; it < 8; ++it) { const int pi = it * 64 + lane;
        const int unit = pi >> 5, q = pi & 31, sec = q >> 4, i = q & 15;
        const int e0 = unit * 64 + sec * 32 + i; const int pos = sec ? pcol : prow;
        const float cs = tab32[(pos * 16 + i) * 2], sn = tab32[(pos * 16 + i) * 2 + 1];
        const float x1 = bf2f(pr[e0]), x2 = bf2f(pr[e0 + 16]);
        pr[e0] = f2bf(x1 * cs - x2 * sn); pr[e0 + 16] = f2bf(x2 * cs + x1 * sn); }
      if (lane < 16) { const int sec = lane >> 3, i = lane & 7; const int e0 = 2176 + sec * 16 + i; const int pos = sec ? pcol : prow;
        const float cs = tab16[(pos * 8 + i) * 2], sn = tab16[(pos * 8 + i) * 2 + 1];
        const float x1 = bf2f(pr[e0]), x2 = bf2f(pr[e0 + 8]);
        pr[e0] = f2bf(x1 * cs - x2 * sn); pr[e0 + 8] = f2bf(x2 * cs + x1 * sn); }
    }
    { float v[6]; float ss = 0.f;
#pragma unroll
      for (int j = 0; j < 6; ++j) { v[j] = bf2f(pr[1536 + lane + 64 * j]); ss += v[j] * v[j]; }
      const float rs = 1.f / sqrtf(wave_sum(ss) * (1.f / 384.f) + EPS);
#pragma unroll
      for (int j = 0; j < 6; ++j) pr[1536 + lane + 64 * j] = f2bf(v[j] * rs * qn[lane + 64 * j]); }
    { float v[4]; float ss = 0.f;
#pragma unroll
      for (int j = 0; j < 4; ++j) { v[j] = bf2f(pr[1920 + lane + 64 * j]); ss += v[j] * v[j]; }
      const float rs = 1.f / sqrtf(wave_sum(ss) * (1.f / 256.f) + EPS);
#pragma unroll
      for (int j = 0; j < 4; ++j) pr[1920 + lane + 64 * j] = f2bf(v[j] * rs * kvn[lane + 64 * j]); }
  }
}
DI void phase_qup_rope(const Params& p) {
  const int wave = tidx() >> 6, lane = tidx() & 63;
  bf16_t* QUP = (bf16_t*)(p.ws + WS_BIG + BG_QUP); const float* tab16 = (const float*)(p.ws + WS_TAB16);
  for (int row = blockIdx.x * 8 + wave; row < TL; row += gridDim.x * 8) {
    const int prow = row >> 6, pcol = row & 63; bf16_t* pr = QUP + (size_t)row * 384;
    const int h = lane >> 4, q = lane & 15, sec = q >> 3, i = q & 7; const int e0 = h * 96 + 64 + sec * 16 + i; const int pos = sec ? pcol : prow;
    const float cs = tab16[(pos * 8 + i) * 2], sn = tab16[(pos * 8 + i) * 2 + 1];
    const float x1 = bf2f(pr[e0]), x2 = bf2f(pr[e0 + 8]);
    pr[e0] = f2bf(x1 * cs - x2 * sn); pr[e0 + 8] = f2bf(x2 * cs + x1 * sn);
  }
}

DI void attn_item_diff(const Params& p, int l, int q0, int h, int key0, int nkeys, char* lds) {
  const bf16_t* PAC = (const bf16_t*)(p.ws + WS_BIG + BG_PAC);
  bf16_t* OUT = (bf16_t*)(p.ws + WS_BR);
  const int tid = tidx(), wid = tid >> 6, lane = tid & 63, r32 = lane & 31, hi = lane >> 5;
  const float lam = ((const float*)(p.ws + WS_LAM))[l]; const float lam_init = 0.8f - 0.6f * expf(-0.3f * (float)l);
  f32x16 o1[4], o2[4]; float rli1[16], rli2[16];
  att::attn_diff2(PAC + (size_t)q0 * NB_AC + h * 128, NB_AC, PAC + (size_t)key0 * NB_AC + 512 + h * 128, NB_AC, PAC + (size_t)key0 * NB_AC + 1024 + h * 128, NB_AC,
                  nkeys, 0.125f, lds, o1, o2, rli1, rli2);
  const float* sw = p.in[8] + l * 128; const float og = 1.f - lam_init;
  float swv[4];
#pragma unroll
  for (int d0 = 0; d0 < 4; ++d0) swv[d0] = sw[d0 * 32 + r32] * og;
#pragma unroll
  for (int r = 0; r < 16; ++r) { float ss = 0.f; const float c1 = rli1[r], c2 = lam * rli2[r];
#pragma unroll
    for (int d0 = 0; d0 < 4; ++d0) { const float v = o1[d0][r] * c1 - o2[d0][r] * c2; o1[d0][r] = v; ss += v * v; }
#pragma unroll
    for (int off = 1; off < 32; off <<= 1) ss += __shfl_xor(ss, off);
    const float rs = 1.f / sqrtf(ss * (1.f / 128.f) + EPS);
    bf16_t* orow = OUT + (size_t)(q0 + wid * 32 + att::crow(r, hi)) * 512 + h * 128 + r32;
#pragma unroll
    for (int d0 = 0; d0 < 4; ++d0) orow[d0 * 32] = f2bf(o1[d0][r] * rs * swv[d0]); }
}
DI void attn_item_mla(const Params& p, int q0, int h, int key0, int nkeys, char* lds) {
  const bf16_t* PAC = (const bf16_t*)(p.ws + WS_BIG + BG_PAC);
  const bf16_t* QUP = (const bf16_t*)(p.ws + WS_BIG + BG_QUP); const bf16_t* KVUP = (const bf16_t*)(p.ws + WS_BIG + BG_KVUP);
  bf16_t* OUT = (bf16_t*)(p.ws + WS_BR) + (size_t)2 * T * 512;
  const int tid = tidx(), wid = tid >> 6, lane = tid & 63, r32 = lane & 31, hi = lane >> 5;
  f32x16 o[4]; float rli[16];
  if (q0 < TL) {
    bf16_t* QW = (bf16_t*)(p.ws + WS_BIG + BG_QUP); const float* tab16 = (const float*)(p.ws + WS_TAB16);
    for (int u = tid; u < 256 * 16; u += 512) { const int row = q0 + (u >> 4), q = u & 15, sec = q >> 3, i = q & 7;
      const int prow = row >> 6, pcol = row & 63, pos = sec ? pcol : prow; bf16_t* pr = QW + (size_t)row * 384 + h * 96 + 64 + sec * 16 + i;
      const float cs = tab16[(pos * 8 + i) * 2], sn = tab16[(pos * 8 + i) * 2 + 1];
      const float x1 = bf2f(pr[0]), x2 = bf2f(pr[8]);
      pr[0] = f2bf(x1 * cs - x2 * sn); pr[8] = f2bf(x2 * cs + x1 * sn); }
    __syncthreads();
  }
  att::attn_body<96>(QUP + (size_t)q0 * 384 + h * 96, 384, KVUP + (size_t)key0 * 768 + h * 192, 768, PAC + (size_t)key0 * NB_AC + 2176, NB_AC,
                     KVUP + (size_t)key0 * 768 + h * 192 + 64, 768, nkeys, 0.10206207261596575f, lds, o, rli);
#pragma unroll
  for (int r = 0; r < 16; ++r) { bf16_t* orow = OUT + (size_t)(q0 + wid * 32 + att::crow(r, hi)) * 512 + h * 128 + r32;
#pragma unroll
    for (int d0 = 0; d0 < 4; ++d0) orow[d0 * 32] = f2bf(o[d0][r] * rli[r]); }
}
DI void phase_attention(const Params& p, int l, char* lds) {
  const int c = blockIdx.x, G = gridDim.x;
  for (int it = c; it < 256; it += G) attn_item_diff(p, l, (it >> 2) * 256, it & 3, 0, T, lds);
  for (int it = c; it < 256; it += G) attn_item_mla(p, (it >> 2) * 256, it & 3, 0, T, lds);
  if (l == 0) {
    for (int it = c; it < 8; it += G) { if (it < 4) attn_item_diff(p, l, TL, it, TL, TC, lds); else attn_item_mla(p, TL, it - 4, TL, TC, lds); }
  }
}

DI float log_sigmoid(float x) { return fminf(x, 0.f) - log1pf(__expf(-fabsf(x))); }
DI float wave_scan_sum(float v, int lane, int dir) {
#pragma unroll
  for (int o = 1; o < 64; o <<= 1) { const float t = dir ? __shfl_down(v, o) : __shfl_up(v, o); const bool ok = dir ? (lane + o < 64) : (lane >= o); v += ok ? t : 0.f; }
  return v;
}
DI float wave_scan_max(float v, int lane, int dir) {
#pragma unroll
  for (int o = 1; o < 64; o <<= 1) { const float t = dir ? __shfl_down(v, o) : __shfl_up(v, o); const bool ok = dir ? (lane + o < 64) : (lane >= o); v = ok ? fmaxf(v, t) : v; }
  return v;
}
template <int NR, class F>
DI void conv_tile(const bf16_t* P, int ldp, int row0, int lo, int hi, const float* cw, int cw_ld, const float* cb, int gcol, int r0, int  , F&& out) {
  float w[5];
#pragma unroll
  for (int t = 0; t < 5; ++t) w[t] = cw[t * cw_ld];
  const float b = cb[0];
  float x[NR + 4];
#pragma unroll
  for (int i = 0; i < NR + 4; ++i) { const int row = row0 + r0 - 2 + i; const int rc = row < lo ? lo : (row >= hi ? hi - 1 : row);
    const float v = bf2f(P[(size_t)rc * ldp + gcol]); x[i] = (row >= lo && row < hi) ? v : 0.f; }
#pragma unroll
  for (int i = 0; i < NR; ++i) { const float y = b + w[0] * x[i] + w[1] * x[i + 1] + w[2] * x[i + 2] + w[3] * x[i + 3] + w[4] * x[i + 4]; out(r0 + i, siluf(y)); }
}
DI void phase_ml_s1(const Params& p, int l, unsigned char* lds) {
  const int tid = tidx(), wave = tid >> 6, lane = tid & 63;
  const bf16_t* PB = (const bf16_t*)(p.ws + WS_BIG + BG_PB);
  bf16_t* UC = (bf16_t*)(p.ws + WS_BIG + BG_UC); float* MSC = (float*)(p.ws + WS_BIG + BG_MSC);
  bf16_t* Vt = (bf16_t*)lds;
  bf16_t* Kt = Vt + 128 * LP;
  bf16_t* Kts = Kt + 64 * LP;
  float* wsv = (float*)(Kts + 64 * LP);
  const float* cw = p.in[9] + (size_t)l * 5 * 512; const float* cb = p.in[10] + l * 512; const float* gb = p.in[11] + l * 16;
  for (int item = blockIdx.x; item < 4 * NCH; item += gridDim.x) {
    const int h = item & 3, tc = item >> 2, row0 = chunk_row0(tc); int lo, hi; stream_bounds(row0, lo, hi);
    __syncthreads();
    {
      const int d = tid & 63, r0 = (tid >> 6) * 8; const int gc = 256 + h * 64 + d;
      conv_tile<8>(PB, NB_B, row0, lo, hi, cw + gc, 512, cb + gc, gc, r0, 8, [&](int r, float v) { Kt[d * LP + r] = f2bf(v * 0.125f); }); }
    {
      const int j = tid >> 3, e0 = (tid & 7) * 16; const bf16_t* src = PB + (size_t)(row0 + j) * NB_B + 512 + h * 128 + e0;
      const bf16x8 a = *(const bf16x8*)src, b = *(const bf16x8*)(src + 8);
#pragma unroll
      for (int i = 0; i < 8; ++i) { Vt[(e0 + i) * LP + j] = (bf16_t)a[i]; Vt[(e0 + 8 + i) * LP + j] = (bf16_t)b[i]; } }
    if (wave < 2) { const int dir = wave; const bf16_t* gr = PB + (size_t)(row0 + lane) * NB_B + 1536;
      const float ig = bf2f(gr[(2 * dir) * 4 + h]) + gb[(2 * dir) * 4 + h];
      const float lf = log_sigmoid(bf2f(gr[(2 * dir + 1) * 4 + h]) + gb[(2 * dir + 1) * 4 + h]);
      const float g = wave_scan_sum(lf, lane, dir); const float g_end = wave_sum(lf);
      const float ls = g_end - g + ig; const float m_loc = wave_max(ls);
      wsv[dir * 64 + lane] = __expf(ls - m_loc);
      if (lane == 0) { const int ch = h * 2 + dir, s = scan_idx(tc, dir); MSC[(0 * 8 + ch) * NCH + s] = g_end; MSC[(1 * 8 + ch) * NCH + s] = m_loc; } }
    __syncthreads();
    for (int dir = 0; dir < 2; ++dir) {
      const int ch = h * 2 + dir, s = scan_idx(tc, dir); bf16_t* urow = UC + ((size_t)ch * NCH + s) * MLROW;
      { const int d = tid >> 3, j0 = (tid & 7) * 8; float sum = 0.f;
#pragma unroll
        for (int i = 0; i < 8; ++i) { const bf16_t v = f2bf(bf2f(Kt[d * LP + j0 + i]) * wsv[dir * 64 + j0 + i]); Kts[d * LP + j0 + i] = v; sum += bf2f(v); }
        sum += __shfl_xor(sum, 1); sum += __shfl_xor(sum, 2); sum += __shfl_xor(sum, 4);
        if ((tid & 7) == 0) urow[8192 + d] = f2bf(sum); }
      __syncthreads();
#pragma unroll
      for (int dt = 0; dt < 4; ++dt) { f32x4 acc = {0.f, 0.f, 0.f, 0.f};
        acc = mm16(Vt + wave * 16 * LP, LP, Kts + dt * 16 * LP, LP, 64, acc, lane);
#pragma unroll
        for (int r = 0; r < 4; ++r) urow[(wave * 16 + (lane >> 4) * 4 + r) * 64 + dt * 16 + (lane & 15)] = f2bf(acc[r]); }
      __syncthreads();
    }
  }
}
DI void phase_ml_s2(const Params& p) {
  const bf16_t* __restrict__ UC = (const bf16_t*)(p.ws + WS_BIG + BG_UC); bf16_t* __restrict__ SC = (bf16_t*)(p.ws + WS_BIG + BG_SC);
  float* MSC = (float*)(p.ws + WS_BIG + BG_MSC);
  const int npairs = 8 * (MLROW / 2);
  for (int e = blockIdx.x * 512 + tidx(); e < npairs; e += gridDim.x * 512) {
    const int ch = e / (MLROW / 2), off = (e % (MLROW / 2)) * 2;
    const float* GE = MSC + (0 * 8 + ch) * NCH; const float* ML = MSC + (1 * 8 + ch) * NCH; float* MS = MSC + (2 * 8 + ch) * NCH;
    float m = 0.f, c0 = 0.f, c1 = 0.f;
    for (int s0 = 0; s0 < NCH; s0 += 13) {
      unsigned u[13];
#pragma unroll
      for (int q = 0; q < 13; ++q) u[q] = *(const unsigned*)(UC + ((size_t)ch * NCH + s0 + q) * MLROW + off);
      float gev[13], mlv[13];
#pragma unroll
      for (int q = 0; q < 13; ++q) { gev[q] = GE[s0 + q]; mlv[q] = ML[s0 + q]; }
#pragma unroll
      for (int q = 0; q < 13; ++q) { const int s = s0 + q;
        *(unsigned*)(SC + ((size_t)ch * NCH + s) * MLROW + off) = cvtpk(c0, c1);
        if (off == 0) MS[s] = m;
        const float ge = gev[q], ml = mlv[q]; const float mn = fmaxf(ge + m, ml); const float dec = __expf(ge + m - mn), sc = __expf(ml - mn);
        c0 = dec * c0 + sc * bflo(u[q]); c1 = dec * c1 + sc * bfhi(u[q]); m = mn; }
    }
  }
}
DI void phase_ml_s3(const Params& p, int l, unsigned char* lds, int ntc) {
  const int tid = tidx(), wave = tid >> 6, lane = tid & 63;
  const bf16_t* PB = (const bf16_t*)(p.ws + WS_BIG + BG_PB);
  const bf16_t* SC = (const bf16_t*)(p.ws + WS_BIG + BG_SC); const float* MSC = (const float*)(p.ws + WS_BIG + BG_MSC);
  bf16_t* OUT = (bf16_t*)(p.ws + WS_BR) + (size_t)1 * T * 512;
  bf16_t* Q = (bf16_t*)lds;
  bf16_t* Kk = Q + 64 * LP;
  bf16_t* W = Kk + 64 * LP;
  bf16_t* Vt = W + 64 * LP;
  bf16_t* Ct = Vt + 128 * LP;
  float* fa = (float*)(Ct + 128 * LP);
  float* gS = fa;
  float* bS = fa + 128;
  float* mjS = fa + 256;
  float* aiS = fa + 384;
  float* rdS = fa + 448;
  float* nS = fa + 512;
  float* ssS = fa + 576;
  const float* cw = p.in[9] + (size_t)l * 5 * 512; const float* cb = p.in[10] + l * 512; const float* gb = p.in[11] + l * 16;
  const float* nw = p.in[12] + l * 512;
  const int js = wave >> 1, eh = wave & 1;
  for (int item = blockIdx.x; item < 4 * ntc; item += gridDim.x) {
    const int h = item & 3, tc = item >> 2, row0 = chunk_row0(tc); int lo, hi; stream_bounds(row0, lo, hi);
    __syncthreads();
    { const int c = tid & 127, r0 = (tid >> 7) * 16; const int gc = (c < 64) ? h * 64 + c : 256 + h * 64 + (c - 64);
      bf16_t* dst = (c < 64) ? Q + c : Kk + (c - 64); const float scl = (c < 64) ? 1.f : 0.125f;
      conv_tile<16>(PB, NB_B, row0, lo, hi, cw + gc, 512, cb + gc, gc, r0, 16, [&](int r, float v) { dst[r * LP] = f2bf(v * scl); }); }
    { const int j = tid >> 3, e0 = (tid & 7) * 16; const bf16_t* src = PB + (size_t)(row0 + j) * NB_B + 512 + h * 128 + e0;
      const bf16x8 a = *(const bf16x8*)src, b = *(const bf16x8*)(src + 8);
#pragma unroll
      for (int i = 0; i < 8; ++i) { Vt[(e0 + i) * LP + j] = (bf16_t)a[i]; Vt[(e0 + 8 + i) * LP + j] = (bf16_t)b[i]; } }
    float mdir[2];
#pragma unroll
    for (int dir = 0; dir < 2; ++dir) mdir[dir] = MSC[(2 * 8 + h * 2 + dir) * NCH + scan_idx(tc, dir)];
    if (wave < 2) { const int dir = wave; const bf16_t* gr = PB + (size_t)(row0 + lane) * NB_B + 1536;
      const float ig = bf2f(gr[(2 * dir) * 4 + h]) + gb[(2 * dir) * 4 + h];
      const float lf = log_sigmoid(bf2f(gr[(2 * dir + 1) * 4 + h]) + gb[(2 * dir + 1) * 4 + h]);
      const float g = wave_scan_sum(lf, lane, dir); const float b = ig - g; const float bm = wave_scan_max(b, lane, dir);
      gS[dir * 64 + lane] = g; bS[dir * 64 + lane] = b; mjS[dir * 64 + lane] = g + fmaxf(dir ? mdir[1] : mdir[0], bm); }
    f32x4 hs[4];
#pragma unroll
    for (int t = 0; t < 4; ++t) hs[t] = (f32x4){0.f, 0.f, 0.f, 0.f};
#pragma unroll
    for (int dir = 0; dir < 2; ++dir) {
      const int ch = h * 2 + dir, s = scan_idx(tc, dir); const bf16_t* srow = SC + ((size_t)ch * NCH + s) * MLROW; const float m = mdir[dir];
      __syncthreads();
      for (int i = tid; i < 1024; i += 512) { const int e = i >> 3, d0 = (i & 7) * 8; *(bf16x8*)(Ct + e * LP + d0) = *(const bf16x8*)(srow + e * 64 + d0); }
      if (tid < 64) { nS[tid] = bf2f(srow[8192 + tid]); aiS[tid] = __expf(gS[dir * 64 + tid] + m - mjS[dir * 64 + tid]); }
#pragma unroll
      for (int tt = 0; tt < 2; ++tt) { const int it = eh * 2 + tt; f32x4 acc = {0.f, 0.f, 0.f, 0.f};
        acc = mm16(Q + js * 16 * LP, LP, Kk + it * 16 * LP, LP, 64, acc, lane);
        const int i = it * 16 + (lane & 15); const float bi = bS[dir * 64 + i];
#pragma unroll
        for (int r = 0; r < 4; ++r) { const int j = js * 16 + (lane >> 4) * 4 + r; const bool ok = dir ? (i >= j) : (i <= j);
          const float wv = ok ? __expf(gS[dir * 64 + j] + bi - mjS[dir * 64 + j]) * acc[r] : 0.f; W[j * LP + i] = f2bf(wv); } }
      __syncthreads();
      { const int j = tid >> 3, i0 = (tid & 7) * 8; float sw = 0.f, sq = 0.f;
#pragma unroll
        for (int i = 0; i < 8; ++i) { sw += bf2f(W[j * LP + i0 + i]); sq += bf2f(Q[j * LP + i0 + i]) * nS[i0 + i]; }
        sw += __shfl_xor(sw, 1); sw += __shfl_xor(sw, 2); sw += __shfl_xor(sw, 4); sq += __shfl_xor(sq, 1); sq += __shfl_xor(sq, 2); sq += __shfl_xor(sq, 4);
        if ((tid & 7) == 0) { const float den = sw + aiS[j] * sq; rdS[j] = 1.f / fmaxf(fabsf(den), __expf(-mjS[dir * 64 + j])); } }
      __syncthreads();
#pragma unroll
      for (int t = 0; t < 4; ++t) { const int et = eh * 4 + t; f32x4 a1 = {0.f, 0.f, 0.f, 0.f}, a2 = {0.f, 0.f, 0.f, 0.f};
        a1 = mm16(W + js * 16 * LP, LP, Vt + et * 16 * LP, LP, 64, a1, lane);
        a2 = mm16(Q + js * 16 * LP, LP, Ct + et * 16 * LP, LP, 64, a2, lane);
#pragma unroll
        for (int r = 0; r < 4; ++r) { const int j = js * 16 + (lane >> 4) * 4 + r; hs[t][r] += (a1[r] + aiS[j] * a2[r]) * rdS[j]; } }
    }
    { float ssq[4] = {0.f, 0.f, 0.f, 0.f};
#pragma unroll
      for (int t = 0; t < 4; ++t)
#pragma unroll
        for (int r = 0; r < 4; ++r) ssq[r] += hs[t][r] * hs[t][r];
#pragma unroll
      for (int r = 0; r < 4; ++r) { float s = ssq[r]; s += __shfl_xor(s, 1); s += __shfl_xor(s, 2); s += __shfl_xor(s, 4); s += __shfl_xor(s, 8);
        if ((lane & 15) == 0) ssS[(js * 16 + (lane >> 4) * 4 + r) * 2 + eh] = s; }
      __syncthreads();
#pragma unroll
      for (int r = 0; r < 4; ++r) { const int j = js * 16 + (lane >> 4) * 4 + r; const float rs = 1.f / sqrtf((ssS[j * 2] + ssS[j * 2 + 1]) * (1.f / 128.f) + EPS);
        const size_t row = (size_t)(row0 + j);
#pragma unroll
        for (int t = 0; t < 4; ++t) { const int e = (eh * 4 + t) * 16 + (lane & 15); const float og = sigmoidf(bf2f(PB[row * NB_B + 1024 + h * 128 + e]));
          OUT[row * 512 + h * 128 + e] = f2bf(hs[t][r] * rs * nw[h * 128 + e] * og); } }
    }
  }
}

DI float softplusf(float x) { return fmaxf(x, 0.f) + log1pf(__expf(-fabsf(x))); }
struct SsdLds { bf16_t* Xt; bf16_t* Cm; bf16_t* Bm; bf16_t* Bmt; bf16_t* Sc; bf16_t* Hs; float* CB; float* sS; float* dtS; float* seS; float* ssS; };
DI SsdLds ssd_lds(unsigned char* lds) {
  SsdLds L; L.Xt = (bf16_t*)lds;
  L.Cm = L.Xt + 4 * 64 * LP;
  L.Bm = L.Cm + 64 * LP;
  L.Bmt = L.Bm + 64 * LP;
  L.Sc = L.Bmt + 64 * LP;
  L.Hs = L.Sc + 64 * LP;
  L.CB = (float*)(L.Hs + 64 * LP);
  L.sS = L.CB + 64 * 65;
  L.dtS = L.sS + 512;
  L.seS = L.dtS + 512;
  L.ssS = L.seS + 8;
  return L;
}
DI void ssd_load(const Params& p, int l, int g, int tc, const SsdLds& L) {
  const int tid = tidx(), wave = tid >> 6, lane = tid & 63;
  const bf16_t* PD = (const bf16_t*)(p.ws + WS_BIG + BG_PD);
  const float* cw = p.in[17] + (size_t)l * 5 * 768; const float* cb = p.in[18] + l * 768;
  const int row0 = chunk_row0(tc); int lo, hi; stream_bounds(row0, lo, hi);
  for (int u = tid; u < 384 * 4; u += 512) { const int c = u % 384, r0 = (u / 384) * 16;
    if (c < 256) { const int gc = g * 256 + c; bf16_t* dst = L.Xt + c * LP;
      conv_tile<16>(PD, NB_D, row0, lo, hi, cw + gc, 768, cb + gc, 512 + gc, r0, 16, [&](int r, float v) { dst[r] = f2bf(v); }); }
    else if (c < 320) { const int n = c - 256, gc = 512 + g * 64 + n;
      conv_tile<16>(PD, NB_D, row0, lo, hi, cw + gc, 768, cb + gc, 512 + gc, r0, 16, [&](int r, float v) { const bf16_t b = f2bf(v); L.Bm[r * LP + n] = b; L.Bmt[n * LP + r] = b; }); }
    else { const int n = c - 320, gc = 640 + g * 64 + n;
      conv_tile<16>(PD, NB_D, row0, lo, hi, cw + gc, 768, cb + gc, 512 + gc, r0, 16, [&](int r, float v) { L.Cm[r * LP + n] = f2bf(v); }); } }
  { const int hh = wave >> 1, dir = wave & 1, h = g * 4 + hh;
    const float dtb = p.in[19][l * 16 + dir * 8 + h], am = -__expf(p.in[20][l * 16 + dir * 8 + h]);
    const float dt = softplusf(bf2f(PD[(size_t)(row0 + lane) * NB_D + 1280 + dir * 8 + h]) + dtb); const float a = dt * am;
    const float s = wave_scan_sum(a, lane, dir); const float se = wave_sum(a);
    L.sS[wave * 64 + lane] = s; L.dtS[wave * 64 + lane] = dt; if (lane == 0) L.seS[wave] = se; }
}
DI bf16x8 pack8(const float (&v)[8]) { u32x4 w; w.x = cvtpk(v[0], v[1]); w.y = cvtpk(v[2], v[3]); w.z = cvtpk(v[4], v[5]); w.w = cvtpk(v[6], v[7]); return __builtin_bit_cast(bf16x8, w); }
DI void unpack8(const bf16x8 b, float (&v)[8]) { const u32x4 w = __builtin_bit_cast(u32x4, b); v[0] = bflo(w.x); v[1] = bfhi(w.x); v[2] = bflo(w.y); v[3] = bfhi(w.y); v[4] = bflo(w.z); v[5] = bfhi(w.z); v[6] = bflo(w.w); v[7] = bfhi(w.w); }
DI void phase_ssd_s1(const Params& p, int l, unsigned char* lds) {
  const int tid = tidx(), wave = tid >> 6, lane = tid & 63, l15 = lane & 15, lq = lane >> 4;
  const SsdLds L = ssd_lds(lds);
  bf16_t* UH = (bf16_t*)(p.ws + WS_BIG + BG_UH); float* DE = (float*)(p.ws + WS_BIG + BG_DE);
  for (int item = blockIdx.x; item < 2 * NCH; item += gridDim.x) {
    const int g = item & 1, tc = item >> 1;
    __syncthreads();
    ssd_load(p, l, g, tc, L);
    __syncthreads();
    const int hd = wave, hh = hd >> 1, dir = hd & 1, h = g * 4 + hh, ch = h * 2 + dir, s = scan_idx(tc, dir);
    const float se = L.seS[hd];
    if (lane == 0) DE[ch * NCH + s] = __expf(se);
    float cf[2][8];
#pragma unroll
    for (int ks = 0; ks < 2; ++ks)
#pragma unroll
      for (int e = 0; e < 8; ++e) { const int i = ks * 32 + 8 * lq + e; cf[ks][e] = __expf(se - L.sS[hd * 64 + i]) * L.dtS[hd * 64 + i]; }
    bf16x8 bfr[4][2];
#pragma unroll
    for (int nt = 0; nt < 4; ++nt)
#pragma unroll
      for (int ks = 0; ks < 2; ++ks) { float v[8]; unpack8(*(const bf16x8*)(L.Bmt + (nt * 16 + l15) * LP + ks * 32 + 8 * lq), v);
#pragma unroll
        for (int e = 0; e < 8; ++e) v[e] *= cf[ks][e];
        bfr[nt][ks] = pack8(v); }
    bf16_t* urow = UH + ((size_t)ch * NCH + s) * 4096;
#pragma unroll
    for (int pt = 0; pt < 4; ++pt) { const bf16_t* ap = L.Xt + (hh * 64 + pt * 16 + l15) * LP + 8 * lq;
      const bf16x8 a0 = *(const bf16x8*)ap, a1 = *(const bf16x8*)(ap + 32);
#pragma unroll
      for (int nt = 0; nt < 4; ++nt) { f32x4 acc = {0.f, 0.f, 0.f, 0.f};
        acc = __builtin_amdgcn_mfma_f32_16x16x32_bf16(a0, bfr[nt][0], acc, 0, 0, 0);
        acc = __builtin_amdgcn_mfma_f32_16x16x32_bf16(a1, bfr[nt][1], acc, 0, 0, 0);
#pragma unroll
        for (int r = 0; r < 4; ++r) urow[(pt * 16 + lq * 4 + r) * 64 + nt * 16 + l15] = f2bf(acc[r]); } }
  }
}
DI void phase_ssd_s2(const Params& p) {
  const bf16_t* __restrict__ UH = (const bf16_t*)(p.ws + WS_BIG + BG_UH); bf16_t* __restrict__ SH = (bf16_t*)(p.ws + WS_BIG + BG_SH);
  const float* DE = (const float*)(p.ws + WS_BIG + BG_DE);
  const int npairs = 16 * 2048;
  for (int e = blockIdx.x * 512 + tidx(); e < npairs; e += gridDim.x * 512) {
    const int ch = e >> 11, off = (e & 2047) * 2; float c0 = 0.f, c1 = 0.f;
    for (int s0 = 0; s0 < NCH; s0 += 13) {
      unsigned u[13];
#pragma unroll
      for (int q = 0; q < 13; ++q) u[q] = *(const unsigned*)(UH + ((size_t)ch * NCH + s0 + q) * 4096 + off);
      float dev[13];
#pragma unroll
      for (int q = 0; q < 13; ++q) dev[q] = DE[ch * NCH + s0 + q];
#pragma unroll
      for (int q = 0; q < 13; ++q) { const int s = s0 + q;
        *(unsigned*)(SH + ((size_t)ch * NCH + s) * 4096 + off) = cvtpk(c0, c1);
        const float dec = dev[q]; c0 = dec * c0 + bflo(u[q]); c1 = dec * c1 + bfhi(u[q]); }
    }
  }
}
DI void phase_ssd_s3(const Params& p, int l, unsigned char* lds, int ntc) {
  const int tid = tidx(), wave = tid >> 6, lane = tid & 63, l15 = lane & 15, lq = lane >> 4;
  const SsdLds L = ssd_lds(lds);
  const bf16_t* PD = (const bf16_t*)(p.ws + WS_BIG + BG_PD);
  const bf16_t* SH = (const bf16_t*)(p.ws + WS_BIG + BG_SH);
  bf16_t* OUT = (bf16_t*)(p.ws + WS_BR) + (size_t)3 * T * 512;
  const float* dsk = p.in[21] + l * 8; const float* nw = p.in[22] + l * 512;
  float* ssq4 = L.CB + 64 * 65;
  ssq4 = L.ssS + 128;
  const int hh = wave >> 1, jh = wave & 1;
  for (int item = blockIdx.x; item < 2 * ntc; item += gridDim.x) {
    const int g = item & 1, tc = item >> 1, row0 = chunk_row0(tc), h = g * 4 + hh;
    __syncthreads();
    ssd_load(p, l, g, tc, L);
    __syncthreads();
#pragma unroll
    for (int tt = 0; tt < 2; ++tt) { const int t = wave * 2 + tt, jt = t >> 2, it = t & 3; f32x4 acc = {0.f, 0.f, 0.f, 0.f};
      acc = mm16(L.Cm + jt * 16 * LP, LP, L.Bm + it * 16 * LP, LP, 64, acc, lane);
#pragma unroll
      for (int r = 0; r < 4; ++r) L.CB[(jt * 16 + lq * 4 + r) * 65 + it * 16 + l15] = acc[r]; }
    __syncthreads();
    const float dk = dsk[h];
#pragma unroll 1
    for (int jl = 0; jl < 2; ++jl) { const int jt = jh * 2 + jl, j = jt * 16 + l15;
      f32x4 ys[4];
#pragma unroll
      for (int b = 0; b < 4; ++b) ys[b] = (f32x4){0.f, 0.f, 0.f, 0.f};
#pragma unroll 1
      for (int dir = 0; dir < 2; ++dir) { const int hd = hh * 2 + dir, ch = h * 2 + dir, s = scan_idx(tc, dir);
        const bf16_t* srow = SH + ((size_t)ch * NCH + s) * 4096;
        const float sj = L.sS[hd * 64 + j];
        bf16x8 asc[2], acm[2];
#pragma unroll
        for (int ks = 0; ks < 2; ++ks) { float v[8];
#pragma unroll
          for (int e = 0; e < 8; ++e) { const int ii = ks * 32 + 8 * lq + e; const bool ok = dir ? (ii >= j) : (ii <= j);
            v[e] = ok ? __expf(sj - L.sS[hd * 64 + ii]) * L.CB[j * 65 + ii] * L.dtS[hd * 64 + ii] : 0.f; }
          asc[ks] = pack8(v); acm[ks] = *(const bf16x8*)(L.Cm + j * LP + ks * 32 + 8 * lq); }
        float ej[4];
#pragma unroll
        for (int r = 0; r < 4; ++r) ej[r] = __expf(L.sS[hd * 64 + jt * 16 + lq * 4 + r]);
#pragma unroll
        for (int pt = 0; pt < 4; ++pt) { const bf16_t* xp = L.Xt + (hh * 64 + pt * 16 + l15) * LP + 8 * lq;
          const bf16_t* hp = srow + (pt * 16 + l15) * 64 + 8 * lq;
          f32x4 a1 = {0.f, 0.f, 0.f, 0.f}, a2 = {0.f, 0.f, 0.f, 0.f};
          a1 = __builtin_amdgcn_mfma_f32_16x16x32_bf16(asc[0], *(const bf16x8*)xp, a1, 0, 0, 0);
          a1 = __builtin_amdgcn_mfma_f32_16x16x32_bf16(asc[1], *(const bf16x8*)(xp + 32), a1, 0, 0, 0);
          a2 = __builtin_amdgcn_mfma_f32_16x16x32_bf16(acm[0], *(const bf16x8*)hp, a2, 0, 0, 0);
          a2 = __builtin_amdgcn_mfma_f32_16x16x32_bf16(acm[1], *(const bf16x8*)(hp + 32), a2, 0, 0, 0);
#pragma unroll
          for (int r = 0; r < 4; ++r) ys[pt][r] += a1[r] + ej[r] * a2[r]; }
      }
#pragma unroll
      for (int r = 0; r < 4; ++r) { const int jr = jt * 16 + lq * 4 + r; float sq = 0.f;
#pragma unroll
        for (int pt = 0; pt < 4; ++pt) { const int pp = pt * 16 + l15;
          const float z = bf2f(PD[(size_t)(row0 + jr) * NB_D + h * 64 + pp]);
          const float v = (ys[pt][r] + dk * bf2f(L.Xt[(hh * 64 + pp) * LP + jr])) * siluf(z);
          const bf16_t vb = f2bf(v); const float vr = bf2f(vb); sq += vr * vr;
          OUT[(size_t)(row0 + jr) * 512 + g * 256 + hh * 64 + pp] = vb; }
        sq += __shfl_xor(sq, 1); sq += __shfl_xor(sq, 2); sq += __shfl_xor(sq, 4); sq += __shfl_xor(sq, 8);
        if (l15 == 0) ssq4[jr * 4 + hh] = sq; }
    }
    __syncthreads();
#pragma unroll 1
    for (int jl = 0; jl < 2; ++jl)
#pragma unroll
      for (int r = 0; r < 4; ++r) { const int jr = (jh * 2 + jl) * 16 + lq * 4 + r;
        const float tot = (ssq4[jr * 4 + 0] + ssq4[jr * 4 + 1]) + (ssq4[jr * 4 + 2] + ssq4[jr * 4 + 3]);
        const float rs = 1.f / sqrtf(tot * (1.f / 256.f) + EPS);
#pragma unroll
        for (int pt = 0; pt < 4; ++pt) { const int c = g * 256 + hh * 64 + pt * 16 + l15;
          bf16_t* op = OUT + (size_t)(row0 + jr) * 512 + c; *op = f2bf(bf2f(*op) * rs * nw[c]); } }
  }
}

extern __shared__ __attribute__((aligned(16))) unsigned char dyn_lds[];

#define XB_TMO      128
#define XB_XCNT(j)  (256  + 64 * (j))
#define XB_XSUB(j)  (1280 + 64 * (j))
#define XB_XGEN(j)  (2304 + 64 * (j))
#define XB_TOP      3328
#define XB_TOPGEN   3392
#define XCD_BAR_WORDS 3456
#define XB_SPIN_CAP (1u << 18)
DI unsigned xb_ld(unsigned* p)              { return __hip_atomic_load(p, __ATOMIC_RELAXED, __HIP_MEMORY_SCOPE_AGENT); }
DI unsigned xb_add(unsigned* p, unsigned v) { return __hip_atomic_fetch_add(p, v, __ATOMIC_RELAXED, __HIP_MEMORY_SCOPE_AGENT); }
DI unsigned xb_xcc_id() { return (unsigned)__builtin_amdgcn_s_getreg((3 << 11) | 20) & 0xFu; }
#define XB_SPIN(cond, bar) do { unsigned _sp = 0; while (cond) { __builtin_amdgcn_s_sleep(1); \
    if ((++_sp & 255u) == 0u) { if (xb_ld(&(bar)[XB_TMO])) break; if (_sp > XB_SPIN_CAP) { atomicAdd(&(bar)[XB_TMO], 1u); break; } } } } while (0)
DI void xcd_barrier_complete(unsigned* bar, unsigned x, unsigned& nloc, unsigned& nx) {
  const unsigned G = gridDim.x;
  unsigned sum, cnt, mine, sp = 0u;
  for (;;) {
    sum = 0u; cnt = 0u; mine = 0u;
#pragma unroll
    for (unsigned j = 0; j < 16; ++j) { const unsigned c = xb_ld(&bar[XB_XCNT(j)]); sum += c; cnt += (c > 0u) ? 1u : 0u; mine = (j == x) ? c : mine; }
    if (sum == G) break;
    __builtin_amdgcn_s_sleep(1);
    if ((++sp & 255u) == 0u) { if (xb_ld(&bar[XB_TMO])) break; if (sp > XB_SPIN_CAP) { atomicAdd(&bar[XB_TMO], 1u); break; } }
  }
  nloc = mine > 0u ? mine : 1u; nx = cnt > 0u ? cnt : 1u;
}
DI void xcd_barrier(unsigned* bar, volatile LAS unsigned* st) {
  asm volatile("s_waitcnt vmcnt(0)" ::: "memory");
  __syncthreads();
  if (tidx() == 0) {
    const unsigned x = xb_xcc_id();
    __builtin_amdgcn_s_waitcnt(0);
    unsigned nloc = st[0], nx = st[1];
    if (nloc == 0u) { xcd_barrier_complete(bar, x, nloc, nx); st[0] = nloc; st[1] = nx; }
    const unsigned old = xb_add(&bar[XB_XSUB(x)], 1u);
    const unsigned gen = old / nloc;
    if (old + 1u == (gen + 1u) * nloc) {
      __builtin_amdgcn_fence(__ATOMIC_RELEASE, "agent");
      asm volatile("s_waitcnt vmcnt(0)" ::: "memory");
      const unsigned og = xb_add(&bar[XB_TOP], 1u);
      const unsigned tg = og / nx;
      if (og + 1u == (tg + 1u) * nx) xb_add(&bar[XB_TOPGEN], 1u);
      else XB_SPIN(xb_ld(&bar[XB_TOPGEN]) == tg, bar);
      __builtin_amdgcn_fence(__ATOMIC_ACQUIRE, "agent");
      xb_add(&bar[XB_XGEN(x)], 1u);
      asm volatile("s_waitcnt vmcnt(0)" ::: "memory");
    } else {
      XB_SPIN(xb_ld(&bar[XB_XGEN(x)]) == gen, bar);
      __builtin_amdgcn_fence(__ATOMIC_ACQUIRE, "agent");
      asm volatile("s_waitcnt vmcnt(0)" ::: "memory");
    }
  }
  __syncthreads();
}

#ifndef REP_ATTN
#define REP_ATTN 1
#endif
#ifndef REP_SCAN
#define REP_SCAN 1
#endif
#ifndef DBG_STOP
#define DBG_STOP 0
#endif
DI void dbg_dump_br(const Params& p, int mode) {
  const bf16_t* BR = (const bf16_t*)(p.ws + WS_BR);
  for (size_t i = (size_t)blockIdx.x * 512 + tidx(); i < (size_t)TL * 1024; i += (size_t)gridDim.x * 512) {
    const size_t row = i >> 10; const int c = (int)(i & 1023), cc = c & 511, hf = c >> 9;
    float v = 0.f;
    if (mode == 0) v = bf2f(BR[((size_t)(hf * 2) * T + row) * 512 + cc]) + bf2f(BR[((size_t)(hf * 2 + 1) * T + row) * 512 + cc]);
    else if (mode == 1) v = bf2f(BR[((size_t)(hf ? 3 : 1) * T + row) * 512 + cc]);
    else if (mode == 2) v = bf2f(BR[((size_t)(hf ? 2 : 0) * T + row) * 512 + cc]);
    p.out[i] = v;
  }
}

DI void dbg_dump_raw(const Params& p, size_t byte_off, size_t cnt = (size_t)TL * 1024) {
  const bf16_t* src = (const bf16_t*)(p.ws + WS_BIG + byte_off);
  for (size_t i = (size_t)blockIdx.x * 512 + tidx(); i < (size_t)TL * 1024; i += (size_t)gridDim.x * 512) p.out[i] = i < cnt ? bf2f(src[i]) : 0.f;
}
typedef const __attribute__((address_space(4))) Params* KP;
DI const Params* launder(KP kp) { asm volatile("" : "+s"(kp)); return (const Params*)kp; }
#define PL (*launder(kp))
DI void gsync_(KP kp) { xcd_barrier((unsigned*)(PL.ws + WS_BAR), (volatile LAS unsigned*)((LAS unsigned char*)dyn_lds + LDS_PHASE)); }
#define gsync(g) gsync_(kp)
template <int l>
DI bool layer_fwd(KP kp, cg::grid_group& grid) {
  unsigned char* lds = dyn_lds; LAS unsigned char* ldsl = (LAS unsigned char*)dyn_lds;
  const int c = blockIdx.x, G = gridDim.x;
  unsigned char* ws = PL.ws;
  const float* MOD = (const float*)(ws + WS_MOD);
  bf16_t* H = (bf16_t*)(ws + WS_H); float* XC = (float*)(ws + WS_XC);
  const bf16_t* WA = (const bf16_t*)(ws + WS_WA); unsigned char* WB = ws + WS_WB; unsigned char* BIG = ws + WS_BIG;
    const float* mod_l = MOD + (size_t)(l * 2 + 0) * 6144; const float* mod_c = MOD + (size_t)(l * 2 + 1) * 6144;
    const float* xin_l = (l == 0) ? PL.in[0] : PL.out; const float* xin_c = (l == 0) ? PL.in[2] : XC;
    const int Mm = (l == 0) ? T : TL;
    const int ntc = (l == 0) ? NCH : 256;
    { pg8::Sched S{(const char*)H, (size_t)D * 2, (const char*)WA + WA_B, 1024, T / 256, NB_B / 256, G, c};
      pg8::EpiStore E{(bf16_t*)(BIG + BG_PB), NB_B, NB_B}; pg8::gemm_phase(ldsl, S, E); }
    gsync(grid);
    if (DBG_STOP == 7 && l == 0) { dbg_dump_raw(PL, BG_PB); return true; }
    if (DBG_STOP == 8 && l == 0) { dbg_dump_raw(PL, BG_PB + (size_t)TL * 1024 * 2, (size_t)T * NB_B - (size_t)TL * 1024); return true; }
    for (int rep = 0; rep < REP_SCAN; ++rep) {
    phase_ml_s1(PL, l, lds);
    gsync(grid);
    if (DBG_STOP == 4 && l == 0) { dbg_dump_raw(PL, BG_UC); return true; }
    phase_ml_s2(PL);
    convert_layer_rest(PL, l, lds, (8 * (MLROW / 2) + 511) / 512);
    gsync(grid);
    if (DBG_STOP == 5 && l == 0) { dbg_dump_raw(PL, BG_SC); return true; }
    phase_ml_s3(PL, l, lds, ntc);
    gsync(grid);
    }
    if (DBG_STOP == 6 && l == 0) { dbg_dump_br(PL, 1); return true; }
    { pg8::Sched S{(const char*)H, (size_t)D * 2, (const char*)WA + WA_D, 1024, T / 256, NB_D / 256, G, c};
      pg8::EpiStore E{(bf16_t*)(BIG + BG_PD), NB_D, NB_D}; pg8::gemm_phase(ldsl, S, E); }
    gsync(grid);
    for (int rep = 0; rep < REP_SCAN; ++rep) {
    phase_ssd_s1(PL, l, lds);
    gsync(grid);
    phase_ssd_s2(PL);
    gsync(grid);
    phase_ssd_s3(PL, l, lds, ntc);
    gsync(grid);
    }
    { pg8::Sched S{(const char*)H, (size_t)D * 2, (const char*)WA + WA_AC, 1024, T / 256, NB_AC / 256, G, c};
      pg8::EpiStore E{(bf16_t*)(BIG + BG_PAC), NB_AC, NB_AC}; pg8::gemm_phase(ldsl, S, E); }
    gsync(grid);
    phase_attn_prep(PL, l);
    for (int k = 0; k < 4; ++k) transpose_job(PL.in[23] + ((size_t)l * 4 + k) * 1024 * 1024, 1024, 1024, 1024, 1024, (bf16_t*)(ws + WS_WA) + (size_t)k * 1024 * 1024, lds);
    gsync(grid);
    { pg8::Sched S{(const char*)(BIG + BG_PAC) + 1536 * 2, (size_t)NB_AC * 2, (const char*)WB + WB_UQ, 384, T / 256, 2, G, c};
      pg8::EpiStore E{(bf16_t*)(BIG + BG_QUP), 384, 384}; pg8::gemm_phase(ldsl, S, E); }
    { pg8::Sched S{(const char*)(BIG + BG_PAC) + 1920 * 2, (size_t)NB_AC * 2, (const char*)WB + WB_UKV, 256, T / 256, 3, G, c};
      pg8::EpiStore E{(bf16_t*)(BIG + BG_KVUP), 768, 768}; pg8::gemm_phase(ldsl, S, E); }
    gsync(grid);
    for (int rep = 0; rep < REP_ATTN; ++rep) { phase_attention(PL, l, (char*)lds);
    gsync(grid); }
    if (DBG_STOP == 1 && l == 0) { dbg_dump_br(PL, 0); return true; }
    if (DBG_STOP == 2 && l == 0) { dbg_dump_br(PL, 1); return true; }
    if (DBG_STOP == 3 && l == 0) { dbg_dump_br(PL, 2); return true; }
    { pg8::Sched S{(const char*)H, (size_t)D * 2, (const char*)WA, 1024, Mm / 256, 16, G, c};
      pg8::EpiAct<0> E{(bf16_t*)BIG, 4096, PL.in[24] + (size_t)l * 4096}; pg8::gemm_phase(ldsl, S, E); }
    gsync(grid);
    { pg8::HSched S{(const char*)(ws + WS_BR), (size_t)512 * 2, (size_t)T * 512 * 2, (const char*)WB + WB_BR, (size_t)1024 * 512 * 2, 512, Mm / 256, 4, G, c};
      pg8::EpiHorner E{(const bf16_t*)BIG, H}; pg8::gemm_phase(ldsl, S, E); }
    transpose_job(PL.in[29] + (size_t)l * 1024 * 4096, 4096, 1024, 4096, 4096, (bf16_t*)(ws + WS_WA), lds);
    gsync(grid);
    { pg8::Sched S{(const char*)H, (size_t)D * 2, (const char*)WB + WB_WO, 1024, TL / 256, 4, G, c};
      pg8::EpiResid E{xin_l, xin_c, PL.out, XC, mod_l + 2048, mod_c + 2048, nullptr}; pg8::gemm_phase(ldsl, S, E); }
    if (l == 0) {
      pg8::KSched S{(const char*)(H + (size_t)TL * D), (size_t)D * 2, (const char*)WB + WB_WO, 1024, 256, 4, 4, G, (c + G / 2) % G};
      pg8::EpiAtomic E{(float*)(ws + WS_ACC)}; pg8::gemm_phase(ldsl, S, E); }
    gsync(grid);
    if (l == 0) phase_ln_affine_mod(PL.out, XC, PL.in[27] + l * 1024, PL.in[28] + l * 1024, mod_l, mod_c, 3072, 4096, H, Mm, PL.in[2], (const float*)(ws + WS_ACC), mod_c + 2048, nullptr);
    else phase_ln_affine_mod(PL.out, XC, PL.in[27] + l * 1024, PL.in[28] + l * 1024, mod_l, mod_c, 3072, 4096, H, Mm);
    transpose_job(PL.in[31] + (size_t)l * 4096 * 1024, 1024, 4096, 1024, 1024, (bf16_t*)WB, lds);
    gsync(grid);
    { pg8::Sched S{(const char*)H, (size_t)D * 2, (const char*)WA, 1024, Mm / 256, 16, G, c};
      pg8::EpiAct<1> E{(bf16_t*)BIG, 4096, PL.in[30] + (size_t)l * 4096}; pg8::gemm_phase(ldsl, S, E); }
    gsync(grid);
    { pg8::Sched S{(const char*)BIG, (size_t)4096 * 2, (const char*)WB, 4096, TL / 256, 4, G, c};
      pg8::EpiResid E{PL.out, XC, PL.out, XC, mod_l + 5120, mod_c + 5120, PL.in[32] + l * 1024}; pg8::gemm_phase(ldsl, S, E); }
    if (l == 0) {
      pg8::KSched S{(const char*)BIG + (size_t)TL * 4096 * 2, (size_t)4096 * 2, (const char*)WB, 4096, 1024, 4, 4, G, (c + G / 2) % G};
      pg8::EpiAtomic E{(float*)(ws + WS_ACC) + (size_t)TC * D}; pg8::gemm_phase(ldsl, S, E); }
    gsync(grid);
    if (l == 0) {
      const float* m1l = MOD + (size_t)(2 + 0) * 6144; const float* m1c = MOD + (size_t)(2 + 1) * 6144;
      phase_ln_affine_mod(PL.out, XC, PL.in[33], PL.in[34], m1l, m1c, 0, 1024, H, T, XC, (const float*)(ws + WS_ACC) + (size_t)TC * D, mod_c + 5120, PL.in[32]);
      convert_layer_start(PL, 1, lds);
      gsync(grid);
    } else {
      phase_ln_affine_mod(PL.out, XC, PL.in[33] + 1024, PL.in[34] + 1024, mod_l, mod_c, 0, 1024, nullptr, TL);
    }
  return false;
}
__global__ void __launch_bounds__(512) fwd_megakernel(Params p_unused) {
  cg::grid_group grid = cg::this_grid();
  unsigned char* lds = dyn_lds;
  KP kp = (KP)__builtin_amdgcn_kernarg_segment_ptr();
  { volatile LAS unsigned* st = (volatile LAS unsigned*)((LAS unsigned char*)dyn_lds + LDS_PHASE);
    if (tidx() == 0) { st[0] = 0u; st[1] = 0u; (void)xb_add((unsigned*)(PL.ws + WS_BAR) + XB_XCNT(xb_xcc_id()), 1u); }
    __syncthreads();
    if (PL.out == nullptr) grid.sync(); }
  phase_setup(PL, lds);
  __syncthreads();
  convert_layer_start(PL, 0, lds);
  gsync(grid);
  { const Params& p = PL; const float* MOD = (const float*)(p.ws + WS_MOD);
    phase_ln_mod(p.in[0], p.in[2], MOD + 0 * 6144, MOD + 1 * 6144, 0, 1024, (bf16_t*)(p.ws + WS_H), T); }
  gsync(grid);
  if (layer_fwd<0>(kp, grid)) return;
  layer_fwd<1>(kp, grid);
}

extern "C" void kernel_launch(void* const* d_in, const int* in_sizes, int n_in, void* d_out, int out_size, void* d_ws, size_t ws_size, hipStream_t stream) {
  static int grid_blocks = 0;
  if (grid_blocks == 0) {
    if (n_in != 35 || out_size != TL * D || ws_size < WS_END) { fprintf(stderr, "kernel_launch: unexpected shapes: n_in %d out %d ws %zu (need %zu)\n", n_in, out_size, ws_size, (size_t)WS_END); grid_blocks = -1; return; }
    int dev = 0, cus = 0, per_cu = 0;
    (void)hipGetDevice(&dev);
    (void)hipDeviceGetAttribute(&cus, hipDeviceAttributeMultiprocessorCount, dev);
    (void)hipFuncSetAttribute((const void*)fwd_megakernel, hipFuncAttributeMaxDynamicSharedMemorySize, LDS_BYTES);
    (void)hipOccupancyMaxActiveBlocksPerMultiprocessor(&per_cu, (const void*)fwd_megakernel, 512, LDS_BYTES);
    if (per_cu < 1) per_cu = 1;
    grid_blocks = cus * 1;
    fprintf(stderr, "kernel_launch: grid %d (cus %d, occupancy %d), ws %zu need %zu\n", grid_blocks, cus, per_cu, ws_size, (size_t)WS_END);
  }
  if (grid_blocks < 0) return;
  Params p{};
  for (int i = 0; i < 35; ++i) p.in[i] = (const float*)d_in[i];
  p.out = (float*)d_out; p.ws = (unsigned char*)d_ws;
  (void)hipMemsetAsync((unsigned char*)d_ws + WS_BAR, 0, XCD_BAR_WORDS * 4, stream);
  void* args[] = {&p};
  hipError_t e = hipLaunchCooperativeKernel((void*)fwd_megakernel, dim3(grid_blocks), dim3(512), args, LDS_BYTES, stream);
  if (e != hipSuccess) fprintf(stderr, "cooperative launch failed: %s (grid %d)\n", hipGetErrorString(e), grid_blocks);
}
```

```cpp
#include <hip/hip_runtime.h>
#include <hip/hip_cooperative_groups.h>
#include <cstdio>
#include <cstdint>
namespace cg = cooperative_groups;
#define DI __device__ __forceinline__
#define LAS __attribute__((address_space(3)))
typedef unsigned short bf16_t;
typedef short bf16x8 __attribute__((ext_vector_type(8)));
typedef short s16x4 __attribute__((ext_vector_type(4)));
typedef float f32x4 __attribute__((ext_vector_type(4)));
typedef float f32x16 __attribute__((ext_vector_type(16)));
typedef unsigned u32x4 __attribute__((ext_vector_type(4)));
typedef unsigned u32x2 __attribute__((ext_vector_type(2)));

constexpr int TL = 16384, TC = 256, T = TL + TC, D = 1024, FF = 4096;
constexpr int NCH = T / 64;
constexpr float ALPHA = 1.4142135623730951f;
constexpr float EPS = 1e-6f;
constexpr int NB_B = 1792, NB_D = 1536, NB_AC = 2304;
constexpr int LDS_PHASE = 156672;
constexpr int LDS_BYTES = LDS_PHASE + 16;
constexpr int MLROW = 8192 + 64;

constexpr size_t al256(size_t x) { return (x + 255) / 256 * 256; }
constexpr size_t WS_TAB32 = 0;
constexpr size_t WS_TAB16 = WS_TAB32 + 256 * 16 * 2 * 4;
constexpr size_t WS_LAM = WS_TAB16 + 256 * 8 * 2 * 4;
constexpr size_t WS_MOD = WS_LAM + 256;
constexpr size_t WS_BAR = al256(WS_MOD + 2 * 2 * 6144 * 4);
constexpr size_t WS_XC = al256(WS_BAR + 16384);
constexpr size_t WS_ACC = al256(WS_XC + (size_t)TC * D * 4);
constexpr size_t WS_WA = al256(WS_ACC + (size_t)2 * TC * D * 4);
constexpr size_t WS_WB = al256(WS_WA + (size_t)5632 * 1024 * 2);
constexpr size_t WS_H = al256(WS_WB + (size_t)4096 * 1024 * 2);
constexpr size_t WS_BR = al256(WS_H + (size_t)T * D * 2);
constexpr size_t WS_BIG = al256(WS_BR + (size_t)4 * T * 512 * 2);
constexpr size_t BIG_BYTES = (size_t)T * 4096 * 2;
constexpr size_t WS_END = WS_BIG + BIG_BYTES;
constexpr size_t BG_PB = 0;
constexpr size_t BG_UC = al256(BG_PB + (size_t)T * NB_B * 2);
constexpr size_t BG_SC = al256(BG_UC + (size_t)8 * NCH * MLROW * 2);
constexpr size_t BG_MSC = al256(BG_SC + (size_t)8 * NCH * MLROW * 2);
constexpr size_t BG_ML_END = BG_MSC + 3 * 8 * NCH * 4;
static_assert(BG_ML_END <= BIG_BYTES, "mlstm overlay");
constexpr size_t BG_PD = 0;
constexpr size_t BG_UH = al256(BG_PD + (size_t)T * NB_D * 2);
constexpr size_t BG_SH = al256(BG_UH + (size_t)16 * NCH * 4096 * 2);
constexpr size_t BG_DE = al256(BG_SH + (size_t)16 * NCH * 4096 * 2);
constexpr size_t BG_SSD_END = BG_DE + 16 * NCH * 4;
static_assert(BG_SSD_END <= BIG_BYTES, "ssd overlay");
constexpr size_t BG_PAC = 0;
constexpr size_t BG_QUP = al256(BG_PAC + (size_t)T * NB_AC * 2);
constexpr size_t BG_KVUP = al256(BG_QUP + (size_t)T * 384 * 2);
static_assert(BG_KVUP + (size_t)T * 768 * 2 <= BIG_BYTES, "attn overlay");
constexpr size_t WB_UQ = 0, WB_UKV = 512 * 384 * 2, WB_BR = WB_UKV + 768 * 256 * 2, WB_WO = WB_BR + (size_t)4 * 1024 * 512 * 2;
static_assert(WB_WO + 1024 * 1024 * 2 <= (size_t)4096 * 1024 * 2, "slot B");
constexpr size_t WA_B = 0, WA_D = (size_t)NB_B * 1024 * 2, WA_AC = WA_D + (size_t)NB_D * 1024 * 2;

struct Params { const float* in[35]; float* out; unsigned char* ws; };

typedef __bf16 bf16x2_t __attribute__((ext_vector_type(2)));
typedef float f32x2_t __attribute__((ext_vector_type(2)));
DI unsigned cvtpk(float lo, float hi) { f32x2_t v = {lo, hi}; bf16x2_t b = __builtin_convertvector(v, bf16x2_t); return __builtin_bit_cast(unsigned, b); }
DI bf16_t f2bf(float x) { return (bf16_t)(cvtpk(x, 0.f) & 0xffffu); }
DI float bf2f(bf16_t v) { return __uint_as_float((unsigned)v << 16); }
DI float bflo(unsigned w) { return __uint_as_float(w << 16); }
DI float bfhi(unsigned w) { return __uint_as_float(w & 0xffff0000u); }
DI float wave_sum(float v) {
#pragma unroll
  for (int o = 1; o < 64; o <<= 1) v += __shfl_xor(v, o);
  return v;
}
DI float wave_max(float v) {
#pragma unroll
  for (int o = 1; o < 64; o <<= 1) v = fmaxf(v, __shfl_xor(v, o));
  return v;
}
DI float sigmoidf(float x) { return __builtin_amdgcn_rcpf(1.f + __expf(-x)); }
DI float siluf(float x) { return x / (1.f + __expf(-x)); }
DI int tidx() { int t = (int)__builtin_amdgcn_workitem_id_x(); asm volatile("" : "+v"(t)); return t; }
#define LDS_WAIT() asm volatile("s_waitcnt lgkmcnt(0)" ::: "memory")

namespace pg8 {
constexpr int BM = 256, BK = 64, HALF = 128, HTB = HALF * BK * 2, STAGE_BYTES = 8 * HTB, NXCD = 8, WGM = 8;
DI int lds_byte(int r, int c) { const int st = (r >> 4) * 2 + (c >> 5), rr = r & 15, cc = c & 31, ob = rr * 64 + cc * 2; return st * 1024 + (ob ^ (((ob >> 9) & 1) << 5)); }
DI void stage_rc(int b, int& R, int& C) { const int st = b / 1024, sb = b % 1024, swz = sb ^ (((sb >> 9) & 1) << 5); R = (st >> 1) * 16 + swz / 64; C = (st & 1) * 32 + (swz % 64) / 2; }
DI int perm32(int rho) { const int n = rho >> 4, i = rho & 15; return 8 * (i >> 2) + 4 * n + (i & 3); }
struct Unit { int pm, pn, k; };
DI void tile_order(int L, int nM, int nN, int& pm, int& pn) {
  const int nwg = nM * nN; int wgid = L;
  { const int q = nwg / NXCD, r = nwg % NXCD, xcd = wgid % NXCD, off = wgid / NXCD; wgid = (xcd < r ? xcd * (q + 1) : r * (q + 1) + (xcd - r) * q) + off; }
  const int nig = WGM * nN, gid = wgid / nig, fm = gid * WGM, gsz = (nM - fm) < WGM ? (nM - fm) : WGM;
  pm = fm + ((wgid % nig) % gsz); pn = (wgid % nig) / gsz;
}
struct Sched {
  const char* A; size_t lda_b; const char* Bt; int K; int nM, nN, G, c;
  DI bool next(int i, Unit& u) const { const long L = (long)i * G + c; if (L >= (long)nM * nN) return false; tile_order((int)L, nM, nN, u.pm, u.pn); u.k = 0; return true; }
  DI const char* a_ptr(const Unit& u) const { return A + (size_t)u.pm * BM * lda_b; }
  DI const char* b_ptr(const Unit& u) const { return Bt + (size_t)u.pn * BM * K * 2; }
  DI int ldb_e() const { return K; }
};
struct HSched {
  const char* A; size_t lda_b; size_t a_ks; const char* Bt; size_t b_ks; int K; int nM, nN, G, c;
  DI bool next(int i, Unit& u) const { const long L = (long)(i >> 2) * G + c; if (L >= (long)nM * nN) return false; tile_order((int)L, nM, nN, u.pm, u.pn); u.k = i & 3; return true; }
  DI const char* a_ptr(const Unit& u) const { return A + (size_t)u.k * a_ks + (size_t)u.pm * BM * lda_b; }
  DI const char* b_ptr(const Unit& u) const { return Bt + (size_t)u.k * b_ks + (size_t)u.pn * BM * K * 2; }
  DI int ldb_e() const { return K; }
};
struct KSched {
  const char* A; size_t lda_b; const char* Bt; int ldb; int K; int nks, nN, G, c;
  DI bool next(int i, Unit& u) const { const long L = (long)i * G + c; if (L >= (long)nN * nks) return false; u.pm = 0; u.pn = (int)(L % nN); u.k = (int)(L / nN); return true; }
  DI const char* a_ptr(const Unit& u) const { return A + (size_t)u.k * K * 2; }
  DI const char* b_ptr(const Unit& u) const { return Bt + ((size_t)u.pn * BM * ldb + (size_t)u.k * K) * 2; }
  DI int ldb_e() const { return ldb; }
};

template <class Epi, class SchedT>
DI void gemm_phase(LAS unsigned char* lds, const SchedT& S, const Epi& E) {
  const int tid = tidx(), wid = __builtin_amdgcn_readfirstlane(tid >> 6), lane = tid & 63, wr = wid >> 2, wc = wid & 3, fr = lane & 15, fq = lane >> 4;
  const int K = S.K, nt = K / BK, ldb = S.ldb_e();
  unsigned voffA[2], voffB[2];
#pragma unroll
  for (int i = 0; i < 2; ++i) { int R, C; stage_rc(tid * 16 + i * 8192, R, C); const int Rb = Epi::PERM ? ((R & ~31) + perm32(R & 31)) : R;
    voffA[i] = (unsigned)(R * (int)S.lda_b + C * 2); voffB[i] = (unsigned)(Rb * ldb + C) * 2u; }
  const size_t kstep = (size_t)(BK * 2);
  const size_t hsA = (size_t)HALF * S.lda_b, hsB = (size_t)HALF * ldb * 2;
  const unsigned ldsw = (unsigned)wid * 1024u;
  const int aoff = lds_byte(wr * 64 + fr, fq * 8), boff = lds_byte(wc * 32 + fr, fq * 8);
#define PG8_SA(b, h) (((b) * 2 + (h)) * HTB)
#define PG8_SB(b, h) ((4 + (b) * 2 + (h)) * HTB)
#define PG8_STAGE(bufoff, gbase, voff) do { _Pragma("unroll") for (int _i = 0; _i < 2; ++_i) \
    __builtin_amdgcn_global_load_lds((const unsigned*)((const char*)(gbase) + (voff)[_i]), (LAS unsigned*)(lds + (bufoff) + ldsw + _i * 8192), 16, 0, 0); } while (0)
#define PG8_LDA(dst, b, h) do { _Pragma("unroll") for (int m = 0; m < 4; ++m) _Pragma("unroll") for (int k = 0; k < 2; ++k) dst[m][k] = *(const LAS bf16x8*)(lds + PG8_SA(b, h) + aoff + m * 2048 + k * 1024); } while (0)
#define PG8_LDB(dst, b, h) do { _Pragma("unroll") for (int n = 0; n < 2; ++n) _Pragma("unroll") for (int k = 0; k < 2; ++k) dst[n][k] = *(const LAS bf16x8*)(lds + PG8_SB(b, h) + boff + n * 2048 + k * 1024); } while (0)
#define PG8_MMA(ai, bj, At, Bt) do { __builtin_amdgcn_s_setprio(1); _Pragma("unroll") for (int m = 0; m < 4; ++m) _Pragma("unroll") for (int n = 0; n < 2; ++n) _Pragma("unroll") for (int k = 0; k < 2; ++k) \
    acc[ai][bj][m][n] = __builtin_amdgcn_mfma_f32_16x16x32_bf16(Bt[n][k], At[m][k], acc[ai][bj][m][n], 0, 0, 0); __builtin_amdgcn_s_setprio(0); } while (0)
#define PG8_WAIT_V(n) asm volatile("s_waitcnt vmcnt(" #n ")" ::: "memory")
#define PG8_WAIT_L(n) asm volatile("s_waitcnt lgkmcnt(" #n ")" ::: "memory")
#define PG8_BAR __builtin_amdgcn_s_barrier()
#define PG8_SCHED __builtin_amdgcn_sched_barrier(0)
  Unit cur, nxt; int ui = 0;
  if (!S.next(0, cur)) return;
  f32x4 acc[2][2][4][2];
#pragma unroll
  for (int a = 0; a < 2; ++a)
#pragma unroll
    for (int b = 0; b < 2; ++b)
#pragma unroll
      for (int m = 0; m < 4; ++m)
#pragma unroll
        for (int n = 0; n < 2; ++n) acc[a][b][m][n] = (f32x4){0.f, 0.f, 0.f, 0.f};
  bf16x8 At[4][2], B0[2][2], B1[2][2];
  const char* cA = S.a_ptr(cur); const char* cB = S.b_ptr(cur);
  PG8_STAGE(PG8_SB(0, 0), cB, voffB); PG8_STAGE(PG8_SA(0, 0), cA, voffA); PG8_STAGE(PG8_SB(0, 1), cB + hsB, voffB); PG8_STAGE(PG8_SA(0, 1), cA + hsA, voffA);
  if (wr == 1) PG8_BAR;
  PG8_WAIT_V(4); PG8_BAR;
  PG8_STAGE(PG8_SB(1, 0), cB + kstep, voffB); PG8_STAGE(PG8_SA(1, 0), cA + kstep, voffA); PG8_STAGE(PG8_SB(1, 1), cB + hsB + kstep, voffB);
  PG8_WAIT_V(6); PG8_BAR;
  for (;;) {
    const bool has_next = S.next(ui + 1, nxt);
    const char* nA = has_next ? S.a_ptr(nxt) : cA; const char* nB = has_next ? S.b_ptr(nxt) : cB;
    for (int t = 0; t < nt; t += 2) {
      const bool last = (t == nt - 2);
      const char* a1 = cA + (size_t)(t + 1) * kstep;
      const char* a2 = last ? nA : cA + (size_t)(t + 2) * kstep; const char* b2 = last ? nB : cB + (size_t)(t + 2) * kstep;
      const char* a3 = a2 + kstep; const char* b3 = b2 + kstep;
      PG8_LDB(B0, 0, 0); PG8_SCHED; PG8_LDA(At, 0, 0); PG8_STAGE(PG8_SA(1, 1), a1 + hsA, voffA);
      PG8_WAIT_L(8); PG8_BAR; PG8_WAIT_L(0); PG8_MMA(0, 0, At, B0); PG8_BAR; PG8_SCHED;
      PG8_LDB(B1, 0, 1); PG8_STAGE(PG8_SB(0, 0), b2, voffB);
      PG8_BAR; PG8_WAIT_L(0); PG8_MMA(0, 1, At, B1); PG8_BAR;
      PG8_LDA(At, 0, 1); PG8_STAGE(PG8_SA(0, 0), a2, voffA);
      PG8_BAR; PG8_WAIT_L(0); PG8_MMA(1, 0, At, B0); PG8_BAR; PG8_SCHED;
      PG8_STAGE(PG8_SB(0, 1), b2 + hsB, voffB);
      PG8_WAIT_V(6); PG8_BAR; PG8_MMA(1, 1, At, B1); PG8_BAR;
      PG8_LDB(B0, 1, 0); PG8_SCHED; PG8_LDA(At, 1, 0); PG8_STAGE(PG8_SA(0, 1), a2 + hsA, voffA);
      PG8_WAIT_L(8); PG8_BAR; PG8_WAIT_L(0); PG8_MMA(0, 0, At, B0); PG8_BAR; PG8_SCHED;
      PG8_LDB(B1, 1, 1); PG8_STAGE(PG8_SB(1, 0), b3, voffB);
      PG8_BAR; PG8_WAIT_L(0); PG8_MMA(0, 1, At, B1); PG8_BAR;
      PG8_LDA(At, 1, 1); PG8_STAGE(PG8_SA(1, 0), a3, voffA);
      PG8_BAR; PG8_WAIT_L(0); PG8_MMA(1, 0, At, B0); PG8_BAR; PG8_SCHED;
      PG8_STAGE(PG8_SB(1, 1), b3 + hsB, voffB);
      PG8_WAIT_V(6); PG8_BAR; PG8_MMA(1, 1, At, B1); PG8_BAR;
    }
    const bool zero = E(acc, cur, wr, wc, fr, fq);
    if (zero) {
#pragma unroll
      for (int a = 0; a < 2; ++a)
#pragma unroll
        for (int b = 0; b < 2; ++b)
#pragma unroll
          for (int m = 0; m < 4; ++m)
#pragma unroll
            for (int n = 0; n < 2; ++n) acc[a][b][m][n] = (f32x4){0.f, 0.f, 0.f, 0.f};
    }
    if (!has_next) break;
    cur = nxt; cA = nA; cB = nB; ++ui;
  }
  PG8_WAIT_V(0);
  if (wr == 0) PG8_BAR;
  PG8_BAR;
#undef PG8_SA
#undef PG8_SB
#undef PG8_STAGE
#undef PG8_LDA
#undef PG8_LDB
#undef PG8_MMA
#undef PG8_WAIT_V
#undef PG8_WAIT_L
#undef PG8_BAR
#undef PG8_SCHED
}

typedef f32x4 Acc[2][2][4][2];
struct EpiStore {
  static constexpr bool PERM = true;
  bf16_t* O; int ldc; int ncols;
  DI bool operator()(Acc& acc, const Unit& u, int wr, int wc, int fr, int fq) const {
    const int row0 = u.pm * BM + wr * 64 + fr, col0 = u.pn * BM + wc * 32 + 8 * fq;
#pragma unroll
    for (int ai = 0; ai < 2; ++ai)
#pragma unroll
      for (int m = 0; m < 4; ++m) { bf16_t* rowp = O + (size_t)(row0 + ai * HALF + m * 16) * ldc;
#pragma unroll
        for (int bj = 0; bj < 2; ++bj) { const int col = col0 + bj * HALF; const f32x4 v0 = acc[ai][bj][m][0], v1 = acc[ai][bj][m][1];
          u32x4 w; w.x = cvtpk(v0[0], v0[1]); w.y = cvtpk(v0[2], v0[3]); w.z = cvtpk(v1[0], v1[1]); w.w = cvtpk(v1[2], v1[3]);
          if (col < ncols) *(u32x4*)(rowp + col) = w; } }
    return true;
  }
};
template <int ACT> struct EpiAct {
  static constexpr bool PERM = true;
  bf16_t* O; int ldc; const float* bias;
  DI bool operator()(Acc& acc, const Unit& u, int wr, int wc, int fr, int fq) const {
    const int row0 = u.pm * BM + wr * 64 + fr, col0 = u.pn * BM + wc * 32 + 8 * fq;
    f32x4 bv[2][2];
#pragma unroll
    for (int bj = 0; bj < 2; ++bj)
#pragma unroll
      for (int n = 0; n < 2; ++n) bv[bj][n] = *(const f32x4*)(bias + col0 + bj * HALF + 4 * n);
#pragma unroll
    for (int ai = 0; ai < 2; ++ai)
#pragma unroll
      for (int m = 0; m < 4; ++m) { bf16_t* rowp = O + (size_t)(row0 + ai * HALF + m * 16) * ldc + col0;
#pragma unroll
        for (int bj = 0; bj < 2; ++bj) { f32x4 v0 = acc[ai][bj][m][0] + bv[bj][0], v1 = acc[ai][bj][m][1] + bv[bj][1];
#pragma unroll
          for (int j = 0; j < 4; ++j) {
            if (ACT == 0) { v0[j] = sigmoidf(v0[j]); v1[j] = sigmoidf(v1[j]); }
            else { const float a = fmaxf(v0[j], 0.f), b = fmaxf(v1[j], 0.f); v0[j] = a * a; v1[j] = b * b; } }
          u32x4 w; w.x = cvtpk(v0[0], v0[1]); w.y = cvtpk(v0[2], v0[3]); w.z = cvtpk(v1[0], v1[1]); w.w = cvtpk(v1[2], v1[3]);
          *(u32x4*)(rowp + bj * HALF) = w; } }
    return true;
  }
};
struct EpiHorner {
  static constexpr bool PERM = true;
  const bf16_t* G; bf16_t* Z;
  DI bool operator()(Acc& acc, const Unit& u, int wr, int wc, int fr, int fq) const {
    const int row0 = u.pm * BM + wr * 64 + fr, col0 = u.pn * BM + wc * 32 + 8 * fq, k = u.k;
#pragma unroll
    for (int ai = 0; ai < 2; ++ai)
#pragma unroll
      for (int m = 0; m < 4; ++m) { const size_t row = (size_t)(row0 + ai * HALF + m * 16);
#pragma unroll
        for (int bj = 0; bj < 2; ++bj) { const int col = col0 + bj * HALF;
          const u32x4 s0 = *(const u32x4*)(G + row * 4096 + k * 1024 + col);
          float f[8] = {bflo(s0.x), bfhi(s0.x), bflo(s0.y), bfhi(s0.y), bflo(s0.z), bfhi(s0.z), bflo(s0.w), bfhi(s0.w)};
          if (k < 3) { const u32x4 s1 = *(const u32x4*)(G + row * 4096 + (k + 1) * 1024 + col);
            const float d[8] = {bflo(s1.x), bfhi(s1.x), bflo(s1.y), bfhi(s1.y), bflo(s1.z), bfhi(s1.z), bflo(s1.w), bfhi(s1.w)};
#pragma unroll
            for (int j = 0; j < 8; ++j) f[j] = f[j] * __builtin_amdgcn_rcpf(d[j]); }
          f32x4 v0 = acc[ai][bj][m][0], v1 = acc[ai][bj][m][1];
#pragma unroll
          for (int j = 0; j < 4; ++j) { v0[j] *= f[j]; v1[j] *= f[4 + j]; }
          acc[ai][bj][m][0] = v0; acc[ai][bj][m][1] = v1;
          if (k == 3) { u32x4 w; w.x = cvtpk(v0[0], v0[1]); w.y = cvtpk(v0[2], v0[3]); w.z = cvtpk(v1[0], v1[1]); w.w = cvtpk(v1[2], v1[3]);
            *(u32x4*)(Z + row * 1024 + col) = w; } } }
    return k == 3;
  }
};
struct EpiResid {
  static constexpr bool PERM = false;
  const float* xin_l; const float* xin_c; float* out_l; float* out_c; const float* g_l; const float* g_c; const float* bias;
  DI bool operator()(Acc& acc, const Unit& u, int wr, int wc, int fr, int fq) const {
    const bool isc = u.pm >= TL / BM;
    const float* xin = isc ? xin_c - (size_t)TL * D : xin_l; float* out = isc ? out_c - (size_t)TL * D : out_l; const float* g = isc ? g_c : g_l;
    const int row0 = u.pm * BM + wr * 64 + fr, col0 = u.pn * BM + wc * 32 + 4 * fq;
    f32x4 gv[2][2], bv[2][2];
#pragma unroll
    for (int bj = 0; bj < 2; ++bj)
#pragma unroll
      for (int n = 0; n < 2; ++n) { gv[bj][n] = *(const f32x4*)(g + col0 + bj * HALF + n * 16); bv[bj][n] = bias ? *(const f32x4*)(bias + col0 + bj * HALF + n * 16) : (f32x4){0.f, 0.f, 0.f, 0.f}; }
#pragma unroll
    for (int ai = 0; ai < 2; ++ai)
#pragma unroll
      for (int m = 0; m < 4; ++m) { const size_t off = (size_t)(row0 + ai * HALF + m * 16) * D + col0;
#pragma unroll
        for (int bj = 0; bj < 2; ++bj)
#pragma unroll
          for (int n = 0; n < 2; ++n) { const f32x4 xv = *(const f32x4*)(xin + off + bj * HALF + n * 16);
            *(f32x4*)(out + off + bj * HALF + n * 16) = xv * ALPHA + gv[bj][n] * (acc[ai][bj][m][n] + bv[bj][n]); } }
    return true;
  }
};
struct EpiAtomic {
  static constexpr bool PERM = false;
  float* ACC;
  DI bool operator()(Acc& acc, const Unit& u, int wr, int wc, int fr, int fq) const {
    const int row0 = wr * 64 + fr, col0 = u.pn * BM + wc * 32 + 4 * fq;
#pragma unroll
    for (int ai = 0; ai < 2; ++ai)
#pragma unroll
      for (int m = 0; m < 4; ++m) { float* rp = ACC + (size_t)(row0 + ai * HALF + m * 16) * D + col0;
#pragma unroll
        for (int bj = 0; bj < 2; ++bj)
#pragma unroll
          for (int n = 0; n < 2; ++n)
#pragma unroll
            for (int e = 0; e < 4; ++e) (void)__hip_atomic_fetch_add(rp + bj * HALF + n * 16 + e, acc[ai][bj][m][n][e], __ATOMIC_RELAXED, __HIP_MEMORY_SCOPE_AGENT); }
    return true;
  }
};
}

namespace att {
constexpr int QBLK = 32, KVBLK = 64;
constexpr float THR = 8.f;
constexpr size_t SHM_V = KVBLK * 128 * 2;
constexpr size_t OFF_K = 3 * SHM_V, OFF_WS = OFF_K + 3 * 64 * 208, OFF_O1 = OFF_WS + 8 * 64 * 4;
static_assert(OFF_O1 + 65536 <= LDS_PHASE, "attn lds");
#define SBAR() __builtin_amdgcn_sched_barrier(0)
DI int crow(int r, int hi) { return (r & 3) + 8 * (r >> 2) + 4 * hi; }
DI bf16x8 ld8(const bf16_t* p) { return *reinterpret_cast<const bf16x8*>(p); }

DI void partialSM(f32x16& p0, f32x16& p1, float& m_reg, float& mn, float& alpha, const float C, const float thr_raw) {
  float pmax = p0[0];
#pragma unroll
  for (int r = 1; r < 16; ++r) pmax = fmaxf(pmax, p0[r]);
#pragma unroll
  for (int r = 0; r < 16; ++r) pmax = fmaxf(pmax, p1[r]);
  { auto rr = __builtin_amdgcn_permlane32_swap(__float_as_uint(pmax), __float_as_uint(pmax), false, false);
    pmax = fmaxf(__uint_as_float(rr[0]), __uint_as_float(rr[1])); }
  if (__builtin_expect(__all(pmax - m_reg <= thr_raw), 1)) { mn = m_reg; alpha = 1.f; }
  else { mn = fmaxf(m_reg, pmax); alpha = __builtin_amdgcn_exp2f((m_reg - mn) * C); m_reg = mn; }
  const float mnC = -mn * C;
#pragma unroll
  for (int r = 0; r < 16; ++r) p0[r] = fmaf(p0[r], C, mnC);
#pragma unroll
  for (int r = 0; r < 16; ++r) p1[r] = fmaf(p1[r], C, mnC);
#pragma unroll
  for (int r = 0; r < 16; ++r) p0[r] = __builtin_amdgcn_exp2f(p0[r]);
}
DI void finishSM(f32x16& p0, f32x16& p1, float alpha, float& l_reg, bf16x8& pa0, bf16x8& pa1, bf16x8& pa2, bf16x8& pa3) {
#pragma unroll
  for (int r = 0; r < 16; ++r) p1[r] = __builtin_amdgcn_exp2f(p1[r]);
  float ps = 0;
#pragma unroll
  for (int r = 0; r < 16; ++r) ps += p0[r];
#pragma unroll
  for (int r = 0; r < 16; ++r) ps += p1[r];
  { auto rr = __builtin_amdgcn_permlane32_swap(__float_as_uint(ps), __float_as_uint(ps), false, false);
    ps = __uint_as_float(rr[0]) + __uint_as_float(rr[1]); }
  l_reg = l_reg * alpha + ps;
#define PK4(P, BASE, OUT) do { unsigned a0 = cvtpk(P[BASE + 0], P[BASE + 1]), a1 = cvtpk(P[BASE + 2], P[BASE + 3]);   \
    unsigned b0 = cvtpk(P[BASE + 4], P[BASE + 5]), b1 = cvtpk(P[BASE + 6], P[BASE + 7]);                              \
    auto r0 = __builtin_amdgcn_permlane32_swap(a0, b0, false, false); auto r1 = __builtin_amdgcn_permlane32_swap(a1, b1, false, false); \
    u32x4 w = {r0[0], r1[0], r0[1], r1[1]}; OUT = *reinterpret_cast<bf16x8*>(&w); } while (0)
  PK4(p0, 0, pa0); PK4(p0, 8, pa1); PK4(p1, 0, pa2); PK4(p1, 8, pa3);
#undef PK4
}
template <int DQK>
DI void qkt(f32x16& p0, f32x16& p1, const char* Ks, const bf16x8* qr, int r32, int hi) {
  constexpr int KP = DQK * 2 + 16;
  p0 = f32x16{}; p1 = f32x16{};
#pragma unroll
  for (int d0 = 0; d0 < DQK / 16; ++d0) { const int cb = (d0 * 16 + hi * 8) * 2;
    bf16x8 b0 = *reinterpret_cast<const bf16x8*>(Ks + r32 * KP + cb);
    bf16x8 b1 = *reinterpret_cast<const bf16x8*>(Ks + (32 + r32) * KP + cb);
    p0 = __builtin_amdgcn_mfma_f32_32x32x16_bf16(b0, qr[d0], p0, 0, 0, 0);
    p1 = __builtin_amdgcn_mfma_f32_32x32x16_bf16(b1, qr[d0], p1, 0, 0, 0); }
}
DI int v_st(int k, int c) { const int kk = (k & ~0xC) | ((k & 4) << 1) | ((k & 8) >> 1); return ((kk >> 3) * 4 + (c >> 5)) * 512 + ((kk & 7) * 32 + (c & 31)) * 2; }
DI int v_rd_base(int lane) { return ((lane & 3) << 3) | (((lane >> 2) & 3) << 6) | (((lane >> 4) & 1) << 5) | (((lane >> 5) & 1) << 8); }
constexpr int v_rd_off(int d0, int ks, int half) { return d0 * 512 + ks * 4096 + half * 2048; }
template <int OFF> DI s16x4 tr_read(int vb) {
  s16x4 r; asm volatile("ds_read_b64_tr_b16 %0, %1 offset:%2" : "=&v"(r) : "v"(vb), "i"(OFF) : "memory"); return r;
}
template <int D0> DI void pv_one(f32x16& od, int vb, bf16x8 pa0, bf16x8 pa1, bf16x8 pa2, bf16x8 pa3) {
  const s16x4 l0 = tr_read<v_rd_off(D0, 0, 0)>(vb), h0 = tr_read<v_rd_off(D0, 0, 1)>(vb), l1 = tr_read<v_rd_off(D0, 1, 0)>(vb), h1 = tr_read<v_rd_off(D0, 1, 1)>(vb);
  const s16x4 l2 = tr_read<v_rd_off(D0, 2, 0)>(vb), h2 = tr_read<v_rd_off(D0, 2, 1)>(vb), l3 = tr_read<v_rd_off(D0, 3, 0)>(vb), h3 = tr_read<v_rd_off(D0, 3, 1)>(vb);
  asm volatile("s_waitcnt lgkmcnt(0)" ::: "memory"); SBAR();
#define PK(L, H) (bf16x8){L[0], L[1], L[2], L[3], H[0], H[1], H[2], H[3]}
  od = __builtin_amdgcn_mfma_f32_32x32x16_bf16(pa0, PK(l0, h0), od, 0, 0, 0);
  od = __builtin_amdgcn_mfma_f32_32x32x16_bf16(pa1, PK(l1, h1), od, 0, 0, 0);
  od = __builtin_amdgcn_mfma_f32_32x32x16_bf16(pa2, PK(l2, h2), od, 0, 0, 0);
  od = __builtin_amdgcn_mfma_f32_32x32x16_bf16(pa3, PK(l3, h3), od, 0, 0, 0);
#undef PK
}
template <int KS> DI void pv_step(f32x16* o, int vb, bf16x8 pa) {
  const s16x4 l0 = tr_read<v_rd_off(0, KS, 0)>(vb), h0 = tr_read<v_rd_off(0, KS, 1)>(vb), l1 = tr_read<v_rd_off(1, KS, 0)>(vb), h1 = tr_read<v_rd_off(1, KS, 1)>(vb);
  const s16x4 l2 = tr_read<v_rd_off(2, KS, 0)>(vb), h2 = tr_read<v_rd_off(2, KS, 1)>(vb), l3 = tr_read<v_rd_off(3, KS, 0)>(vb), h3 = tr_read<v_rd_off(3, KS, 1)>(vb);
  asm volatile("s_waitcnt lgkmcnt(0)" ::: "memory"); SBAR();
#define PK(L, H) (bf16x8){L[0], L[1], L[2], L[3], H[0], H[1], H[2], H[3]}
  o[0] = __builtin_amdgcn_mfma_f32_32x32x16_bf16(pa, PK(l0, h0), o[0], 0, 0, 0);
  o[1] = __builtin_amdgcn_mfma_f32_32x32x16_bf16(pa, PK(l1, h1), o[1], 0, 0, 0);
  o[2] = __builtin_amdgcn_mfma_f32_32x32x16_bf16(pa, PK(l2, h2), o[2], 0, 0, 0);
  o[3] = __builtin_amdgcn_mfma_f32_32x32x16_bf16(pa, PK(l3, h3), o[3], 0, 0, 0);
#undef PK
}
DI void pv_d0(f32x16* o, int vb, bf16x8 pa0, bf16x8 pa1, bf16x8 pa2, bf16x8 pa3) {
  pv_step<0>(o, vb, pa0); pv_step<1>(o, vb, pa1); pv_step<2>(o, vb, pa2); pv_step<3>(o, vb, pa3);
}

template <int DQK>
DI void attn_body(const bf16_t* __restrict__ Qb, int ldq, const bf16_t* __restrict__ K0, int ldk0, const bf16_t* __restrict__ K1, int ldk1,
                  const bf16_t* __restrict__ Vh, int ldv, int seq, float scale, char* lds, f32x16 (&o)[4], float (&rli)[16]) {
  constexpr int KP = DQK * 2 + 16, SHM_K = 64 * KP, CPR = DQK / 8;
  const float C = scale * 1.4426950408889634f, thr_raw = THR / scale;
  const int tid = tidx(), wid = tid >> 6, lane = tid & 63, r32 = lane & 31, hi = lane >> 5;
  char* V_lds = lds; char* K_lds = lds + OFF_K;
  float* wsl = (float*)(lds + OFF_WS) + wid * 64; float* li_l = wsl; float* al_l = wsl + 32;
  float m_reg = -1e30f, l_reg = 0; bf16x8 qr[DQK / 16];
#pragma unroll
  for (int d = 0; d < 4; ++d) o[d] = f32x16{};
  const bf16_t* Qw = Qb + (long)(wid * QBLK + r32) * ldq + hi * 8;
#pragma unroll
  for (int d0 = 0; d0 < DQK / 16; ++d0) qr[d0] = ld8(Qw + d0 * 16);
  const int sr = tid >> 4, sc = (tid & 15) * 8, vst0 = v_st(sr, sc), vst1 = v_st(32 + sr, sc);
  const int vb0 = (int)(uintptr_t)V_lds + v_rd_base(lane);
  const int kc0 = tid, kc1 = 512 + (tid & 255);
  const int kr0 = kc0 / CPR, kcc0 = kc0 % CPR, kr1 = (DQK == 96) ? kc1 / CPR : 0, kcc1 = (DQK == 96) ? kc1 % CPR : 0;
  const bf16_t* kp0 = (kcc0 < 8) ? K0 + (long)kr0 * ldk0 + kcc0 * 8 : K1 + (long)kr0 * ldk1 + (kcc0 - 8) * 8;
  const long kst0 = (kcc0 < 8) ? (long)64 * ldk0 : (long)64 * ldk1;
  const bf16_t* kp1 = (kcc1 < 8) ? K0 + (long)kr1 * ldk0 + kcc1 * 8 : K1 + (long)kr1 * ldk1 + (kcc1 - 8) * 8;
  const long kst1 = (kcc1 < 8) ? (long)64 * ldk0 : (long)64 * ldk1;
  const int kw0 = kr0 * KP + kcc0 * 16, kw1 = kr1 * KP + kcc1 * 16;
  struct { bf16x8 vs0, vs1, ks0, ks1; } sr_[2];
#define SLOAD(i, t) do { sr_[i].vs0 = ld8(&Vh[(long)((t) * 64 + sr) * ldv + sc]); sr_[i].vs1 = ld8(&Vh[(long)((t) * 64 + 32 + sr) * ldv + sc]); \
    sr_[i].ks0 = ld8(kp0 + (long)(t) * kst0); if (DQK == 96) sr_[i].ks1 = ld8(kp1 + (long)(t) * kst1); } while (0)
#define SWRITE(b, i) do { *(bf16x8*)(V_lds + (b) * SHM_V + vst0) = sr_[i].vs0; *(bf16x8*)(V_lds + (b) * SHM_V + vst1) = sr_[i].vs1; \
    *(bf16x8*)(K_lds + (b) * SHM_K + kw0) = sr_[i].ks0; if (DQK == 96) *(bf16x8*)(K_lds + (b) * SHM_K + kw1) = sr_[i].ks1; } while (0)
#define SWAIT() do { if (DQK == 96) asm volatile("s_waitcnt vmcnt(4)" ::: "memory"); else asm volatile("s_waitcnt vmcnt(3)" ::: "memory"); } while (0)
#define RESC(a) do { if (__any((a) < 1.f)) { if (hi == 0) al_l[r32] = (a); asm volatile("s_waitcnt lgkmcnt(0)" ::: "memory"); \
    _Pragma("unroll") for (int d = 0; d < 4; ++d) _Pragma("unroll") for (int r = 0; r < 16; ++r) o[d][r] *= al_l[crow(r, hi)]; } } while (0)
  f32x16 pA0, pA1, pB0, pB1; float mnA, mnB, alA, alB; bf16x8 pa0, pa1, pa2, pa3; const int NT = seq / KVBLK;
  constexpr int SE = 0, SO = 1;
  SLOAD(SE, 0); asm volatile("s_waitcnt vmcnt(0)" ::: "memory"); SWRITE(0, SE); __syncthreads();
  qkt<DQK>(pA0, pA1, K_lds, qr, r32, hi); partialSM(pA0, pA1, m_reg, mnA, alA, C, thr_raw);
  SLOAD(SO, 1); if (2 < NT) SLOAD(SE, 2);
  SWAIT(); SWRITE(1, SO); __syncthreads();
  int b = 1;
  for (int j = 1; j + 1 < NT; j += 2) {
    const int b1 = (b == 2) ? 0 : b + 1, b2 = (b == 0) ? 2 : b - 1;
    SBAR(); qkt<DQK>(pB0, pB1, K_lds + b * SHM_K, qr, r32, hi);
    finishSM(pA0, pA1, alA, l_reg, pa0, pa1, pa2, pa3); SBAR();
    SLOAD(SO, j + 2); SBAR();
    pv_d0(o, vb0 + b2 * (int)SHM_V, pa0, pa1, pa2, pa3); partialSM(pB0, pB1, m_reg, mnB, alB, C, thr_raw);
    SWAIT(); SWRITE(b1, SE);
    RESC(alB); __syncthreads();
    SBAR(); qkt<DQK>(pA0, pA1, K_lds + b1 * SHM_K, qr, r32, hi);
    finishSM(pB0, pB1, alB, l_reg, pa0, pa1, pa2, pa3); SBAR();
    if (j + 3 < NT) SLOAD(SE, j + 3); SBAR();
    pv_d0(o, vb0 + b * (int)SHM_V, pa0, pa1, pa2, pa3); partialSM(pA0, pA1, m_reg, mnA, alA, C, thr_raw);
    SWAIT(); SWRITE(b2, SO);
    RESC(alA); __syncthreads();
    b = b2;
  }
  { const int b2 = (b == 0) ? 2 : b - 1;
    SBAR(); qkt<DQK>(pB0, pB1, K_lds + b * SHM_K, qr, r32, hi);
    finishSM(pA0, pA1, alA, l_reg, pa0, pa1, pa2, pa3); SBAR();
    pv_d0(o, vb0 + b2 * (int)SHM_V, pa0, pa1, pa2, pa3); partialSM(pB0, pB1, m_reg, mnB, alB, C, thr_raw);
    RESC(alB);
    finishSM(pB0, pB1, alB, l_reg, pa0, pa1, pa2, pa3); SBAR();
    pv_d0(o, vb0 + b * (int)SHM_V, pa0, pa1, pa2, pa3); }
  if (hi == 0) li_l[r32] = l_reg; asm volatile("s_waitcnt lgkmcnt(0)" ::: "memory");
#pragma unroll
  for (int r = 0; r < 16; ++r) rli[r] = 1.f / li_l[crow(r, hi)];
  __syncthreads();
#undef SLOAD
#undef SWRITE
#undef SWAIT
#undef RESC
}

constexpr int D2_KT = 64 * 144, D2_KBUF = 2 * D2_KT, D2_OFF_K = 2 * (int)SHM_V, D2_OFF_Q = D2_OFF_K + 2 * D2_KBUF, D2_QM = 256 * 144, D2_OFF_WS = D2_OFF_Q + 2 * D2_QM;
static_assert(D2_OFF_WS + 8 * 512 <= LDS_PHASE, "diff2 lds");
DI void qkt_l(f32x16& p0, f32x16& p1, const char* Ks, const char* Qrow, int r32, int hi) {
  p0 = f32x16{}; p1 = f32x16{};
#pragma unroll
  for (int d0 = 0; d0 < 4; ++d0) { const int cb = (d0 * 16 + hi * 8) * 2;
    const bf16x8 qf = *reinterpret_cast<const bf16x8*>(Qrow + cb);
    const bf16x8 b0 = *reinterpret_cast<const bf16x8*>(Ks + r32 * 144 + cb);
    const bf16x8 b1 = *reinterpret_cast<const bf16x8*>(Ks + (32 + r32) * 144 + cb);
    p0 = __builtin_amdgcn_mfma_f32_32x32x16_bf16(b0, qf, p0, 0, 0, 0);
    p1 = __builtin_amdgcn_mfma_f32_32x32x16_bf16(b1, qf, p1, 0, 0, 0); }
}
template <int KS> DI void pv2_step(f32x16* o1, f32x16* o2, int vb, bf16x8 pa, bf16x8 pb) {
  const s16x4 l0 = tr_read<v_rd_off(0, KS, 0)>(vb), h0 = tr_read<v_rd_off(0, KS, 1)>(vb), l1 = tr_read<v_rd_off(1, KS, 0)>(vb), h1 = tr_read<v_rd_off(1, KS, 1)>(vb);
  const s16x4 l2 = tr_read<v_rd_off(2, KS, 0)>(vb), h2 = tr_read<v_rd_off(2, KS, 1)>(vb), l3 = tr_read<v_rd_off(3, KS, 0)>(vb), h3 = tr_read<v_rd_off(3, KS, 1)>(vb);
  asm volatile("s_waitcnt lgkmcnt(0)" ::: "memory"); SBAR();
#define PK(L, H) (bf16x8){L[0], L[1], L[2], L[3], H[0], H[1], H[2], H[3]}
  const bf16x8 v0 = PK(l0, h0), v1 = PK(l1, h1), v2 = PK(l2, h2), v3 = PK(l3, h3);
#undef PK
  o1[0] = __builtin_amdgcn_mfma_f32_32x32x16_bf16(pa, v0, o1[0], 0, 0, 0); o2[0] = __builtin_amdgcn_mfma_f32_32x32x16_bf16(pb, v0, o2[0], 0, 0, 0);
  o1[1] = __builtin_amdgcn_mfma_f32_32x32x16_bf16(pa, v1, o1[1], 0, 0, 0); o2[1] = __builtin_amdgcn_mfma_f32_32x32x16_bf16(pb, v1, o2[1], 0, 0, 0);
  o1[2] = __builtin_amdgcn_mfma_f32_32x32x16_bf16(pa, v2, o1[2], 0, 0, 0); o2[2] = __builtin_amdgcn_mfma_f32_32x32x16_bf16(pb, v2, o2[2], 0, 0, 0);
  o1[3] = __builtin_amdgcn_mfma_f32_32x32x16_bf16(pa, v3, o1[3], 0, 0, 0); o2[3] = __builtin_amdgcn_mfma_f32_32x32x16_bf16(pb, v3, o2[3], 0, 0, 0);
}
DI void attn_diff2(const bf16_t* __restrict__ Qg, int ldq, const bf16_t* __restrict__ Kg, int ldk, const bf16_t* __restrict__ Vg, int ldv, int seq, float scale,
                   char* lds, f32x16 (&o1)[4], f32x16 (&o2)[4], float (&rli1)[16], float (&rli2)[16]) {
  const float C = scale * 1.4426950408889634f, thr_raw = THR / scale;
  const int tid = tidx(), wid = tid >> 6, lane = tid & 63, r32 = lane & 31, hi = lane >> 5;
  char* V_lds = lds; char* K_lds = lds + D2_OFF_K; char* Q_lds = lds + D2_OFF_Q;
  float* wsl = (float*)(lds + D2_OFF_WS) + wid * 128; float* li1 = wsl; float* li2 = wsl + 32; float* al_l = wsl + 64;
#pragma unroll
  for (int i = 0; i < 8; ++i) { const int ch = tid + 512 * i, row = ch >> 4, cc = ch & 15;
    *(bf16x8*)(Q_lds + (cc >> 3) * D2_QM + row * 144 + (cc & 7) * 16) = ld8(Qg + (long)row * ldq + cc * 8); }
  const char* Q1row = Q_lds + (wid * 32 + r32) * 144; const char* Q2row = Q1row + D2_QM;
  const int sr = tid >> 4, sc = (tid & 15) * 8, vst0 = v_st(sr, sc), vst1 = v_st(32 + sr, sc);
  const int vb0 = (int)(uintptr_t)V_lds + v_rd_base(lane);
  const int kr = tid >> 3, kc = tid & 7, kw = kr * 144 + kc * 16;
  const bf16_t* kp = Kg + (long)kr * ldk + kc * 8;
  bf16x8 sv0, sv1, sk0, sk1;
#define SLOAD2(t) do { sv0 = ld8(&Vg[(long)((t) * 64 + sr) * ldv + sc]); sv1 = ld8(&Vg[(long)((t) * 64 + 32 + sr) * ldv + sc]); \
    sk0 = ld8(kp + (long)(t) * 64 * ldk); sk1 = ld8(kp + (long)(t) * 64 * ldk + 64); } while (0)
#define SWRITE2(b) do { *(bf16x8*)(V_lds + (b) * SHM_V + vst0) = sv0; *(bf16x8*)(V_lds + (b) * SHM_V + vst1) = sv1; \
    *(bf16x8*)(K_lds + (b) * D2_KBUF + kw) = sk0; *(bf16x8*)(K_lds + (b) * D2_KBUF + D2_KT + kw) = sk1; } while (0)
#define RESC2(o, a) do { if (__any((a) < 1.f)) { if (hi == 0) al_l[r32] = (a); asm volatile("s_waitcnt lgkmcnt(0)" ::: "memory"); \
    _Pragma("unroll") for (int d = 0; d < 4; ++d) _Pragma("unroll") for (int r = 0; r < 16; ++r) o[d][r] *= al_l[crow(r, hi)]; } } while (0)
  float m1 = -1e30f, m2 = -1e30f, l1 = 0.f, l2 = 0.f;
#pragma unroll
  for (int d = 0; d < 4; ++d) { o1[d] = f32x16{}; o2[d] = f32x16{}; }
  const int NT = seq / KVBLK;
  SLOAD2(0); asm volatile("s_waitcnt vmcnt(0)" ::: "memory"); SWRITE2(0); __syncthreads();
  if (1 < NT) SLOAD2(1);
  for (int t = 0; t < NT; ++t) {
    const int cur = t & 1;
    f32x16 p0, p1, q0, q1; float mn, al1, al2; bf16x8 a0, a1, a2, a3, b0, b1, b2, b3;
    qkt_l(p0, p1, K_lds + cur * D2_KBUF, Q1row, r32, hi);
    qkt_l(q0, q1, K_lds + cur * D2_KBUF + D2_KT, Q2row, r32, hi);
    partialSM(p0, p1, m1, mn, al1, C, thr_raw); finishSM(p0, p1, al1, l1, a0, a1, a2, a3);
    partialSM(q0, q1, m2, mn, al2, C, thr_raw); finishSM(q0, q1, al2, l2, b0, b1, b2, b3);
    RESC2(o1, al1); RESC2(o2, al2);
    if (t + 1 < NT) { SWRITE2(cur ^ 1); if (t + 2 < NT) SLOAD2(t + 2); }
    const int vb = vb0 + cur * (int)SHM_V;
    pv2_step<0>(o1, o2, vb, a0, b0); pv2_step<1>(o1, o2, vb, a1, b1); pv2_step<2>(o1, o2, vb, a2, b2); pv2_step<3>(o1, o2, vb, a3, b3);
    __syncthreads();
  }
  if (hi == 0) { li1[r32] = l1; li2[r32] = l2; } asm volatile("s_waitcnt lgkmcnt(0)" ::: "memory");
#pragma unroll
  for (int r = 0; r < 16; ++r) { rli1[r] = 1.f / li1[crow(r, hi)]; rli2[r] = 1.f / li2[crow(r, hi)]; }
  __syncthreads();
#undef SLOAD2
#undef SWRITE2
#undef RESC2
}
}

DI f32x4 mm16(const bf16_t* A, int lda, const bf16_t* Bt, int ldb, int K, f32x4 acc, int lane) {
  const bf16_t* ap = A + (lane & 15) * lda + 8 * (lane >> 4);
  const bf16_t* bp = Bt + (lane & 15) * ldb + 8 * (lane >> 4);
  for (int k0 = 0; k0 < K; k0 += 32) {
    const bf16x8 a = *(const bf16x8*)(ap + k0), b = *(const bf16x8*)(bp + k0);
    acc = __builtin_amdgcn_mfma_f32_16x16x32_bf16(a, b, acc, 0, 0, 0);
  }
  return acc;
}
constexpr int LP = 72;

DI int chunk_row0(int tc) { return tc * 64; }
DI int scan_idx(int tc, int dir) { return tc < 256 ? (dir == 0 ? 4 + tc : 4 + (255 - tc)) : (dir == 0 ? tc - 256 : 3 - (tc - 256)); }
DI void stream_bounds(int row0, int& lo, int& hi) { if (row0 < TL) { lo = 0; hi = TL; } else { lo = TL; hi = T; } }

DI void sincos_d(double a, float& c, float& s) {
  const double TWO_PI = 6.283185307179586476925287;
  const double k = rint(a / TWO_PI); const double r = a - k * TWO_PI; const double r2 = r * r;
  double ss = 1.0, cc = 1.0;
#pragma unroll
  for (int n = 13; n >= 1; --n) { ss = 1.0 - r2 / (double)((2 * n) * (2 * n + 1)) * ss; cc = 1.0 - r2 / (double)((2 * n - 1) * (2 * n)) * cc; }
  s = (float)(r * ss); c = (float)cc;
}
DI void phase_setup(const Params& p, unsigned char* lds) {
  const int tid = tidx();
  float* sx = (float*)lds;
  float* red = sx + 2048;
  float* MOD = (float*)(p.ws + WS_MOD);
  for (int i = tid; i < 1024; i += 512) { sx[i] = siluf(p.in[1][i]); sx[1024 + i] = siluf(p.in[3][i]); }
  __syncthreads();
  for (int item = blockIdx.x; item < 384; item += gridDim.x) {
    const int l = item / 192, cb = item % 192, cl = tid & 31, ks = tid >> 5;
    const float* w = p.in[4] + (size_t)l * 1024 * 6144 + cb * 32 + cl;
    float a0 = 0.f, a1 = 0.f;
    for (int k = ks * 64; k < ks * 64 + 64; ++k) { const float wv = w[(size_t)k * 6144]; a0 += sx[k] * wv; a1 += sx[1024 + k] * wv; }
    red[(0 * 16 + ks) * 32 + cl] = a0; red[(1 * 16 + ks) * 32 + cl] = a1;
    __syncthreads();
    if (tid < 64) { const int s = tid >> 5; float sum = 0.f;
      for (int q = 0; q < 16; ++q) sum += red[(s * 16 + q) * 32 + cl];
      MOD[(size_t)(l * 2 + s) * 6144 + cb * 32 + cl] = sum + p.in[5][l * 6144 + cb * 32 + cl]; }
    __syncthreads();
  }
  { float* acc = (float*)(p.ws + WS_ACC); for (int i = blockIdx.x * 512 + tid; i < 2 * TC * D; i += gridDim.x * 512) acc[i] = 0.f; }
  const int gt = blockIdx.x * 512 + tid;
  if (gt < 256 * 16) { const int pos = gt >> 4, i = gt & 15; const double inv = exp2(-(double)i / 16.0 * 13.287712379549449);
    float c, s; sincos_d((double)pos * inv, c, s); float* t = (float*)(p.ws + WS_TAB32) + gt * 2; t[0] = c; t[1] = s; }
  else if (gt < 256 * 16 + 256 * 8) { const int g2 = gt - 256 * 16; const int pos = g2 >> 3, i = g2 & 7; const double inv = exp2(-(double)i / 8.0 * 13.287712379549449);
    float c, s; sincos_d((double)pos * inv, c, s); float* t = (float*)(p.ws + WS_TAB16) + g2 * 2; t[0] = c; t[1] = s; }
  if (blockIdx.x == gridDim.x - 1 && tid < 128) {
    const int l = tid >> 6, lane = tid & 63; const float* lam = p.in[7] + l * 4 * 64;
    const float s1 = wave_sum(lam[lane] * lam[64 + lane]), s2 = wave_sum(lam[128 + lane] * lam[192 + lane]);
    const float lam_init = 0.8f - 0.6f * expf(-0.3f * (float)l);
    if (lane == 0) ((float*)(p.ws + WS_LAM))[l] = expf(s1) - expf(s2) + lam_init;
  }
}

DI void transpose_job(const float* __restrict__ src, int ld, int K, int nvalid, int npad, bf16_t* __restrict__ dst, unsigned char* lds, int wg0 = 0) {
  const int wave = tidx() >> 6, lane = tidx() & 63;
  float* scr = (float*)lds + wave * (64 * 33);
  if ((int)blockIdx.x < wg0) return;
  const int gw = ((int)blockIdx.x - wg0) * 8 + wave, NGW = ((int)gridDim.x - wg0) * 8;
  const int nblk = npad / 32, nitems = (K / 64) * nblk;
  for (int item = gw; item < nitems; item += NGW) {
    const int kb = item / nblk, nb = item % nblk, k0 = 64 * kb, n0 = 32 * nb;
    const int nn = n0 + (lane & 31); const bool ok = nn < nvalid;
#pragma unroll 8
    for (int i = 0; i < 32; ++i) { const int kk = 2 * i + (lane >> 5); scr[kk * 33 + (lane & 31)] = ok ? src[(size_t)(k0 + kk) * ld + nn] : 0.f; }
    LDS_WAIT();
    const int c = lane & 7;
#pragma unroll
    for (int j = 0; j < 4; ++j) { const int n = (lane >> 3) + 8 * j; const float* s = scr + (8 * c) * 33 + n;
      u32x4 o; o.x = cvtpk(s[0 * 33], s[1 * 33]); o.y = cvtpk(s[2 * 33], s[3 * 33]); o.z = cvtpk(s[4 * 33], s[5 * 33]); o.w = cvtpk(s[6 * 33], s[7 * 33]);
      *(u32x4*)(dst + (size_t)(n0 + n) * K + k0 + 8 * c) = o; }
    LDS_WAIT();
  }
}
DI void convert_layer_start(const Params& p, int l, unsigned char* lds) {
  const float* w_in = p.in[6] + (size_t)l * 1024 * 5056;
  bf16_t* wa = (bf16_t*)(p.ws + WS_WA);
  transpose_job(w_in + 1536, 5056, 1024, 1552, NB_B, (bf16_t*)((unsigned char*)wa + WA_B), lds);
}
DI void convert_layer_rest(const Params& p, int l, unsigned char* lds, int wg0) {
  const float* w_in = p.in[6] + (size_t)l * 1024 * 5056;
  bf16_t* wa = (bf16_t*)(p.ws + WS_WA); unsigned char* wb = p.ws + WS_WB;
  transpose_job(w_in + 3760, 5056, 1024, 1296, NB_D, (bf16_t*)((unsigned char*)wa + WA_D), lds, wg0);
  transpose_job(w_in + 0, 5056, 1024, 1536, 1536, (bf16_t*)((unsigned char*)wa + WA_AC), lds, wg0);
  transpose_job(w_in + 3088, 5056, 1024, 672, 768, (bf16_t*)((unsigned char*)wa + WA_AC) + (size_t)1536 * 1024, lds, wg0);
  transpose_job(p.in[15] + (size_t)l * 384 * 384, 384, 384, 384, 512, (bf16_t*)(wb + WB_UQ), lds, wg0);
  transpose_job(p.in[16] + (size_t)l * 256 * 768, 768, 256, 768, 768, (bf16_t*)(wb + WB_UKV), lds, wg0);
  for (int k = 0; k < 4; ++k) transpose_job(p.in[25] + ((size_t)l * 4 + k) * 512 * 1024, 1024, 512, 1024, 1024, (bf16_t*)(wb + WB_BR) + (size_t)k * 1024 * 512, lds, wg0);
  transpose_job(p.in[26] + (size_t)l * 1024 * 1024, 1024, 1024, 1024, 1024, (bf16_t*)(wb + WB_WO), lds, wg0);
}

DI void ln_stats(const f32x4 (&v)[4], float& mean, float& rstd) {
  float s = 0.f;
#pragma unroll
  for (int j = 0; j < 4; ++j) s += (v[j].x + v[j].y) + (v[j].z + v[j].w);
  mean = wave_sum(s) * (1.f / D); float s2 = 0.f;
#pragma unroll
  for (int j = 0; j < 4; ++j) { const f32x4 d = v[j] - mean; s2 += (d.x * d.x + d.y * d.y) + (d.z * d.z + d.w * d.w); }
  rstd = 1.f / sqrtf(wave_sum(s2) * (1.f / D) + EPS);
}
DI void phase_ln_mod(const float* xl, const float* xc, const float* mod_l, const float* mod_c, int sh_off, int sc_off, bf16_t* H, int nrows) {
  const int wave = tidx() >> 6, lane = tidx() & 63, stride = gridDim.x * 8;
  auto load_row = [&](int row, f32x4 (&v)[4]) { const float* xr = row >= TL ? xc + (size_t)(row - TL) * D : xl + (size_t)row * D;
#pragma unroll
    for (int j = 0; j < 4; ++j) v[j] = *(const f32x4*)(xr + 4 * lane + 256 * j); };
  int row = blockIdx.x * 8 + wave; f32x4 v[4];
  if (row < nrows) load_row(row, v);
  while (row < nrows) {
    const int nrow = row + stride; f32x4 vn[4];
    if (nrow < nrows) load_row(nrow, vn);
    const float* mod = row >= TL ? mod_c : mod_l;
    float mean, rstd; ln_stats(v, mean, rstd);
#pragma unroll
    for (int j = 0; j < 4; ++j) { const int c = 4 * lane + 256 * j; const f32x4 sh = *(const f32x4*)(mod + sh_off + c), sc = *(const f32x4*)(mod + sc_off + c);
      const f32x4 y = (v[j] - mean) * rstd * (sc + 1.f) + sh; u32x2 w; w.x = cvtpk(y.x, y.y); w.y = cvtpk(y.z, y.w);
      *(u32x2*)(H + (size_t)row * D + c) = w; }
#pragma unroll
    for (int j = 0; j < 4; ++j) v[j] = vn[j];
    row = nrow;
  }
}
DI void phase_ln_affine_mod(float* xl, float* xc, const float* g, const float* b, const float* mod_l, const float* mod_c, int sh_off, int sc_off, bf16_t* H, int nrows,
                            const float* cx = nullptr, const float* cacc = nullptr, const float* cg = nullptr, const float* cb = nullptr) {
  const int wave = tidx() >> 6, lane = tidx() & 63, stride = gridDim.x * 8;
  auto load_row = [&](int row, f32x4 (&v)[4]) {
    if (row >= TL && cacc) {
#pragma unroll
      for (int j = 0; j < 4; ++j) { const int c = 4 * lane + 256 * j; const size_t o = (size_t)(row - TL) * D + c;
        const f32x4 bb = cb ? *(const f32x4*)(cb + c) : (f32x4){0.f, 0.f, 0.f, 0.f};
        v[j] = *(const f32x4*)(cx + o) * ALPHA + *(const f32x4*)(cg + c) * (*(const f32x4*)(cacc + o) + bb); }
    } else { const float* xr = row >= TL ? xc + (size_t)(row - TL) * D : xl + (size_t)row * D;
#pragma unroll
      for (int j = 0; j < 4; ++j) v[j] = *(const f32x4*)(xr + 4 * lane + 256 * j); } };
  int row = blockIdx.x * 8 + wave; f32x4 v[4];
  if (row < nrows) load_row(row, v);
  while (row < nrows) {
    const int nrow = row + stride; f32x4 vn[4];
    if (nrow < nrows) load_row(nrow, vn);
    const bool isc = row >= TL; float* xr = isc ? xc + (size_t)(row - TL) * D : xl + (size_t)row * D; const float* mod = isc ? mod_c : mod_l;
    float mean, rstd; ln_stats(v, mean, rstd);
#pragma unroll
    for (int j = 0; j < 4; ++j) { const int c = 4 * lane + 256 * j; v[j] = (v[j] - mean) * rstd * *(const f32x4*)(g + c) + *(const f32x4*)(b + c); *(f32x4*)(xr + c) = v[j]; }
    if (H) {
      ln_stats(v, mean, rstd);
#pragma unroll
      for (int j = 0; j < 4; ++j) { const int c = 4 * lane + 256 * j; const f32x4 sh = *(const f32x4*)(mod + sh_off + c), sc = *(const f32x4*)(mod + sc_off + c);
        const f32x4 y = (v[j] - mean) * rstd * (sc + 1.f) + sh; u32x2 w; w.x = cvtpk(y.x, y.y); w.y = cvtpk(y.z, y.w);
        *(u32x2*)(H + (size_t)row * D + c) = w; }
    }
#pragma unroll
    for (int j = 0; j < 4; ++j) v[j] = vn[j];
    row = nrow;
  }
}

DI void phase_attn_prep(const Params& p, int l) {
  const int wave = tidx() >> 6, lane = tidx() & 63;
  bf16_t* PAC = (bf16_t*)(p.ws + WS_BIG + BG_PAC);
  const float* tab32 = (const float*)(p.ws + WS_TAB32); const float* tab16 = (const float*)(p.ws + WS_TAB16);
  const float* qn = p.in[13] + l * 384; const float* kvn = p.in[14] + l * 256;
  for (int row = blockIdx.x * 8 + wave; row < T; row += gridDim.x * 8) {
    bf16_t* pr = PAC + (size_t)row * NB_AC;
    if (row < TL) {
      const int prow = row >> 6, pcol = row & 63;
#pragma unroll
      for (int it = 0; it < 8; ++it) { const int pi = it * 64 + lane;
        const int unit = pi >> 5, q = pi & 31, sec = q >> 4, i = q & 15;
        const int e0 = unit * 64 + sec * 32 + i; const int pos = sec ? pcol : prow;
        const float cs = tab32[(pos * 16 + i) * 2], sn = tab32[(pos * 16 + i) * 2 + 1];
        const float x1 = bf2f(pr[e0]), x2 = bf2f(pr[e0 + 16]);
        pr[e0] = f2bf(x1 * cs - x2 * sn); pr[e0 + 16] = f2bf(x2 * cs + x1 * sn); }
      if (lane < 16) { const int sec = lane >> 3, i = lane & 7; const int e0 = 2176 + sec * 16 + i; const int pos = sec ? pcol : prow;
        const float cs = tab16[(pos * 8 + i) * 2], sn = tab16[(pos * 8 + i) * 2 + 1];
        const float x1 = bf2f(pr[e0]), x2 = bf2f(pr[e0 + 8]);
        pr[e0] = f2bf(x1 * cs - x2 * sn); pr[e0 + 8] = f2bf(x2 * cs + x1 * sn); }
    }
    { float v[6]; float ss = 0.f;
#pragma unroll
      for (int j = 0; j < 6; ++j) { v[j] = bf2f(pr[1536 + lane + 64 * j]); ss += v[j] * v[j]; }
      const float rs = 1.f / sqrtf(wave_sum(ss) * (1.f / 384.f) + EPS);
#pragma unroll
      for (int j = 0; j < 6; ++j) pr[1536 + lane + 64 * j] = f2bf(v[j] * rs * qn[lane + 64 * j]); }
    { float v[4]; float ss = 0.f;
#pragma unroll
      for (int j = 0; j < 4; ++j) { v[j] = bf2f(pr[1920 + lane + 64 * j]); ss += v[j] * v[j]; }
      const float rs = 1.f / sqrtf(wave_sum(ss) * (1.f / 256.f) + EPS);
#pragma unroll
      for (int j = 0; j < 4; ++j) pr[1920 + lane + 64 * j] = f2bf(v[j] * rs * kvn[lane + 64 * j]); }
  }
}
DI void phase_qup_rope(const Params& p) {
  const int wave = tidx() >> 6, lane = tidx() & 63;
  bf16_t* QUP = (bf16_t*)(p.ws + WS_BIG + BG_QUP); const float* tab16 = (const float*)(p.ws + WS_TAB16);
  for (int row = blockIdx.x * 8 + wave; row < TL; row += gridDim.x * 8) {
    const int prow = row >> 6, pcol = row & 63; bf16_t* pr = QUP + (size_t)row * 384;
    const int h = lane >> 4, q = lane & 15, sec = q >> 3, i = q & 7; const int e0 = h * 96 + 64 + sec * 16 + i; const int pos = sec ? pcol : prow;
    const float cs = tab16[(pos * 8 + i) * 2], sn = tab16[(pos * 8 + i) * 2 + 1];
    const float x1 = bf2f(pr[e0]), x2 = bf2f(pr[e0 + 8]);
    pr[e0] = f2bf(x1 * cs - x2 * sn); pr[e0 + 8] = f2bf(x2 * cs + x1 * sn);
  }
}

DI void attn_item_diff(const Params& p, int l, int q0, int h, int key0, int nkeys, char* lds) {
  const bf16_t* PAC = (const bf16_t*)(p.ws + WS_BIG + BG_PAC);
  bf16_t* OUT = (bf16_t*)(p.ws + WS_BR);
  const int tid = tidx(), wid = tid >> 6, lane = tid & 63, r32 = lane & 31, hi = lane >> 5;
  const float lam = ((const float*)(p.ws + WS_LAM))[l]; const float lam_init = 0.8f - 0.6f * expf(-0.3f * (float)l);
  f32x16 o1[4], o2[4]; float rli1[16], rli2[16];
  att::attn_diff2(PAC + (size_t)q0 * NB_AC + h * 128, NB_AC, PAC + (size_t)key0 * NB_AC + 512 + h * 128, NB_AC, PAC + (size_t)key0 * NB_AC + 1024 + h * 128, NB_AC,
                  nkeys, 0.125f, lds, o1, o2, rli1, rli2);
  const float* sw = p.in[8] + l * 128; const float og = 1.f - lam_init;
  float swv[4];
#pragma unroll
  for (int d0 = 0; d0 < 4; ++d0) swv[d0] = sw[d0 * 32 + r32] * og;
#pragma unroll
  for (int r = 0; r < 16; ++r) { float ss = 0.f; const float c1 = rli1[r], c2 = lam * rli2[r];
#pragma unroll
    for (int d0 = 0; d0 < 4; ++d0) { const float v = o1[d0][r] * c1 - o2[d0][r] * c2; o1[d0][r] = v; ss += v * v; }
#pragma unroll
    for (int off = 1; off < 32; off <<= 1) ss += __shfl_xor(ss, off);
    const float rs = 1.f / sqrtf(ss * (1.f / 128.f) + EPS);
    bf16_t* orow = OUT + (size_t)(q0 + wid * 32 + att::crow(r, hi)) * 512 + h * 128 + r32;
#pragma unroll
    for (int d0 = 0; d0 < 4; ++d0) orow[d0 * 32] = f2bf(o1[d0][r] * rs * swv[d0]); }
}
DI void attn_item_mla(const Params& p, int q0, int h, int key0, int nkeys, char* lds) {
  const bf16_t* PAC = (const bf16_t*)(p.ws + WS_BIG + BG_PAC);
  const bf16_t* QUP = (const bf16_t*)(p.ws + WS_BIG + BG_QUP); const bf16_t* KVUP = (const bf16_t*)(p.ws + WS_BIG + BG_KVUP);
  bf16_t* OUT = (bf16_t*)(p.ws + WS_BR) + (size_t)2 * T * 512;
  const int tid = tidx(), wid = tid >> 6, lane = tid & 63, r32 = lane & 31, hi = lane >> 5;
  f32x16 o[4]; float rli[16];
  if (q0 < TL) {
    bf16_t* QW = (bf16_t*)(p.ws + WS_BIG + BG_QUP); const float* tab16 = (const float*)(p.ws + WS_TAB16);
    for (int u = tid; u < 256 * 16; u += 512) { const int row = q0 + (u >> 4), q = u & 15, sec = q >> 3, i = q & 7;
      const int prow = row >> 6, pcol = row & 63, pos = sec ? pcol : prow; bf16_t* pr = QW + (size_t)row * 384 + h * 96 + 64 + sec * 16 + i;
      const float cs = tab16[(pos * 8 + i) * 2], sn = tab16[(pos * 8 + i) * 2 + 1];
      const float x1 = bf2f(pr[0]), x2 = bf2f(pr[8]);
      pr[0] = f2bf(x1 * cs - x2 * sn); pr[8] = f2bf(x2 * cs + x1 * sn); }
    __syncthreads();
  }
  att::attn_body<96>(QUP + (size_t)q0 * 384 + h * 96, 384, KVUP + (size_t)key0 * 768 + h * 192, 768, PAC + (size_t)key0 * NB_AC + 2176, NB_AC,
                     KVUP + (size_t)key0 * 768 + h * 192 + 64, 768, nkeys, 0.10206207261596575f, lds, o, rli);
#pragma unroll
  for (int r = 0; r < 16; ++r) { bf16_t* orow = OUT + (size_t)(q0 + wid * 32 + att::crow(r, hi)) * 512 + h * 128 + r32;
#pragma unroll
    for (int d0 = 0; d0 < 4; ++d0) orow[d0 * 32] = f2bf(o[d0][r] * rli[r]); }
}
DI void phase_attention(const Params& p, int l, char* lds) {
  const int c = blockIdx.x, G = gridDim.x;
  for (int it = c; it < 256; it += G) attn_item_diff(p, l, (it >> 2) * 256, it & 3, 0, T, lds);
  for (int it = c; it < 256; it += G) attn_item_mla(p, (it >> 2) * 256, it & 3, 0, T, lds);
  if (l == 0) {
    for (int it = c; it < 8; it += G) { if (it < 4) attn_item_diff(p, l, TL, it, TL, TC, lds); else attn_item_mla(p, TL, it - 4, TL, TC, lds); }
  }
}

DI float log_sigmoid(float x) { return fminf(x, 0.f) - log1pf(__expf(-fabsf(x))); }
DI float wave_scan_sum(float v, int lane, int dir) {
#pragma unroll
  for (int o = 1; o < 64; o <<= 1) { const float t = dir ? __shfl_down(v, o) : __shfl_up(v, o); const bool ok = dir ? (lane + o < 64) : (lane >= o); v += ok ? t : 0.f; }
  return v;
}
DI float wave_scan_max(float v, int lane, int dir) {
#pragma unroll
  for (int o = 1; o < 64; o <<= 1) { const float t = dir ? __shfl_down(v, o) : __shfl_up(v, o); const bool ok = dir ? (lane + o < 64) : (lane >= o); v = ok ? fmaxf(v, t) : v; }
  return v;
}
template <int NR, class F>
DI void conv_tile(const bf16_t* P, int ldp, int row0, int lo, int hi, const float* cw, int cw_ld, const float* cb, int gcol, int r0, int  , F&& out) {
  float w[5];
#pragma unroll
  for (int t = 0; t < 5; ++t) w[t] = cw[t * cw_ld];
  const float b = cb[0];
  float x[NR + 4];
#pragma unroll
  for (int i = 0; i < NR + 4; ++i) { const int row = row0 + r0 - 2 + i; const int rc = row < lo ? lo : (row >= hi ? hi - 1 : row);
    const float v = bf2f(P[(size_t)rc * ldp + gcol]); x[i] = (row >= lo && row < hi) ? v : 0.f; }
#pragma unroll
  for (int i = 0; i < NR; ++i) { const float y = b + w[0] * x[i] + w[1] * x[i + 1] + w[2] * x[i + 2] + w[3] * x[i + 3] + w[4] * x[i + 4]; out(r0 + i, siluf(y)); }
}
DI void phase_ml_s1(const Params& p, int l, unsigned char* lds) {
  const int tid = tidx(), wave = tid >> 6, lane = tid & 63;
  const bf16_t* PB = (const bf16_t*)(p.ws + WS_BIG + BG_PB);
  bf16_t* UC = (bf16_t*)(p.ws + WS_BIG + BG_UC); float* MSC = (float*)(p.ws + WS_BIG + BG_MSC);
  bf16_t* Vt = (bf16_t*)lds;
  bf16_t* Kt = Vt + 128 * LP;
  bf16_t* Kts = Kt + 64 * LP;
  float* wsv = (float*)(Kts + 64 * LP);
  const float* cw = p.in[9] + (size_t)l * 5 * 512; const float* cb = p.in[10] + l * 512; const float* gb = p.in[11] + l * 16;
  for (int item = blockIdx.x; item < 4 * NCH; item += gridDim.x) {
    const int h = item & 3, tc = item >> 2, row0 = chunk_row0(tc); int lo, hi; stream_bounds(row0, lo, hi);
    __syncthreads();
    {
      const int d = tid & 63, r0 = (tid >> 6) * 8; const int gc = 256 + h * 64 + d;
      conv_tile<8>(PB, NB_B, row0, lo, hi, cw + gc, 512, cb + gc, gc, r0, 8, [&](int r, float v) { Kt[d * LP + r] = f2bf(v * 0.125f); }); }
    {
      const int j = tid >> 3, e0 = (tid & 7) * 16; const bf16_t* src = PB + (size_t)(row0 + j) * NB_B + 512 + h * 128 + e0;
      const bf16x8 a = *(const bf16x8*)src, b = *(const bf16x8*)(src + 8);
#pragma unroll
      for (int i = 0; i < 8; ++i) { Vt[(e0 + i) * LP + j] = (bf16_t)a[i]; Vt[(e0 + 8 + i) * LP + j] = (bf16_t)b[i]; } }
    if (wave < 2) { const int dir = wave; const bf16_t* gr = PB + (size_t)(row0 + lane) * NB_B + 1536;
      const float ig = bf2f(gr[(2 * dir) * 4 + h]) + gb[(2 * dir) * 4 + h];
      const float lf = log_sigmoid(bf2f(gr[(2 * dir + 1) * 4 + h]) + gb[(2 * dir + 1) * 4 + h]);
      const float g = wave_scan_sum(lf, lane, dir); const float g_end = wave_sum(lf);
      const float ls = g_end - g + ig; const float m_loc = wave_max(ls);
      wsv[dir * 64 + lane] = __expf(ls - m_loc);
      if (lane == 0) { const int ch = h * 2 + dir, s = scan_idx(tc, dir); MSC[(0 * 8 + ch) * NCH + s] = g_end; MSC[(1 * 8 + ch) * NCH + s] = m_loc; } }
    __syncthreads();
    for (int dir = 0; dir < 2; ++dir) {
      const int ch = h * 2 + dir, s = scan_idx(tc, dir); bf16_t* urow = UC + ((size_t)ch * NCH + s) * MLROW;
      { const int d = tid >> 3, j0 = (tid & 7) * 8; float sum = 0.f;
#pragma unroll
        for (int i = 0; i < 8; ++i) { const bf16_t v = f2bf(bf2f(Kt[d * LP + j0 + i]) * wsv[dir * 64 + j0 + i]); Kts[d * LP + j0 + i] = v; sum += bf2f(v); }
        sum += __shfl_xor(sum, 1); sum += __shfl_xor(sum, 2); sum += __shfl_xor(sum, 4);
        if ((tid & 7) == 0) urow[8192 + d] = f2bf(sum); }
      __syncthreads();
#pragma unroll
      for (int dt = 0; dt < 4; ++dt) { f32x4 acc = {0.f, 0.f, 0.f, 0.f};
        acc = mm16(Vt + wave * 16 * LP, LP, Kts + dt * 16 * LP, LP, 64, acc, lane);
#pragma unroll
        for (int r = 0; r < 4; ++r) urow[(wave * 16 + (lane >> 4) * 4 + r) * 64 + dt * 16 + (lane & 15)] = f2bf(acc[r]); }
      __syncthreads();
    }
  }
}
DI void phase_ml_s2(const Params& p) {
  const bf16_t* __restrict__ UC = (const bf16_t*)(p.ws + WS_BIG + BG_UC); bf16_t* __restrict__ SC = (bf16_t*)(p.ws + WS_BIG + BG_SC);
  float* MSC = (float*)(p.ws + WS_BIG + BG_MSC);
  const int npairs = 8 * (MLROW / 2);
  for (int e = blockIdx.x * 512 + tidx(); e < npairs; e += gridDim.x * 512) {
    const int ch = e / (MLROW / 2), off = (e % (MLROW / 2)) * 2;
    const float* GE = MSC + (0 * 8 + ch) * NCH; const float* ML = MSC + (1 * 8 + ch) * NCH; float* MS = MSC + (2 * 8 + ch) * NCH;
    float m = 0.f, c0 = 0.f, c1 = 0.f;
    for (int s0 = 0; s0 < NCH; s0 += 26) {
      unsigned u[26];
#pragma unroll
      for (int q = 0; q < 26; ++q) u[q] = *(const unsigned*)(UC + ((size_t)ch * NCH + s0 + q) * MLROW + off);
      float gev[26], mlv[26];
#pragma unroll
      for (int q = 0; q < 26; ++q) { gev[q] = GE[s0 + q]; mlv[q] = ML[s0 + q]; }
#pragma unroll
      for (int q = 0; q < 26; ++q) { const int s = s0 + q;
        *(unsigned*)(SC + ((size_t)ch * NCH + s) * MLROW + off) = cvtpk(c0, c1);
        if (off == 0) MS[s] = m;
        const float ge = gev[q], ml = mlv[q]; const float mn = fmaxf(ge + m, ml); const float dec = __expf(ge + m - mn), sc = __expf(ml - mn);
        c0 = dec * c0 + sc * bflo(u[q]); c1 = dec * c1 + sc * bfhi(u[q]); m = mn; }
    }
  }
}
DI void phase_ml_s3(const Params& p, int l, unsigned char* lds, int ntc) {
  const int tid = tidx(), wave = tid >> 6, lane = tid & 63;
  const bf16_t* PB = (const bf16_t*)(p.ws + WS_BIG + BG_PB);
  const bf16_t* SC = (const bf16_t*)(p.ws + WS_BIG + BG_SC); const float* MSC = (const float*)(p.ws + WS_BIG + BG_MSC);
  bf16_t* OUT = (bf16_t*)(p.ws + WS_BR) + (size_t)1 * T * 512;
  bf16_t* Q = (bf16_t*)lds;
  bf16_t* Kk = Q + 64 * LP;
  bf16_t* W = Kk + 64 * LP;
  bf16_t* Vt = W + 64 * LP;
  bf16_t* Ct = Vt + 128 * LP;
  float* fa = (float*)(Ct + 128 * LP);
  float* gS = fa;
  float* bS = fa + 128;
  float* mjS = fa + 256;
  float* aiS = fa + 384;
  float* rdS = fa + 448;
  float* nS = fa + 512;
  float* ssS = fa + 576;
  const float* cw = p.in[9] + (size_t)l * 5 * 512; const float* cb = p.in[10] + l * 512; const float* gb = p.in[11] + l * 16;
  const float* nw = p.in[12] + l * 512;
  const int js = wave >> 1, eh = wave & 1;
  for (int item = blockIdx.x; item < 4 * ntc; item += gridDim.x) {
    const int h = item & 3, tc = item >> 2, row0 = chunk_row0(tc); int lo, hi; stream_bounds(row0, lo, hi);
    __syncthreads();
    { const int c = tid & 127, r0 = (tid >> 7) * 16; const int gc = (c < 64) ? h * 64 + c : 256 + h * 64 + (c - 64);
      bf16_t* dst = (c < 64) ? Q + c : Kk + (c - 64); const float scl = (c < 64) ? 1.f : 0.125f;
      conv_tile<16>(PB, NB_B, row0, lo, hi, cw + gc, 512, cb + gc, gc, r0, 16, [&](int r, float v) { dst[r * LP] = f2bf(v * scl); }); }
    { const int j = tid >> 3, e0 = (tid & 7) * 16; const bf16_t* src = PB + (size_t)(row0 + j) * NB_B + 512 + h * 128 + e0;
      const bf16x8 a = *(const bf16x8*)src, b = *(const bf16x8*)(src + 8);
#pragma unroll
      for (int i = 0; i < 8; ++i) { Vt[(e0 + i) * LP + j] = (bf16_t)a[i]; Vt[(e0 + 8 + i) * LP + j] = (bf16_t)b[i]; } }
    float mdir[2];
#pragma unroll
    for (int dir = 0; dir < 2; ++dir) mdir[dir] = MSC[(2 * 8 + h * 2 + dir) * NCH + scan_idx(tc, dir)];
    if (wave < 2) { const int dir = wave; const bf16_t* gr = PB + (size_t)(row0 + lane) * NB_B + 1536;
      const float ig = bf2f(gr[(2 * dir) * 4 + h]) + gb[(2 * dir) * 4 + h];
      const float lf = log_sigmoid(bf2f(gr[(2 * dir + 1) * 4 + h]) + gb[(2 * dir + 1) * 4 + h]);
      const float g = wave_scan_sum(lf, lane, dir); const float b = ig - g; const float bm = wave_scan_max(b, lane, dir);
      gS[dir * 64 + lane] = g; bS[dir * 64 + lane] = b; mjS[dir * 64 + lane] = g + fmaxf(dir ? mdir[1] : mdir[0], bm); }
    f32x4 hs[4];
#pragma unroll
    for (int t = 0; t < 4; ++t) hs[t] = (f32x4){0.f, 0.f, 0.f, 0.f};
#pragma unroll
    for (int dir = 0; dir < 2; ++dir) {
      const int ch = h * 2 + dir, s = scan_idx(tc, dir); const bf16_t* srow = SC + ((size_t)ch * NCH + s) * MLROW; const float m = mdir[dir];
      __syncthreads();
      for (int i = tid; i < 1024; i += 512) { const int e = i >> 3, d0 = (i & 7) * 8; *(bf16x8*)(Ct + e * LP + d0) = *(const bf16x8*)(srow + e * 64 + d0); }
      if (tid < 64) { nS[tid] = bf2f(srow[8192 + tid]); aiS[tid] = __expf(gS[dir * 64 + tid] + m - mjS[dir * 64 + tid]); }
#pragma unroll
      for (int tt = 0; tt < 2; ++tt) { const int it = eh * 2 + tt; f32x4 acc = {0.f, 0.f, 0.f, 0.f};
        acc = mm16(Q + js * 16 * LP, LP, Kk + it * 16 * LP, LP, 64, acc, lane);
        const int i = it * 16 + (lane & 15); const float bi = bS[dir * 64 + i];
#pragma unroll
        for (int r = 0; r < 4; ++r) { const int j = js * 16 + (lane >> 4) * 4 + r; const bool ok = dir ? (i >= j) : (i <= j);
          const float wv = ok ? __expf(gS[dir * 64 + j] + bi - mjS[dir * 64 + j]) * acc[r] : 0.f; W[j * LP + i] = f2bf(wv); } }
      __syncthreads();
      { const int j = tid >> 3, i0 = (tid & 7) * 8; float sw = 0.f, sq = 0.f;
#pragma unroll
        for (int i = 0; i < 8; ++i) { sw += bf2f(W[j * LP + i0 + i]); sq += bf2f(Q[j * LP + i0 + i]) * nS[i0 + i]; }
        sw += __shfl_xor(sw, 1); sw += __shfl_xor(sw, 2); sw += __shfl_xor(sw, 4); sq += __shfl_xor(sq, 1); sq += __shfl_xor(sq, 2); sq += __shfl_xor(sq, 4);
        if ((tid & 7) == 0) { const float den = sw + aiS[j] * sq; rdS[j] = 1.f / fmaxf(fabsf(den), __expf(-mjS[dir * 64 + j])); } }
      __syncthreads();
#pragma unroll
      for (int t = 0; t < 4; ++t) { const int et = eh * 4 + t; f32x4 a1 = {0.f, 0.f, 0.f, 0.f}, a2 = {0.f, 0.f, 0.f, 0.f};
        a1 = mm16(W + js * 16 * LP, LP, Vt + et * 16 * LP, LP, 64, a1, lane);
        a2 = mm16(Q + js * 16 * LP, LP, Ct + et * 16 * LP, LP, 64, a2, lane);
#pragma unroll
        for (int r = 0; r < 4; ++r) { const int j = js * 16 + (lane >> 4) * 4 + r; hs[t][r] += (a1[r] + aiS[j] * a2[r]) * rdS[j]; } }
    }
    { float ssq[4] = {0.f, 0.f, 0.f, 0.f};
#pragma unroll
      for (int t = 0; t < 4; ++t)
#pragma unroll
        for (int r = 0; r < 4; ++r) ssq[r] += hs[t][r] * hs[t][r];
#pragma unroll
      for (int r = 0; r < 4; ++r) { float s = ssq[r]; s += __shfl_xor(s, 1); s += __shfl_xor(s, 2); s += __shfl_xor(s, 4); s += __shfl_xor(s, 8);
        if ((lane & 15) == 0) ssS[(js * 16 + (lane >> 4) * 4 + r) * 2 + eh] = s; }
      __syncthreads();
#pragma unroll
      for (int r = 0; r < 4; ++r) { const int j = js * 16 + (lane >> 4) * 4 + r; const float rs = 1.f / sqrtf((ssS[j * 2] + ssS[j * 2 + 1]) * (1.f / 128.f) + EPS);
        const size_t row = (size_t)(row0 + j);
#pragma unroll
        for (int t = 0; t < 4; ++t) { const int e = (eh * 4 + t) * 16 + (lane & 15); const float og = sigmoidf(bf2f(PB[row * NB_B + 1024 + h * 128 + e]));
          OUT[row * 512 + h * 128 + e] = f2bf(hs[t][r] * rs * nw[h * 128 + e] * og); } }
    }
  }
}

DI float softplusf(float x) { return fmaxf(x, 0.f) + log1pf(__expf(-fabsf(x))); }
struct SsdLds { bf16_t* Xt; bf16_t* Cm; bf16_t* Bm; bf16_t* Bmt; bf16_t* Sc; bf16_t* Hs; float* CB; float* sS; float* dtS; float* seS; float* ssS; };
DI SsdLds ssd_lds(unsigned char* lds) {
  SsdLds L; L.Xt = (bf16_t*)lds;
  L.Cm = L.Xt + 4 * 64 * LP;
  L.Bm = L.Cm + 64 * LP;
  L.Bmt = L.Bm + 64 * LP;
  L.Sc = L.Bmt + 64 * LP;
  L.Hs = L.Sc + 64 * LP;
  L.CB = (float*)(L.Hs + 64 * LP);
  L.sS = L.CB + 64 * 65;
  L.dtS = L.sS + 512;
  L.seS = L.dtS + 512;
  L.ssS = L.seS + 8;
  return L;
}
DI void ssd_load(const Params& p, int l, int g, int tc, const SsdLds& L) {
  const int tid = tidx(), wave = tid >> 6, lane = tid & 63;
  const bf16_t* PD = (const bf16_t*)(p.ws + WS_BIG + BG_PD);
  const float* cw = p.in[17] + (size_t)l * 5 * 768; const float* cb = p.in[18] + l * 768;
  const int row0 = chunk_row0(tc); int lo, hi; stream_bounds(row0, lo, hi);
  for (int u = tid; u < 384 * 4; u += 512) { const int c = u % 384, r0 = (u / 384) * 16;
    if (c < 256) { const int gc = g * 256 + c; bf16_t* dst = L.Xt + c * LP;
      conv_tile<16>(PD, NB_D, row0, lo, hi, cw + gc, 768, cb + gc, 512 + gc, r0, 16, [&](int r, float v) { dst[r] = f2bf(v); }); }
    else if (c < 320) { const int n = c - 256, gc = 512 + g * 64 + n;
      conv_tile<16>(PD, NB_D, row0, lo, hi, cw + gc, 768, cb + gc, 512 + gc, r0, 16, [&](int r, float v) { const bf16_t b = f2bf(v); L.Bm[r * LP + n] = b; L.Bmt[n * LP + r] = b; }); }
    else { const int n = c - 320, gc = 640 + g * 64 + n;
      conv_tile<16>(PD, NB_D, row0, lo, hi, cw + gc, 768, cb + gc, 512 + gc, r0, 16, [&](int r, float v) { L.Cm[r * LP + n] = f2bf(v); }); } }
  { const int hh = wave >> 1, dir = wave & 1, h = g * 4 + hh;
    const float dtb = p.in[19][l * 16 + dir * 8 + h], am = -__expf(p.in[20][l * 16 + dir * 8 + h]);
    const float dt = softplusf(bf2f(PD[(size_t)(row0 + lane) * NB_D + 1280 + dir * 8 + h]) + dtb); const float a = dt * am;
    const float s = wave_scan_sum(a, lane, dir); const float se = wave_sum(a);
    L.sS[wave * 64 + lane] = s; L.dtS[wave * 64 + lane] = dt; if (lane == 0) L.seS[wave] = se; }
}
DI bf16x8 pack8(const float (&v)[8]) { u32x4 w; w.x = cvtpk(v[0], v[1]); w.y = cvtpk(v[2], v[3]); w.z = cvtpk(v[4], v[5]); w.w = cvtpk(v[6], v[7]); return __builtin_bit_cast(bf16x8, w); }
DI void unpack8(const bf16x8 b, float (&v)[8]) { const u32x4 w = __builtin_bit_cast(u32x4, b); v[0] = bflo(w.x); v[1] = bfhi(w.x); v[2] = bflo(w.y); v[3] = bfhi(w.y); v[4] = bflo(w.z); v[5] = bfhi(w.z); v[6] = bflo(w.w); v[7] = bfhi(w.w); }
DI void phase_ssd_s1(const Params& p, int l, unsigned char* lds) {
  const int tid = tidx(), wave = tid >> 6, lane = tid & 63, l15 = lane & 15, lq = lane >> 4;
  const SsdLds L = ssd_lds(lds);
  bf16_t* UH = (bf16_t*)(p.ws + WS_BIG + BG_UH); float* DE = (float*)(p.ws + WS_BIG + BG_DE);
  for (int item = blockIdx.x; item < 2 * NCH; item += gridDim.x) {
    const int g = item & 1, tc = item >> 1;
    __syncthreads();
    ssd_load(p, l, g, tc, L);
    __syncthreads();
    const int hd = wave, hh = hd >> 1, dir = hd & 1, h = g * 4 + hh, ch = h * 2 + dir, s = scan_idx(tc, dir);
    const float se = L.seS[hd];
    if (lane == 0) DE[ch * NCH + s] = __expf(se);
    float cf[2][8];
#pragma unroll
    for (int ks = 0; ks < 2; ++ks)
#pragma unroll
      for (int e = 0; e < 8; ++e) { const int i = ks * 32 + 8 * lq + e; cf[ks][e] = __expf(se - L.sS[hd * 64 + i]) * L.dtS[hd * 64 + i]; }
    bf16x8 bfr[4][2];
#pragma unroll
    for (int nt = 0; nt < 4; ++nt)
#pragma unroll
      for (int ks = 0; ks < 2; ++ks) { float v[8]; unpack8(*(const bf16x8*)(L.Bmt + (nt * 16 + l15) * LP + ks * 32 + 8 * lq), v);
#pragma unroll
        for (int e = 0; e < 8; ++e) v[e] *= cf[ks][e];
        bfr[nt][ks] = pack8(v); }
    bf16_t* urow = UH + ((size_t)ch * NCH + s) * 4096;
#pragma unroll
    for (int pt = 0; pt < 4; ++pt) { const bf16_t* ap = L.Xt + (hh * 64 + pt * 16 + l15) * LP + 8 * lq;
      const bf16x8 a0 = *(const bf16x8*)ap, a1 = *(const bf16x8*)(ap + 32);
#pragma unroll
      for (int nt = 0; nt < 4; ++nt) { f32x4 acc = {0.f, 0.f, 0.f, 0.f};
        acc = __builtin_amdgcn_mfma_f32_16x16x32_bf16(a0, bfr[nt][0], acc, 0, 0, 0);
        acc = __builtin_amdgcn_mfma_f32_16x16x32_bf16(a1, bfr[nt][1], acc, 0, 0, 0);
#pragma unroll
        for (int r = 0; r < 4; ++r) urow[(pt * 16 + lq * 4 + r) * 64 + nt * 16 + l15] = f2bf(acc[r]); } }
  }
}
DI void phase_ssd_s2(const Params& p) {
  const bf16_t* __restrict__ UH = (const bf16_t*)(p.ws + WS_BIG + BG_UH); bf16_t* __restrict__ SH = (bf16_t*)(p.ws + WS_BIG + BG_SH);
  const float* DE = (const float*)(p.ws + WS_BIG + BG_DE);
  const int npairs = 16 * 2048;
  for (int e = blockIdx.x * 512 + tidx(); e < npairs; e += gridDim.x * 512) {
    const int ch = e >> 11, off = (e & 2047) * 2; float c0 = 0.f, c1 = 0.f;
    for (int s0 = 0; s0 < NCH; s0 += 26) {
      unsigned u[26];
#pragma unroll
      for (int q = 0; q < 26; ++q) u[q] = *(const unsigned*)(UH + ((size_t)ch * NCH + s0 + q) * 4096 + off);
      float dev[26];
#pragma unroll
      for (int q = 0; q < 26; ++q) dev[q] = DE[ch * NCH + s0 + q];
#pragma unroll
      for (int q = 0; q < 26; ++q) { const int s = s0 + q;
        *(unsigned*)(SH + ((size_t)ch * NCH + s) * 4096 + off) = cvtpk(c0, c1);
        const float dec = dev[q]; c0 = dec * c0 + bflo(u[q]); c1 = dec * c1 + bfhi(u[q]); }
    }
  }
}
DI void phase_ssd_s3(const Params& p, int l, unsigned char* lds, int ntc) {
  const int tid = tidx(), wave = tid >> 6, lane = tid & 63, l15 = lane & 15, lq = lane >> 4;
  const SsdLds L = ssd_lds(lds);
  const bf16_t* PD = (const bf16_t*)(p.ws + WS_BIG + BG_PD);
  const bf16_t* SH = (const bf16_t*)(p.ws + WS_BIG + BG_SH);
  bf16_t* OUT = (bf16_t*)(p.ws + WS_BR) + (size_t)3 * T * 512;
  const float* dsk = p.in[21] + l * 8; const float* nw = p.in[22] + l * 512;
  float* ssq4 = L.CB + 64 * 65;
  ssq4 = L.ssS + 128;
  const int hh = wave >> 1, jh = wave & 1;
  for (int item = blockIdx.x; item < 2 * ntc; item += gridDim.x) {
    const int g = item & 1, tc = item >> 1, row0 = chunk_row0(tc), h = g * 4 + hh;
    __syncthreads();
    ssd_load(p, l, g, tc, L);
    __syncthreads();
#pragma unroll
    for (int tt = 0; tt < 2; ++tt) { const int t = wave * 2 + tt, jt = t >> 2, it = t & 3; f32x4 acc = {0.f, 0.f, 0.f, 0.f};
      acc = mm16(L.Cm + jt * 16 * LP, LP, L.Bm + it * 16 * LP, LP, 64, acc, lane);
#pragma unroll
      for (int r = 0; r < 4; ++r) L.CB[(jt * 16 + lq * 4 + r) * 65 + it * 16 + l15] = acc[r]; }
    __syncthreads();
    const float dk = dsk[h];
#pragma unroll 1
    for (int jl = 0; jl < 2; ++jl) { const int jt = jh * 2 + jl, j = jt * 16 + l15;
      f32x4 ys[4];
#pragma unroll
      for (int b = 0; b < 4; ++b) ys[b] = (f32x4){0.f, 0.f, 0.f, 0.f};
#pragma unroll 1
      for (int dir = 0; dir < 2; ++dir) { const int hd = hh * 2 + dir, ch = h * 2 + dir, s = scan_idx(tc, dir);
        const bf16_t* srow = SH + ((size_t)ch * NCH + s) * 4096;
        bf16x8 bh[4][2];
#pragma unroll
        for (int pt = 0; pt < 4; ++pt) { bh[pt][0] = *(const bf16x8*)(srow + (pt * 16 + l15) * 64 + 8 * lq); bh[pt][1] = *(const bf16x8*)(srow + (pt * 16 + l15) * 64 + 32 + 8 * lq); }
        const float sj = L.sS[hd * 64 + j];
        bf16x8 asc[2], acm[2];
#pragma unroll
        for (int ks = 0; ks < 2; ++ks) { float v[8];
#pragma unroll
          for (int e = 0; e < 8; ++e) { const int ii = ks * 32 + 8 * lq + e; const bool ok = dir ? (ii >= j) : (ii <= j);
            v[e] = ok ? __expf(sj - L.sS[hd * 64 + ii]) * L.CB[j * 65 + ii] * L.dtS[hd * 64 + ii] : 0.f; }
          asc[ks] = pack8(v); acm[ks] = *(const bf16x8*)(L.Cm + j * LP + ks * 32 + 8 * lq); }
        float ej[4];
#pragma unroll
        for (int r = 0; r < 4; ++r) ej[r] = __expf(L.sS[hd * 64 + jt * 16 + lq * 4 + r]);
#pragma unroll
        for (int pt = 0; pt < 4; ++pt) { const bf16_t* xp = L.Xt + (hh * 64 + pt * 16 + l15) * LP + 8 * lq;
          f32x4 a1 = {0.f, 0.f, 0.f, 0.f}, a2 = {0.f, 0.f, 0.f, 0.f};
          a1 = __builtin_amdgcn_mfma_f32_16x16x32_bf16(asc[0], *(const bf16x8*)xp, a1, 0, 0, 0);
          a1 = __builtin_amdgcn_mfma_f32_16x16x32_bf16(asc[1], *(const bf16x8*)(xp + 32), a1, 0, 0, 0);
          a2 = __builtin_amdgcn_mfma_f32_16x16x32_bf16(acm[0], bh[pt][0], a2, 0, 0, 0);
          a2 = __builtin_amdgcn_mfma_f32_16x16x32_bf16(acm[1], bh[pt][1], a2, 0, 0, 0);
#pragma unroll
          for (int r = 0; r < 4; ++r) ys[pt][r] += a1[r] + ej[r] * a2[r]; }
      }
#pragma unroll
      for (int r = 0; r < 4; ++r) { const int jr = jt * 16 + lq * 4 + r; float sq = 0.f;
#pragma unroll
        for (int pt = 0; pt < 4; ++pt) { const int pp = pt * 16 + l15;
          const float z = bf2f(PD[(size_t)(row0 + jr) * NB_D + h * 64 + pp]);
          const float v = (ys[pt][r] + dk * bf2f(L.Xt[(hh * 64 + pp) * LP + jr])) * siluf(z);
          const bf16_t vb = f2bf(v); const float vr = bf2f(vb); sq += vr * vr;
          OUT[(size_t)(row0 + jr) * 512 + g * 256 + hh * 64 + pp] = vb; }
        sq += __shfl_xor(sq, 1); sq += __shfl_xor(sq, 2); sq += __shfl_xor(sq, 4); sq += __shfl_xor(sq, 8);
        if (l15 == 0) ssq4[jr * 4 + hh] = sq; }
    }
    __syncthreads();
#pragma unroll 1
    for (int jl = 0; jl < 2; ++jl)
#pragma unroll
      for (int r = 0; r < 4; ++r) { const int jr = (jh * 2 + jl) * 16 + lq * 4 + r;
        const float tot = (ssq4[jr * 4 + 0] + ssq4[jr * 4 + 1]) + (ssq4[jr * 4 + 2] + ssq4[jr * 4 + 3]);
        const float rs = 1.f / sqrtf(tot * (1.f / 256.f) + EPS);
#pragma unroll
        for (int pt = 0; pt < 4; ++pt) { const int c = g * 256 + hh * 64 + pt * 16 + l15;
          bf16_t* op = OUT + (size_t)(row0 + jr) * 512 + c; *op = f2bf(bf2f(*op) * rs * nw[c]); } }
  }
}

extern __shared__ __attribute__((aligned(16))) unsigned char dyn_lds[];

#define XB_TMO      128
#define XB_XCNT(j)  (256  + 64 * (j))
#define XB_XSUB(j)  (1280 + 64 * (j))
#define XB_XGEN(j)  (2304 + 64 * (j))
#define XB_TOP      3328
#define XB_TOPGEN   3392
#define XCD_BAR_WORDS 3456
#define XB_SPIN_CAP (1u << 18)
DI unsigned xb_ld(unsigned* p)              { return __hip_atomic_load(p, __ATOMIC_RELAXED, __HIP_MEMORY_SCOPE_AGENT); }
DI unsigned xb_add(unsigned* p, unsigned v) { return __hip_atomic_fetch_add(p, v, __ATOMIC_RELAXED, __HIP_MEMORY_SCOPE_AGENT); }
DI unsigned xb_xcc_id() { return (unsigned)__builtin_amdgcn_s_getreg((3 << 11) | 20) & 0xFu; }
#define XB_SPIN(cond, bar) do { unsigned _sp = 0; while (cond) { __builtin_amdgcn_s_sleep(1); \
    if ((++_sp & 255u) == 0u) { if (xb_ld(&(bar)[XB_TMO])) break; if (_sp > XB_SPIN_CAP) { atomicAdd(&(bar)[XB_TMO], 1u); break; } } } } while (0)
DI void xcd_barrier_complete(unsigned* bar, unsigned x, unsigned& nloc, unsigned& nx) {
  const unsigned G = gridDim.x;
  unsigned sum, cnt, mine, sp = 0u;
  for (;;) {
    sum = 0u; cnt = 0u; mine = 0u;
#pragma unroll
    for (unsigned j = 0; j < 16; ++j) { const unsigned c = xb_ld(&bar[XB_XCNT(j)]); sum += c; cnt += (c > 0u) ? 1u : 0u; mine = (j == x) ? c : mine; }
    if (sum == G) break;
    __builtin_amdgcn_s_sleep(1);
    if ((++sp & 255u) == 0u) { if (xb_ld(&bar[XB_TMO])) break; if (sp > XB_SPIN_CAP) { atomicAdd(&bar[XB_TMO], 1u); break; } }
  }
  nloc = mine > 0u ? mine : 1u; nx = cnt > 0u ? cnt : 1u;
}
DI void xcd_barrier(unsigned* bar, volatile LAS unsigned* st) {
  asm volatile("s_waitcnt vmcnt(0)" ::: "memory");
  __syncthreads();
  if (tidx() == 0) {
    const unsigned x = xb_xcc_id();
    __builtin_amdgcn_s_waitcnt(0);
    unsigned nloc = st[0], nx = st[1];
    if (nloc == 0u) { xcd_barrier_complete(bar, x, nloc, nx); st[0] = nloc; st[1] = nx; }
    const unsigned old = xb_add(&bar[XB_XSUB(x)], 1u);
    const unsigned gen = old / nloc;
    if (old + 1u == (gen + 1u) * nloc) {
      __builtin_amdgcn_fence(__ATOMIC_RELEASE, "agent");
      asm volatile("s_waitcnt vmcnt(0)" ::: "memory");
      const unsigned og = xb_add(&bar[XB_TOP], 1u);
      const unsigned tg = og / nx;
      if (og + 1u == (tg + 1u) * nx) xb_add(&bar[XB_TOPGEN], 1u);
      else XB_SPIN(xb_ld(&bar[XB_TOPGEN]) == tg, bar);
      __builtin_amdgcn_fence(__ATOMIC_ACQUIRE, "agent");
      xb_add(&bar[XB_XGEN(x)], 1u);
      asm volatile("s_waitcnt vmcnt(0)" ::: "memory");
    } else {
      XB_SPIN(xb_ld(&bar[XB_XGEN(x)]) == gen, bar);
      __builtin_amdgcn_fence(__ATOMIC_ACQUIRE, "agent");
      asm volatile("s_waitcnt vmcnt(0)" ::: "memory");
    }
  }
  __syncthreads();
}

#ifndef REP_ATTN
#define REP_ATTN 1
#endif
#ifndef REP_SCAN
#define REP_SCAN 1
#endif
#ifndef DBG_STOP
#define DBG_STOP 0
#endif
DI void dbg_dump_br(const Params& p, int mode) {
  const bf16_t* BR = (const bf16_t*)(p.ws + WS_BR);
  for (size_t i = (size_t)blockIdx.x * 512 + tidx(); i < (size_t)TL * 1024; i += (size_t)gridDim.x * 512) {
    const size_t row = i >> 10; const int c = (int)(i & 1023), cc = c & 511, hf = c >> 9;
    float v = 0.f;
    if (mode == 0) v = bf2f(BR[((size_t)(hf * 2) * T + row) * 512 + cc]) + bf2f(BR[((size_t)(hf * 2 + 1) * T + row) * 512 + cc]);
    else if (mode == 1) v = bf2f(BR[((size_t)(hf ? 3 : 1) * T + row) * 512 + cc]);
    else if (mode == 2) v = bf2f(BR[((size_t)(hf ? 2 : 0) * T + row) * 512 + cc]);
    p.out[i] = v;
  }
}

DI void dbg_dump_raw(const Params& p, size_t byte_off, size_t cnt = (size_t)TL * 1024) {
  const bf16_t* src = (const bf16_t*)(p.ws + WS_BIG + byte_off);
  for (size_t i = (size_t)blockIdx.x * 512 + tidx(); i < (size_t)TL * 1024; i += (size_t)gridDim.x * 512) p.out[i] = i < cnt ? bf2f(src[i]) : 0.f;
}
typedef const __attribute__((address_space(4))) Params* KP;
DI const Params* launder(KP kp) { asm volatile("" : "+s"(kp)); return (const Params*)kp; }
#define PL (*launder(kp))
DI void gsync_(KP kp) { xcd_barrier((unsigned*)(PL.ws + WS_BAR), (volatile LAS unsigned*)((LAS unsigned char*)dyn_lds + LDS_PHASE)); }
#define gsync(g) gsync_(kp)
template <int l>
DI bool layer_fwd(KP kp, cg::grid_group& grid) {
  unsigned char* lds = dyn_lds; LAS unsigned char* ldsl = (LAS unsigned char*)dyn_lds;
  const int c = blockIdx.x, G = gridDim.x;
  unsigned char* ws = PL.ws;
  const float* MOD = (const float*)(ws + WS_MOD);
  bf16_t* H = (bf16_t*)(ws + WS_H); float* XC = (float*)(ws + WS_XC);
  const bf16_t* WA = (const bf16_t*)(ws + WS_WA); unsigned char* WB = ws + WS_WB; unsigned char* BIG = ws + WS_BIG;
    const float* mod_l = MOD + (size_t)(l * 2 + 0) * 6144; const float* mod_c = MOD + (size_t)(l * 2 + 1) * 6144;
    const float* xin_l = (l == 0) ? PL.in[0] : PL.out; const float* xin_c = (l == 0) ? PL.in[2] : XC;
    const int Mm = (l == 0) ? T : TL;
    const int ntc = (l == 0) ? NCH : 256;
    { pg8::Sched S{(const char*)H, (size_t)D * 2, (const char*)WA + WA_B, 1024, T / 256, NB_B / 256, G, c};
      pg8::EpiStore E{(bf16_t*)(BIG + BG_PB), NB_B, NB_B}; pg8::gemm_phase(ldsl, S, E); }
    gsync(grid);
    if (DBG_STOP == 7 && l == 0) { dbg_dump_raw(PL, BG_PB); return true; }
    if (DBG_STOP == 8 && l == 0) { dbg_dump_raw(PL, BG_PB + (size_t)TL * 1024 * 2, (size_t)T * NB_B - (size_t)TL * 1024); return true; }
    for (int rep = 0; rep < REP_SCAN; ++rep) {
    phase_ml_s1(PL, l, lds);
    gsync(grid);
    if (DBG_STOP == 4 && l == 0) { dbg_dump_raw(PL, BG_UC); return true; }
    phase_ml_s2(PL);
    convert_layer_rest(PL, l, lds, (8 * (MLROW / 2) + 511) / 512);
    gsync(grid);
    if (DBG_STOP == 5 && l == 0) { dbg_dump_raw(PL, BG_SC); return true; }
    phase_ml_s3(PL, l, lds, ntc);
    gsync(grid);
    }
    if (DBG_STOP == 6 && l == 0) { dbg_dump_br(PL, 1); return true; }
    { pg8::Sched S{(const char*)H, (size_t)D * 2, (const char*)WA + WA_D, 1024, T / 256, NB_D / 256, G, c};
      pg8::EpiStore E{(bf16_t*)(BIG + BG_PD), NB_D, NB_D}; pg8::gemm_phase(ldsl, S, E); }
    gsync(grid);
    for (int rep = 0; rep < REP_SCAN; ++rep) {
    phase_ssd_s1(PL, l, lds);
    gsync(grid);
    phase_ssd_s2(PL);
    gsync(grid);
    phase_ssd_s3(PL, l, lds, ntc);
    gsync(grid);
    }
    { pg8::Sched S{(const char*)H, (size_t)D * 2, (const char*)WA + WA_AC, 1024, T / 256, NB_AC / 256, G, c};
      pg8::EpiStore E{(bf16_t*)(BIG + BG_PAC), NB_AC, NB_AC}; pg8::gemm_phase(ldsl, S, E); }
    gsync(grid);
    phase_attn_prep(PL, l);
    for (int k = 0; k < 4; ++k) transpose_job(PL.in[23] + ((size_t)l * 4 + k) * 1024 * 1024, 1024, 1024, 1024, 1024, (bf16_t*)(ws + WS_WA) + (size_t)k * 1024 * 1024, lds);
    gsync(grid);
    { pg8::Sched S{(const char*)(BIG + BG_PAC) + 1536 * 2, (size_t)NB_AC * 2, (const char*)WB + WB_UQ, 384, T / 256, 2, G, c};
      pg8::EpiStore E{(bf16_t*)(BIG + BG_QUP), 384, 384}; pg8::gemm_phase(ldsl, S, E); }
    { pg8::Sched S{(const char*)(BIG + BG_PAC) + 1920 * 2, (size_t)NB_AC * 2, (const char*)WB + WB_UKV, 256, T / 256, 3, G, c};
      pg8::EpiStore E{(bf16_t*)(BIG + BG_KVUP), 768, 768}; pg8::gemm_phase(ldsl, S, E); }
    gsync(grid);
    for (int rep = 0; rep < REP_ATTN; ++rep) { phase_attention(PL, l, (char*)lds);
    gsync(grid); }
    if (DBG_STOP == 1 && l == 0) { dbg_dump_br(PL, 0); return true; }
    if (DBG_STOP == 2 && l == 0) { dbg_dump_br(PL, 1); return true; }
    if (DBG_STOP == 3 && l == 0) { dbg_dump_br(PL, 2); return true; }
    { pg8::Sched S{(const char*)H, (size_t)D * 2, (const char*)WA, 1024, Mm / 256, 16, G, c};
      pg8::EpiAct<0> E{(bf16_t*)BIG, 4096, PL.in[24] + (size_t)l * 4096}; pg8::gemm_phase(ldsl, S, E); }
    gsync(grid);
    { pg8::HSched S{(const char*)(ws + WS_BR), (size_t)512 * 2, (size_t)T * 512 * 2, (const char*)WB + WB_BR, (size_t)1024 * 512 * 2, 512, Mm / 256, 4, G, c};
      pg8::EpiHorner E{(const bf16_t*)BIG, H}; pg8::gemm_phase(ldsl, S, E); }
    transpose_job(PL.in[29] + (size_t)l * 1024 * 4096, 4096, 1024, 4096, 4096, (bf16_t*)(ws + WS_WA), lds);
    gsync(grid);
    { pg8::Sched S{(const char*)H, (size_t)D * 2, (const char*)WB + WB_WO, 1024, TL / 256, 4, G, c};
      pg8::EpiResid E{xin_l, xin_c, PL.out, XC, mod_l + 2048, mod_c + 2048, nullptr}; pg8::gemm_phase(ldsl, S, E); }
    if (l == 0) {
      pg8::KSched S{(const char*)(H + (size_t)TL * D), (size_t)D * 2, (const char*)WB + WB_WO, 1024, 256, 4, 4, G, (c + G / 2) % G};
      pg8::EpiAtomic E{(float*)(ws + WS_ACC)}; pg8::gemm_phase(ldsl, S, E); }
    gsync(grid);
    if (l == 0) phase_ln_affine_mod(PL.out, XC, PL.in[27] + l * 1024, PL.in[28] + l * 1024, mod_l, mod_c, 3072, 4096, H, Mm, PL.in[2], (const float*)(ws + WS_ACC), mod_c + 2048, nullptr);
    else phase_ln_affine_mod(PL.out, XC, PL.in[27] + l * 1024, PL.in[28] + l * 1024, mod_l, mod_c, 3072, 4096, H, Mm);
    transpose_job(PL.in[31] + (size_t)l * 4096 * 1024, 1024, 4096, 1024, 1024, (bf16_t*)WB, lds);
    gsync(grid);
    { pg8::Sched S{(const char*)H, (size_t)D * 2, (const char*)WA, 1024, Mm / 256, 16, G, c};
      pg8::EpiAct<1> E{(bf16_t*)BIG, 4096, PL.in[30] + (size_t)l * 4096}; pg8::gemm_phase(ldsl, S, E); }
    gsync(grid);
    { pg8::Sched S{(const char*)BIG, (size_t)4096 * 2, (const char*)WB, 4096, TL / 256, 4, G, c};
      pg8::EpiResid E{PL.out, XC, PL.out, XC, mod_l + 5120, mod_c + 5120, PL.in[32] + l * 1024}; pg8::gemm_phase(ldsl, S, E); }
    if (l == 0) {
      pg8::KSched S{(const char*)BIG + (size_t)TL * 4096 * 2, (size_t)4096 * 2, (const char*)WB, 4096, 1024, 4, 4, G, (c + G / 2) % G};
      pg8::EpiAtomic E{(float*)(ws + WS_ACC) + (size_t)TC * D}; pg8::gemm_phase(ldsl, S, E); }
    gsync(grid);
    if (l == 0) {
      const float* m1l = MOD + (size_t)(2 + 0) * 6144; const float* m1c = MOD + (size_t)(2 + 1) * 6144;
      phase_ln_affine_mod(PL.out, XC, PL.in[33], PL.in[34], m1l, m1c, 0, 1024, H, T, XC, (const float*)(ws + WS_ACC) + (size_t)TC * D, mod_c + 5120, PL.in[32]);
      convert_layer_start(PL, 1, lds);
      gsync(grid);
    } else {
      phase_ln_affine_mod(PL.out, XC, PL.in[33] + 1024, PL.in[34] + 1024, mod_l, mod_c, 0, 1024, nullptr, TL);
    }
  return false;
}
__global__ void __launch_bounds__(512) fwd_megakernel(Params p_unused) {
  cg::grid_group grid = cg::this_grid();
  unsigned char* lds = dyn_lds;
  KP kp = (KP)__builtin_amdgcn_kernarg_segment_ptr();
  { volatile LAS unsigned* st = (volatile LAS unsigned*)((LAS unsigned char*)dyn_lds + LDS_PHASE);
    if (tidx() == 0) { st[0] = 0u; st[1] = 0u; (void)xb_add((unsigned*)(PL.ws + WS_BAR) + XB_XCNT(xb_xcc_id()), 1u); }
    __syncthreads();
    if (PL.out == nullptr) grid.sync(); }
  phase_setup(PL, lds);
  __syncthreads();
  convert_layer_start(PL, 0, lds);
  gsync(grid);
  { const Params& p = PL; const float* MOD = (const float*)(p.ws + WS_MOD);
    phase_ln_mod(p.in[0], p.in[2], MOD + 0 * 6144, MOD + 1 * 6144, 0, 1024, (bf16_t*)(p.ws + WS_H), T); }
  gsync(grid);
  if (layer_fwd<0>(kp, grid)) return;
  layer_fwd<1>(kp, grid);
}

extern "C" void kernel_launch(void* const* d_in, const int* in_sizes, int n_in, void* d_out, int out_size, void* d_ws, size_t ws_size, hipStream_t stream) {
  static int grid_blocks = 0;
  if (grid_blocks == 0) {
    if (n_in != 35 || out_size != TL * D || ws_size < WS_END) { fprintf(stderr, "kernel_launch: unexpected shapes: n_in %d out %d ws %zu (need %zu)\n", n_in, out_size, ws_size, (size_t)WS_END); grid_blocks = -1; return; }
    int dev = 0, cus = 0, per_cu = 0;
    (void)hipGetDevice(&dev);
    (void)hipDeviceGetAttribute(&cus, hipDeviceAttributeMultiprocessorCount, dev);
    (void)hipFuncSetAttribute((const void*)fwd_megakernel, hipFuncAttributeMaxDynamicSharedMemorySize, LDS_BYTES);
    (void)hipOccupancyMaxActiveBlocksPerMultiprocessor(&per_cu, (const void*)fwd_megakernel, 512, LDS_BYTES);
    if (per_cu < 1) per_cu = 1;
    grid_blocks = cus * 1;
    fprintf(stderr, "kernel_launch: grid %d (cus %d, occupancy %d), ws %zu need %zu\n", grid_blocks, cus, per_cu, ws_size, (size_t)WS_END);
  }
  if (grid_blocks < 0) return;
  Params p{};
  for (int i = 0; i < 35; ++i) p.in[i] = (const float*)d_in[i];
  p.out = (float*)d_out; p.ws = (unsigned char*)d_ws;
  (void)hipMemsetAsync((unsigned char*)d_ws + WS_BAR, 0, XCD_BAR_WORDS * 4, stream);
  void* args[] = {&p};
  hipError_t e = hipLaunchCooperativeKernel((void*)fwd_megakernel, dim3(grid_blocks), dim3(512), args, LDS_BYTES, stream);
  if (e != hipSuccess) fprintf(stderr, "cooperative launch failed: %s (grid %d)\n", hipGetErrorString(e), grid_blocks);
}
```

```cpp
#include <hip/hip_runtime.h>
#include <hip/hip_cooperative_groups.h>
#include <cstdio>
#include <cstdint>
namespace cg = cooperative_groups;
#define DI __device__ __forceinline__
#define LAS __attribute__((address_space(3)))
typedef unsigned short bf16_t;
typedef short bf16x8 __attribute__((ext_vector_type(8)));
typedef short s16x4 __attribute__((ext_vector_type(4)));
typedef float f32x4 __attribute__((ext_vector_type(4)));
typedef float f32x16 __attribute__((ext_vector_type(16)));
typedef unsigned u32x4 __attribute__((ext_vector_type(4)));
typedef unsigned u32x2 __attribute__((ext_vector_type(2)));

constexpr int TL = 16384, TC = 256, T = TL + TC, D = 1024, FF = 4096;
constexpr int NCH = T / 64;
constexpr float ALPHA = 1.4142135623730951f;
constexpr float EPS = 1e-6f;
constexpr int NB_B = 1792, NB_D = 1536, NB_AC = 2304;
constexpr int LDS_PHASE = 156672;
constexpr int LDS_BYTES = LDS_PHASE + 16;
constexpr int MLROW = 8192 + 64;

constexpr size_t al256(size_t x) { return (x + 255) / 256 * 256; }
constexpr size_t WS_TAB32 = 0;
constexpr size_t WS_TAB16 = WS_TAB32 + 256 * 16 * 2 * 4;
constexpr size_t WS_LAM = WS_TAB16 + 256 * 8 * 2 * 4;
constexpr size_t WS_MOD = WS_LAM + 256;
constexpr size_t WS_BAR = al256(WS_MOD + 2 * 2 * 6144 * 4);
constexpr size_t WS_XC = al256(WS_BAR + 16384);
constexpr size_t WS_ACC = al256(WS_XC + (size_t)TC * D * 4);
constexpr size_t WS_WA = al256(WS_ACC + (size_t)2 * TC * D * 4);
constexpr size_t WS_WB = al256(WS_WA + (size_t)5632 * 1024 * 2);
constexpr size_t WS_H = al256(WS_WB + (size_t)4096 * 1024 * 2);
constexpr size_t WS_BR = al256(WS_H + (size_t)T * D * 2);
constexpr size_t WS_BIG = al256(WS_BR + (size_t)4 * T * 512 * 2);
constexpr size_t BIG_BYTES = (size_t)T * 4096 * 2;
constexpr size_t WS_END = WS_BIG + BIG_BYTES;
constexpr size_t BG_PB = 0;
constexpr size_t BG_UC = al256(BG_PB + (size_t)T * NB_B * 2);
constexpr size_t BG_SC = al256(BG_UC + (size_t)8 * NCH * MLROW * 2);
constexpr size_t BG_MSC = al256(BG_SC + (size_t)8 * NCH * MLROW * 2);
constexpr size_t BG_ML_END = BG_MSC + 3 * 8 * NCH * 4;
static_assert(BG_ML_END <= BIG_BYTES, "mlstm overlay");
constexpr size_t BG_PD = 0;
constexpr size_t BG_UH = al256(BG_PD + (size_t)T * NB_D * 2);
constexpr size_t BG_SH = al256(BG_UH + (size_t)16 * NCH * 4096 * 2);
constexpr size_t BG_DE = al256(BG_SH + (size_t)16 * NCH * 4096 * 2);
constexpr size_t BG_SSD_END = BG_DE + 16 * NCH * 4;
static_assert(BG_SSD_END <= BIG_BYTES, "ssd overlay");
constexpr size_t BG_PAC = 0;
constexpr size_t BG_QUP = al256(BG_PAC + (size_t)T * NB_AC * 2);
constexpr size_t BG_KVUP = al256(BG_QUP + (size_t)T * 384 * 2);
static_assert(BG_KVUP + (size_t)T * 768 * 2 <= BIG_BYTES, "attn overlay");
constexpr size_t WB_UQ = 0, WB_UKV = 512 * 384 * 2, WB_BR = WB_UKV + 768 * 256 * 2, WB_WO = WB_BR + (size_t)4 * 1024 * 512 * 2;
static_assert(WB_WO + 1024 * 1024 * 2 <= (size_t)4096 * 1024 * 2, "slot B");
constexpr size_t WA_B = 0, WA_D = (size_t)NB_B * 1024 * 2, WA_AC = WA_D + (size_t)NB_D * 1024 * 2;

struct Params { const float* in[35]; float* out; unsigned char* ws; };

typedef __bf16 bf16x2_t __attribute__((ext_vector_type(2)));
typedef float f32x2_t __attribute__((ext_vector_type(2)));
DI unsigned cvtpk(float lo, float hi) { f32x2_t v = {lo, hi}; bf16x2_t b = __builtin_convertvector(v, bf16x2_t); return __builtin_bit_cast(unsigned, b); }
DI bf16_t f2bf(float x) { return (bf16_t)(cvtpk(x, 0.f) & 0xffffu); }
DI float bf2f(bf16_t v) { return __uint_as_float((unsigned)v << 16); }
DI float bflo(unsigned w) { return __uint_as_float(w << 16); }
DI float bfhi(unsigned w) { return __uint_as_float(w & 0xffff0000u); }
DI float wave_sum(float v) {
#pragma unroll
  for (int o = 1; o < 64; o <<= 1) v += __shfl_xor(v, o);
  return v;
}
DI float wave_max(float v) {
#pragma unroll
  for (int o = 1; o < 64; o <<= 1) v = fmaxf(v, __shfl_xor(v, o));
  return v;
}
DI float sigmoidf(float x) { return __builtin_amdgcn_rcpf(1.f + __expf(-x)); }
DI float siluf(float x) { return x / (1.f + __expf(-x)); }
DI int tidx() { int t = (int)__builtin_amdgcn_workitem_id_x(); asm volatile("" : "+v"(t)); return t; }
#define LDS_WAIT() asm volatile("s_waitcnt lgkmcnt(0)" ::: "memory")

namespace pg8 {
constexpr int BM = 256, BK = 64, HALF = 128, HTB = HALF * BK * 2, STAGE_BYTES = 8 * HTB, NXCD = 8, WGM = 8;
DI int lds_byte(int r, int c) { const int st = (r >> 4) * 2 + (c >> 5), rr = r & 15, cc = c & 31, ob = rr * 64 + cc * 2; return st * 1024 + (ob ^ (((ob >> 9) & 1) << 5)); }
DI void stage_rc(int b, int& R, int& C) { const int st = b / 1024, sb = b % 1024, swz = sb ^ (((sb >> 9) & 1) << 5); R = (st >> 1) * 16 + swz / 64; C = (st & 1) * 32 + (swz % 64) / 2; }
DI int perm32(int rho) { const int n = rho >> 4, i = rho & 15; return 8 * (i >> 2) + 4 * n + (i & 3); }
struct Unit { int pm, pn, k; };
DI void tile_order(int L, int nM, int nN, int& pm, int& pn) {
  const int nwg = nM * nN; int wgid = L;
  { const int q = nwg / NXCD, r = nwg % NXCD, xcd = wgid % NXCD, off = wgid / NXCD; wgid = (xcd < r ? xcd * (q + 1) : r * (q + 1) + (xcd - r) * q) + off; }
  const int nig = WGM * nN, gid = wgid / nig, fm = gid * WGM, gsz = (nM - fm) < WGM ? (nM - fm) : WGM;
  pm = fm + ((wgid % nig) % gsz); pn = (wgid % nig) / gsz;
}
struct Sched {
  const char* A; size_t lda_b; const char* Bt; int K; int nM, nN, G, c;
  DI bool next(int i, Unit& u) const { const long L = (long)i * G + c; if (L >= (long)nM * nN) return false; tile_order((int)L, nM, nN, u.pm, u.pn); u.k = 0; return true; }
  DI const char* a_ptr(const Unit& u) const { return A + (size_t)u.pm * BM * lda_b; }
  DI const char* b_ptr(const Unit& u) const { return Bt + (size_t)u.pn * BM * K * 2; }
  DI int ldb_e() const { return K; }
};
struct HSched {
  const char* A; size_t lda_b; size_t a_ks; const char* Bt; size_t b_ks; int K; int nM, nN, G, c;
  DI bool next(int i, Unit& u) const { const long L = (long)(i >> 2) * G + c; if (L >= (long)nM * nN) return false; tile_order((int)L, nM, nN, u.pm, u.pn); u.k = i & 3; return true; }
  DI const char* a_ptr(const Unit& u) const { return A + (size_t)u.k * a_ks + (size_t)u.pm * BM * lda_b; }
  DI const char* b_ptr(const Unit& u) const { return Bt + (size_t)u.k * b_ks + (size_t)u.pn * BM * K * 2; }
  DI int ldb_e() const { return K; }
};
struct KSched {
  const char* A; size_t lda_b; const char* Bt; int ldb; int K; int nks, nN, G, c;
  DI bool next(int i, Unit& u) const { const long L = (long)i * G + c; if (L >= (long)nN * nks) return false; u.pm = 0; u.pn = (int)(L % nN); u.k = (int)(L / nN); return true; }
  DI const char* a_ptr(const Unit& u) const { return A + (size_t)u.k * K * 2; }
  DI const char* b_ptr(const Unit& u) const { return Bt + ((size_t)u.pn * BM * ldb + (size_t)u.k * K) * 2; }
  DI int ldb_e() const { return ldb; }
};

template <class Epi, class SchedT>
DI void gemm_phase(LAS unsigned char* lds, const SchedT& S, const Epi& E) {
  const int tid = tidx(), wid = __builtin_amdgcn_readfirstlane(tid >> 6), lane = tid & 63, wr = wid >> 2, wc = wid & 3, fr = lane & 15, fq = lane >> 4;
  const int K = S.K, nt = K / BK, ldb = S.ldb_e();
  unsigned voffA[2], voffB[2];
#pragma unroll
  for (int i = 0; i < 2; ++i) { int R, C; stage_rc(tid * 16 + i * 8192, R, C); const int Rb = Epi::PERM ? ((R & ~31) + perm32(R & 31)) : R;
    voffA[i] = (unsigned)(R * (int)S.lda_b + C * 2); voffB[i] = (unsigned)(Rb * ldb + C) * 2u; }
  const size_t kstep = (size_t)(BK * 2);
  const size_t hsA = (size_t)HALF * S.lda_b, hsB = (size_t)HALF * ldb * 2;
  const unsigned ldsw = (unsigned)wid * 1024u;
  const int aoff = lds_byte(wr * 64 + fr, fq * 8), boff = lds_byte(wc * 32 + fr, fq * 8);
#define PG8_SA(b, h) (((b) * 2 + (h)) * HTB)
#define PG8_SB(b, h) ((4 + (b) * 2 + (h)) * HTB)
#define PG8_STAGE(bufoff, gbase, voff) do { _Pragma("unroll") for (int _i = 0; _i < 2; ++_i) \
    __builtin_amdgcn_global_load_lds((const unsigned*)((const char*)(gbase) + (voff)[_i]), (LAS unsigned*)(lds + (bufoff) + ldsw + _i * 8192), 16, 0, 0); } while (0)
#define PG8_LDA(dst, b, h) do { _Pragma("unroll") for (int m = 0; m < 4; ++m) _Pragma("unroll") for (int k = 0; k < 2; ++k) dst[m][k] = *(const LAS bf16x8*)(lds + PG8_SA(b, h) + aoff + m * 2048 + k * 1024); } while (0)
#define PG8_LDB(dst, b, h) do { _Pragma("unroll") for (int n = 0; n < 2; ++n) _Pragma("unroll") for (int k = 0; k < 2; ++k) dst[n][k] = *(const LAS bf16x8*)(lds + PG8_SB(b, h) + boff + n * 2048 + k * 1024); } while (0)
#define PG8_MMA(ai, bj, At, Bt) do { __builtin_amdgcn_s_setprio(1); _Pragma("unroll") for (int m = 0; m < 4; ++m) _Pragma("unroll") for (int n = 0; n < 2; ++n) _Pragma("unroll") for (int k = 0; k < 2; ++k) \
    acc[ai][bj][m][n] = __builtin_amdgcn_mfma_f32_16x16x32_bf16(Bt[n][k], At[m][k], acc[ai][bj][m][n], 0, 0, 0); __builtin_amdgcn_s_setprio(0); } while (0)
#define PG8_WAIT_V(n) asm volatile("s_waitcnt vmcnt(" #n ")" ::: "memory")
#define PG8_WAIT_L(n) asm volatile("s_waitcnt lgkmcnt(" #n ")" ::: "memory")
#define PG8_BAR __builtin_amdgcn_s_barrier()
#define PG8_SCHED __builtin_amdgcn_sched_barrier(0)
  Unit cur, nxt; int ui = 0;
  if (!S.next(0, cur)) return;
  f32x4 acc[2][2][4][2];
#pragma unroll
  for (int a = 0; a < 2; ++a)
#pragma unroll
    for (int b = 0; b < 2; ++b)
#pragma unroll
      for (int m = 0; m < 4; ++m)
#pragma unroll
        for (int n = 0; n < 2; ++n) acc[a][b][m][n] = (f32x4){0.f, 0.f, 0.f, 0.f};
  bf16x8 At[4][2], B0[2][2], B1[2][2];
  const char* cA = S.a_ptr(cur); const char* cB = S.b_ptr(cur);
  PG8_STAGE(PG8_SB(0, 0), cB, voffB); PG8_STAGE(PG8_SA(0, 0), cA, voffA); PG8_STAGE(PG8_SB(0, 1), cB + hsB, voffB); PG8_STAGE(PG8_SA(0, 1), cA + hsA, voffA);
  if (wr == 1) PG8_BAR;
  PG8_WAIT_V(4); PG8_BAR;
  PG8_STAGE(PG8_SB(1, 0), cB + kstep, voffB); PG8_STAGE(PG8_SA(1, 0), cA + kstep, voffA); PG8_STAGE(PG8_SB(1, 1), cB + hsB + kstep, voffB);
  PG8_WAIT_V(6); PG8_BAR;
  for (;;) {
    const bool has_next = S.next(ui + 1, nxt);
    const char* nA = has_next ? S.a_ptr(nxt) : cA; const char* nB = has_next ? S.b_ptr(nxt) : cB;
    for (int t = 0; t < nt; t += 2) {
      const bool last = (t == nt - 2);
      const char* a1 = cA + (size_t)(t + 1) * kstep;
      const char* a2 = last ? nA : cA + (size_t)(t + 2) * kstep; const char* b2 = last ? nB : cB + (size_t)(t + 2) * kstep;
      const char* a3 = a2 + kstep; const char* b3 = b2 + kstep;
      PG8_LDB(B0, 0, 0); PG8_SCHED; PG8_LDA(At, 0, 0); PG8_STAGE(PG8_SA(1, 1), a1 + hsA, voffA);
      PG8_WAIT_L(8); PG8_BAR; PG8_WAIT_L(0); PG8_MMA(0, 0, At, B0); PG8_BAR; PG8_SCHED;
      PG8_LDB(B1, 0, 1); PG8_STAGE(PG8_SB(0, 0), b2, voffB);
      PG8_BAR; PG8_WAIT_L(0); PG8_MMA(0, 1, At, B1); PG8_BAR;
      PG8_LDA(At, 0, 1); PG8_STAGE(PG8_SA(0, 0), a2, voffA);
      PG8_BAR; PG8_WAIT_L(0); PG8_MMA(1, 0, At, B0); PG8_BAR; PG8_SCHED;
      PG8_STAGE(PG8_SB(0, 1), b2 + hsB, voffB);
      PG8_WAIT_V(6); PG8_BAR; PG8_MMA(1, 1, At, B1); PG8_BAR;
      PG8_LDB(B0, 1, 0); PG8_SCHED; PG8_LDA(At, 1, 0); PG8_STAGE(PG8_SA(0, 1), a2 + hsA, voffA);
      PG8_WAIT_L(8); PG8_BAR; PG8_WAIT_L(0); PG8_MMA(0, 0, At, B0); PG8_BAR; PG8_SCHED;
      PG8_LDB(B1, 1, 1); PG8_STAGE(PG8_SB(1, 0), b3, voffB);
      PG8_BAR; PG8_WAIT_L(0); PG8_MMA(0, 1, At, B1); PG8_BAR;
      PG8_LDA(At, 1, 1); PG8_STAGE(PG8_SA(1, 0), a3, voffA);
      PG8_BAR; PG8_WAIT_L(0); PG8_MMA(1, 0, At, B0); PG8_BAR; PG8_SCHED;
      PG8_STAGE(PG8_SB(1, 1), b3 + hsB, voffB);
      PG8_WAIT_V(6); PG8_BAR; PG8_MMA(1, 1, At, B1); PG8_BAR;
    }
    const bool zero = E(acc, cur, wr, wc, fr, fq);
    if (zero) {
#pragma unroll
      for (int a = 0; a < 2; ++a)
#pragma unroll
        for (int b = 0; b < 2; ++b)
#pragma unroll
          for (int m = 0; m < 4; ++m)
#pragma unroll
            for (int n = 0; n < 2; ++n) acc[a][b][m][n] = (f32x4){0.f, 0.f, 0.f, 0.f};
    }
    if (!has_next) break;
    cur = nxt; cA = nA; cB = nB; ++ui;
  }
  PG8_WAIT_V(0);
  if (wr == 0) PG8_BAR;
  PG8_BAR;
#undef PG8_SA
#undef PG8_SB
#undef PG8_STAGE
#undef PG8_LDA
#undef PG8_LDB
#undef PG8_MMA
#undef PG8_WAIT_V
#undef PG8_WAIT_L
#undef PG8_BAR
#undef PG8_SCHED
}

typedef f32x4 Acc[2][2][4][2];
struct EpiStore {
  static constexpr bool PERM = true;
  bf16_t* O; int ldc; int ncols;
  DI bool operator()(Acc& acc, const Unit& u, int wr, int wc, int fr, int fq) const {
    const int row0 = u.pm * BM + wr * 64 + fr, col0 = u.pn * BM + wc * 32 + 8 * fq;
#pragma unroll
    for (int ai = 0; ai < 2; ++ai)
#pragma unroll
      for (int m = 0; m < 4; ++m) { bf16_t* rowp = O + (size_t)(row0 + ai * HALF + m * 16) * ldc;
#pragma unroll
        for (int bj = 0; bj < 2; ++bj) { const int col = col0 + bj * HALF; const f32x4 v0 = acc[ai][bj][m][0], v1 = acc[ai][bj][m][1];
          u32x4 w; w.x = cvtpk(v0[0], v0[1]); w.y = cvtpk(v0[2], v0[3]); w.z = cvtpk(v1[0], v1[1]); w.w = cvtpk(v1[2], v1[3]);
          if (col < ncols) *(u32x4*)(rowp + col) = w; } }
    return true;
  }
};
template <int ACT> struct EpiAct {
  static constexpr bool PERM = true;
  bf16_t* O; int ldc; const float* bias;
  DI bool operator()(Acc& acc, const Unit& u, int wr, int wc, int fr, int fq) const {
    const int row0 = u.pm * BM + wr * 64 + fr, col0 = u.pn * BM + wc * 32 + 8 * fq;
    f32x4 bv[2][2];
#pragma unroll
    for (int bj = 0; bj < 2; ++bj)
#pragma unroll
      for (int n = 0; n < 2; ++n) bv[bj][n] = *(const f32x4*)(bias + col0 + bj * HALF + 4 * n);
#pragma unroll
    for (int ai = 0; ai < 2; ++ai)
#pragma unroll
      for (int m = 0; m < 4; ++m) { bf16_t* rowp = O + (size_t)(row0 + ai * HALF + m * 16) * ldc + col0;
#pragma unroll
        for (int bj = 0; bj < 2; ++bj) { f32x4 v0 = acc[ai][bj][m][0] + bv[bj][0], v1 = acc[ai][bj][m][1] + bv[bj][1];
#pragma unroll
          for (int j = 0; j < 4; ++j) {
            if (ACT == 0) { v0[j] = sigmoidf(v0[j]); v1[j] = sigmoidf(v1[j]); }
            else { const float a = fmaxf(v0[j], 0.f), b = fmaxf(v1[j], 0.f); v0[j] = a * a; v1[j] = b * b; } }
          u32x4 w; w.x = cvtpk(v0[0], v0[1]); w.y = cvtpk(v0[2], v0[3]); w.z = cvtpk(v1[0], v1[1]); w.w = cvtpk(v1[2], v1[3]);
          *(u32x4*)(rowp + bj * HALF) = w; } }
    return true;
  }
};
struct EpiHorner {
  static constexpr bool PERM = true;
  const bf16_t* G; bf16_t* Z;
  DI bool operator()(Acc& acc, const Unit& u, int wr, int wc, int fr, int fq) const {
    const int row0 = u.pm * BM + wr * 64 + fr, col0 = u.pn * BM + wc * 32 + 8 * fq, k = u.k;
#pragma unroll
    for (int ai = 0; ai < 2; ++ai)
#pragma unroll
      for (int m = 0; m < 4; ++m) { const size_t row = (size_t)(row0 + ai * HALF + m * 16);
#pragma unroll
        for (int bj = 0; bj < 2; ++bj) { const int col = col0 + bj * HALF;
          const u32x4 s0 = *(const u32x4*)(G + row * 4096 + k * 1024 + col);
          float f[8] = {bflo(s0.x), bfhi(s0.x), bflo(s0.y), bfhi(s0.y), bflo(s0.z), bfhi(s0.z), bflo(s0.w), bfhi(s0.w)};
          if (k < 3) { const u32x4 s1 = *(const u32x4*)(G + row * 4096 + (k + 1) * 1024 + col);
            const float d[8] = {bflo(s1.x), bfhi(s1.x), bflo(s1.y), bfhi(s1.y), bflo(s1.z), bfhi(s1.z), bflo(s1.w), bfhi(s1.w)};
#pragma unroll
            for (int j = 0; j < 8; ++j) f[j] = f[j] * __builtin_amdgcn_rcpf(d[j]); }
          f32x4 v0 = acc[ai][bj][m][0], v1 = acc[ai][bj][m][1];
#pragma unroll
          for (int j = 0; j < 4; ++j) { v0[j] *= f[j]; v1[j] *= f[4 + j]; }
          acc[ai][bj][m][0] = v0; acc[ai][bj][m][1] = v1;
          if (k == 3) { u32x4 w; w.x = cvtpk(v0[0], v0[1]); w.y = cvtpk(v0[2], v0[3]); w.z = cvtpk(v1[0], v1[1]); w.w = cvtpk(v1[2], v1[3]);
            *(u32x4*)(Z + row * 1024 + col) = w; } } }
    return k == 3;
  }
};
struct EpiResid {
  static constexpr bool PERM = false;
  const float* xin_l; const float* xin_c; float* out_l; float* out_c; const float* g_l; const float* g_c; const float* bias;
  DI bool operator()(Acc& acc, const Unit& u, int wr, int wc, int fr, int fq) const {
    const bool isc = u.pm >= TL / BM;
    const float* xin = isc ? xin_c - (size_t)TL * D : xin_l; float* out = isc ? out_c - (size_t)TL * D : out_l; const float* g = isc ? g_c : g_l;
    const int row0 = u.pm * BM + wr * 64 + fr, col0 = u.pn * BM + wc * 32 + 4 * fq;
    f32x4 gv[2][2], bv[2][2];
#pragma unroll
    for (int bj = 0; bj < 2; ++bj)
#pragma unroll
      for (int n = 0; n < 2; ++n) { gv[bj][n] = *(const f32x4*)(g + col0 + bj * HALF + n * 16); bv[bj][n] = bias ? *(const f32x4*)(bias + col0 + bj * HALF + n * 16) : (f32x4){0.f, 0.f, 0.f, 0.f}; }
#pragma unroll
    for (int ai = 0; ai < 2; ++ai)
#pragma unroll
      for (int m = 0; m < 4; ++m) { const size_t off = (size_t)(row0 + ai * HALF + m * 16) * D + col0;
#pragma unroll
        for (int bj = 0; bj < 2; ++bj)
#pragma unroll
          for (int n = 0; n < 2; ++n) { const f32x4 xv = *(const f32x4*)(xin + off + bj * HALF + n * 16);
            *(f32x4*)(out + off + bj * HALF + n * 16) = xv * ALPHA + gv[bj][n] * (acc[ai][bj][m][n] + bv[bj][n]); } }
    return true;
  }
};
struct EpiAtomic {
  static constexpr bool PERM = false;
  float* ACC;
  DI bool operator()(Acc& acc, const Unit& u, int wr, int wc, int fr, int fq) const {
    const int row0 = wr * 64 + fr, col0 = u.pn * BM + wc * 32 + 4 * fq;
#pragma unroll
    for (int ai = 0; ai < 2; ++ai)
#pragma unroll
      for (int m = 0; m < 4; ++m) { float* rp = ACC + (size_t)(row0 + ai * HALF + m * 16) * D + col0;
#pragma unroll
        for (int bj = 0; bj < 2; ++bj)
#pragma unroll
          for (int n = 0; n < 2; ++n)
#pragma unroll
            for (int e = 0; e < 4; ++e) (void)__hip_atomic_fetch_add(rp + bj * HALF + n * 16 + e, acc[ai][bj][m][n][e], __ATOMIC_RELAXED, __HIP_MEMORY_SCOPE_AGENT); }
    return true;
  }
};
}

namespace att {
constexpr int QBLK = 32, KVBLK = 64;
constexpr float THR = 8.f;
constexpr size_t SHM_V = KVBLK * 128 * 2;
constexpr size_t OFF_K = 3 * SHM_V, OFF_WS = OFF_K + 3 * 64 * 208, OFF_O1 = OFF_WS + 8 * 64 * 4;
static_assert(OFF_O1 + 65536 <= LDS_PHASE, "attn lds");
#define SBAR() __builtin_amdgcn_sched_barrier(0)
DI int crow(int r, int hi) { return (r & 3) + 8 * (r >> 2) + 4 * hi; }
DI bf16x8 ld8(const bf16_t* p) { return *reinterpret_cast<const bf16x8*>(p); }

DI void partialSM(f32x16& p0, f32x16& p1, float& m_reg, float& mn, float& alpha, const float C, const float thr_raw) {
  float pmax = p0[0];
#pragma unroll
  for (int r = 1; r < 16; ++r) pmax = fmaxf(pmax, p0[r]);
#pragma unroll
  for (int r = 0; r < 16; ++r) pmax = fmaxf(pmax, p1[r]);
  { auto rr = __builtin_amdgcn_permlane32_swap(__float_as_uint(pmax), __float_as_uint(pmax), false, false);
    pmax = fmaxf(__uint_as_float(rr[0]), __uint_as_float(rr[1])); }
  if (__builtin_expect(__all(pmax - m_reg <= thr_raw), 1)) { mn = m_reg; alpha = 1.f; }
  else { mn = fmaxf(m_reg, pmax); alpha = __builtin_amdgcn_exp2f((m_reg - mn) * C); m_reg = mn; }
  const float mnC = -mn * C;
#pragma unroll
  for (int r = 0; r < 16; ++r) p0[r] = fmaf(p0[r], C, mnC);
#pragma unroll
  for (int r = 0; r < 16; ++r) p1[r] = fmaf(p1[r], C, mnC);
#pragma unroll
  for (int r = 0; r < 16; ++r) p0[r] = __builtin_amdgcn_exp2f(p0[r]);
}
DI void finishSM(f32x16& p0, f32x16& p1, float alpha, float& l_reg, bf16x8& pa0, bf16x8& pa1, bf16x8& pa2, bf16x8& pa3) {
#pragma unroll
  for (int r = 0; r < 16; ++r) p1[r] = __builtin_amdgcn_exp2f(p1[r]);
  float ps = 0;
#pragma unroll
  for (int r = 0; r < 16; ++r) ps += p0[r];
#pragma unroll
  for (int r = 0; r < 16; ++r) ps += p1[r];
  { auto rr = __builtin_amdgcn_permlane32_swap(__float_as_uint(ps), __float_as_uint(ps), false, false);
    ps = __uint_as_float(rr[0]) + __uint_as_float(rr[1]); }
  l_reg = l_reg * alpha + ps;
#define PK4(P, BASE, OUT) do { unsigned a0 = cvtpk(P[BASE + 0], P[BASE + 1]), a1 = cvtpk(P[BASE + 2], P[BASE + 3]);   \
    unsigned b0 = cvtpk(P[BASE + 4], P[BASE + 5]), b1 = cvtpk(P[BASE + 6], P[BASE + 7]);                              \
    auto r0 = __builtin_amdgcn_permlane32_swap(a0, b0, false, false); auto r1 = __builtin_amdgcn_permlane32_swap(a1, b1, false, false); \
    u32x4 w = {r0[0], r1[0], r0[1], r1[1]}; OUT = *reinterpret_cast<bf16x8*>(&w); } while (0)
  PK4(p0, 0, pa0); PK4(p0, 8, pa1); PK4(p1, 0, pa2); PK4(p1, 8, pa3);
#undef PK4
}
template <int DQK>
DI void qkt(f32x16& p0, f32x16& p1, const char* Ks, const bf16x8* qr, int r32, int hi) {
  constexpr int KP = DQK * 2 + 16;
  p0 = f32x16{}; p1 = f32x16{};
#pragma unroll
  for (int d0 = 0; d0 < DQK / 16; ++d0) { const int cb = (d0 * 16 + hi * 8) * 2;
    bf16x8 b0 = *reinterpret_cast<const bf16x8*>(Ks + r32 * KP + cb);
    bf16x8 b1 = *reinterpret_cast<const bf16x8*>(Ks + (32 + r32) * KP + cb);
    p0 = __builtin_amdgcn_mfma_f32_32x32x16_bf16(b0, qr[d0], p0, 0, 0, 0);
    p1 = __builtin_amdgcn_mfma_f32_32x32x16_bf16(b1, qr[d0], p1, 0, 0, 0); }
}
DI int v_st(int k, int c) { const int kk = (k & ~0xC) | ((k & 4) << 1) | ((k & 8) >> 1); return ((kk >> 3) * 4 + (c >> 5)) * 512 + ((kk & 7) * 32 + (c & 31)) * 2; }
DI int v_rd_base(int lane) { return ((lane & 3) << 3) | (((lane >> 2) & 3) << 6) | (((lane >> 4) & 1) << 5) | (((lane >> 5) & 1) << 8); }
constexpr int v_rd_off(int d0, int ks, int half) { return d0 * 512 + ks * 4096 + half * 2048; }
template <int OFF> DI s16x4 tr_read(int vb) {
  s16x4 r; asm volatile("ds_read_b64_tr_b16 %0, %1 offset:%2" : "=&v"(r) : "v"(vb), "i"(OFF) : "memory"); return r;
}
template <int D0> DI void pv_one(f32x16& od, int vb, bf16x8 pa0, bf16x8 pa1, bf16x8 pa2, bf16x8 pa3) {
  const s16x4 l0 = tr_read<v_rd_off(D0, 0, 0)>(vb), h0 = tr_read<v_rd_off(D0, 0, 1)>(vb), l1 = tr_read<v_rd_off(D0, 1, 0)>(vb), h1 = tr_read<v_rd_off(D0, 1, 1)>(vb);
  const s16x4 l2 = tr_read<v_rd_off(D0, 2, 0)>(vb), h2 = tr_read<v_rd_off(D0, 2, 1)>(vb), l3 = tr_read<v_rd_off(D0, 3, 0)>(vb), h3 = tr_read<v_rd_off(D0, 3, 1)>(vb);
  asm volatile("s_waitcnt lgkmcnt(0)" ::: "memory"); SBAR();
#define PK(L, H) (bf16x8){L[0], L[1], L[2], L[3], H[0], H[1], H[2], H[3]}
  od = __builtin_amdgcn_mfma_f32_32x32x16_bf16(pa0, PK(l0, h0), od, 0, 0, 0);
  od = __builtin_amdgcn_mfma_f32_32x32x16_bf16(pa1, PK(l1, h1), od, 0, 0, 0);
  od = __builtin_amdgcn_mfma_f32_32x32x16_bf16(pa2, PK(l2, h2), od, 0, 0, 0);
  od = __builtin_amdgcn_mfma_f32_32x32x16_bf16(pa3, PK(l3, h3), od, 0, 0, 0);
#undef PK
}
template <int KS> DI void pv_step(f32x16* o, int vb, bf16x8 pa) {
  const s16x4 l0 = tr_read<v_rd_off(0, KS, 0)>(vb), h0 = tr_read<v_rd_off(0, KS, 1)>(vb), l1 = tr_read<v_rd_off(1, KS, 0)>(vb), h1 = tr_read<v_rd_off(1, KS, 1)>(vb);
  const s16x4 l2 = tr_read<v_rd_off(2, KS, 0)>(vb), h2 = tr_read<v_rd_off(2, KS, 1)>(vb), l3 = tr_read<v_rd_off(3, KS, 0)>(vb), h3 = tr_read<v_rd_off(3, KS, 1)>(vb);
  asm volatile("s_waitcnt lgkmcnt(0)" ::: "memory"); SBAR();
#define PK(L, H) (bf16x8){L[0], L[1], L[2], L[3], H[0], H[1], H[2], H[3]}
  o[0] = __builtin_amdgcn_mfma_f32_32x32x16_bf16(pa, PK(l0, h0), o[0], 0, 0, 0);
  o[1] = __builtin_amdgcn_mfma_f32_32x32x16_bf16(pa, PK(l1, h1), o[1], 0, 0, 0);
  o[2] = __builtin_amdgcn_mfma_f32_32x32x16_bf16(pa, PK(l2, h2), o[2], 0, 0, 0);
  o[3] = __builtin_amdgcn_mfma_f32_32x32x16_bf16(pa, PK(l3, h3), o[3], 0, 0, 0);
#undef PK
}
DI void pv_d0(f32x16* o, int vb, bf16x8 pa0, bf16x8 pa1, bf16x8 pa2, bf16x8 pa3) {
  pv_step<0>(o, vb, pa0); pv_step<1>(o, vb, pa1); pv_step<2>(o, vb, pa2); pv_step<3>(o, vb, pa3);
}

template <int DQK>
DI void attn_body(const bf16_t* __restrict__ Qb, int ldq, const bf16_t* __restrict__ K0, int ldk0, const bf16_t* __restrict__ K1, int ldk1,
                  const bf16_t* __restrict__ Vh, int ldv, int seq, float scale, char* lds, f32x16 (&o)[4], float (&rli)[16]) {
  constexpr int KP = DQK * 2 + 16, SHM_K = 64 * KP, CPR = DQK / 8;
  const float C = scale * 1.4426950408889634f, thr_raw = THR / scale;
  const int tid = tidx(), wid = tid >> 6, lane = tid & 63, r32 = lane & 31, hi = lane >> 5;
  char* V_lds = lds; char* K_lds = lds + OFF_K;
  float* wsl = (float*)(lds + OFF_WS) + wid * 64; float* li_l = wsl; float* al_l = wsl + 32;
  float m_reg = -1e30f, l_reg = 0; bf16x8 qr[DQK / 16];
#pragma unroll
  for (int d = 0; d < 4; ++d) o[d] = f32x16{};
  const bf16_t* Qw = Qb + (long)(wid * QBLK + r32) * ldq + hi * 8;
#pragma unroll
  for (int d0 = 0; d0 < DQK / 16; ++d0) qr[d0] = ld8(Qw + d0 * 16);
  const int sr = tid >> 4, sc = (tid & 15) * 8, vst0 = v_st(sr, sc), vst1 = v_st(32 + sr, sc);
  const int vb0 = (int)(uintptr_t)V_lds + v_rd_base(lane);
  const int kc0 = tid, kc1 = 512 + (tid & 255);
  const int kr0 = kc0 / CPR, kcc0 = kc0 % CPR, kr1 = (DQK == 96) ? kc1 / CPR : 0, kcc1 = (DQK == 96) ? kc1 % CPR : 0;
  const bf16_t* kp0 = (kcc0 < 8) ? K0 + (long)kr0 * ldk0 + kcc0 * 8 : K1 + (long)kr0 * ldk1 + (kcc0 - 8) * 8;
  const long kst0 = (kcc0 < 8) ? (long)64 * ldk0 : (long)64 * ldk1;
  const bf16_t* kp1 = (kcc1 < 8) ? K0 + (long)kr1 * ldk0 + kcc1 * 8 : K1 + (long)kr1 * ldk1 + (kcc1 - 8) * 8;
  const long kst1 = (kcc1 < 8) ? (long)64 * ldk0 : (long)64 * ldk1;
  const int kw0 = kr0 * KP + kcc0 * 16, kw1 = kr1 * KP + kcc1 * 16;
  struct { bf16x8 vs0, vs1, ks0, ks1; } sr_[2];
#define SLOAD(i, t) do { sr_[i].vs0 = ld8(&Vh[(long)((t) * 64 + sr) * ldv + sc]); sr_[i].vs1 = ld8(&Vh[(long)((t) * 64 + 32 + sr) * ldv + sc]); \
    sr_[i].ks0 = ld8(kp0 + (long)(t) * kst0); if (DQK == 96) sr_[i].ks1 = ld8(kp1 + (long)(t) * kst1); } while (0)
#define SWRITE(b, i) do { *(bf16x8*)(V_lds + (b) * SHM_V + vst0) = sr_[i].vs0; *(bf16x8*)(V_lds + (b) * SHM_V + vst1) = sr_[i].vs1; \
    *(bf16x8*)(K_lds + (b) * SHM_K + kw0) = sr_[i].ks0; if (DQK == 96) *(bf16x8*)(K_lds + (b) * SHM_K + kw1) = sr_[i].ks1; } while (0)
#define SWAIT() do { if (DQK == 96) asm volatile("s_waitcnt vmcnt(4)" ::: "memory"); else asm volatile("s_waitcnt vmcnt(3)" ::: "memory"); } while (0)
#define RESC(a) do { if (__any((a) < 1.f)) { if (hi == 0) al_l[r32] = (a); asm volatile("s_waitcnt lgkmcnt(0)" ::: "memory"); \
    _Pragma("unroll") for (int d = 0; d < 4; ++d) _Pragma("unroll") for (int r = 0; r < 16; ++r) o[d][r] *= al_l[crow(r, hi)]; } } while (0)
  f32x16 pA0, pA1, pB0, pB1; float mnA, mnB, alA, alB; bf16x8 pa0, pa1, pa2, pa3; const int NT = seq / KVBLK;
  constexpr int SE = 0, SO = 1;
  SLOAD(SE, 0); asm volatile("s_waitcnt vmcnt(0)" ::: "memory"); SWRITE(0, SE); __syncthreads();
  qkt<DQK>(pA0, pA1, K_lds, qr, r32, hi); partialSM(pA0, pA1, m_reg, mnA, alA, C, thr_raw);
  SLOAD(SO, 1); if (2 < NT) SLOAD(SE, 2);
  SWAIT(); SWRITE(1, SO); __syncthreads();
  int b = 1;
  for (int j = 1; j + 1 < NT; j += 2) {
    const int b1 = (b == 2) ? 0 : b + 1, b2 = (b == 0) ? 2 : b - 1;
    SBAR(); qkt<DQK>(pB0, pB1, K_lds + b * SHM_K, qr, r32, hi);
    finishSM(pA0, pA1, alA, l_reg, pa0, pa1, pa2, pa3); SBAR();
    SLOAD(SO, j + 2); SBAR();
    pv_d0(o, vb0 + b2 * (int)SHM_V, pa0, pa1, pa2, pa3); partialSM(pB0, pB1, m_reg, mnB, alB, C, thr_raw);
    SWAIT(); SWRITE(b1, SE);
    RESC(alB); __syncthreads();
    SBAR(); qkt<DQK>(pA0, pA1, K_lds + b1 * SHM_K, qr, r32, hi);
    finishSM(pB0, pB1, alB, l_reg, pa0, pa1, pa2, pa3); SBAR();
    if (j + 3 < NT) SLOAD(SE, j + 3); SBAR();
    pv_d0(o, vb0 + b * (int)SHM_V, pa0, pa1, pa2, pa3); partialSM(pA0, pA1, m_reg, mnA, alA, C, thr_raw);
    SWAIT(); SWRITE(b2, SO);
    RESC(alA); __syncthreads();
    b = b2;
  }
  { const int b2 = (b == 0) ? 2 : b - 1;
    SBAR(); qkt<DQK>(pB0, pB1, K_lds + b * SHM_K, qr, r32, hi);
    finishSM(pA0, pA1, alA, l_reg, pa0, pa1, pa2, pa3); SBAR();
    pv_d0(o, vb0 + b2 * (int)SHM_V, pa0, pa1, pa2, pa3); partialSM(pB0, pB1, m_reg, mnB, alB, C, thr_raw);
    RESC(alB);
    finishSM(pB0, pB1, alB, l_reg, pa0, pa1, pa2, pa3); SBAR();
    pv_d0(o, vb0 + b * (int)SHM_V, pa0, pa1, pa2, pa3); }
  if (hi == 0) li_l[r32] = l_reg; asm volatile("s_waitcnt lgkmcnt(0)" ::: "memory");
#pragma unroll
  for (int r = 0; r < 16; ++r) rli[r] = 1.f / li_l[crow(r, hi)];
  __syncthreads();
#undef SLOAD
#undef SWRITE
#undef SWAIT
#undef RESC
}

constexpr int D2_KT = 64 * 144, D2_KBUF = 2 * D2_KT, D2_OFF_K = 2 * (int)SHM_V, D2_OFF_Q = D2_OFF_K + 2 * D2_KBUF, D2_QM = 256 * 144, D2_OFF_WS = D2_OFF_Q + 2 * D2_QM;
static_assert(D2_OFF_WS + 8 * 512 <= LDS_PHASE, "diff2 lds");
DI void qkt_l(f32x16& p0, f32x16& p1, const char* Ks, const char* Qrow, int r32, int hi) {
  p0 = f32x16{}; p1 = f32x16{};
#pragma unroll
  for (int d0 = 0; d0 < 4; ++d0) { const int cb = (d0 * 16 + hi * 8) * 2;
    const bf16x8 qf = *reinterpret_cast<const bf16x8*>(Qrow + cb);
    const bf16x8 b0 = *reinterpret_cast<const bf16x8*>(Ks + r32 * 144 + cb);
    const bf16x8 b1 = *reinterpret_cast<const bf16x8*>(Ks + (32 + r32) * 144 + cb);
    p0 = __builtin_amdgcn_mfma_f32_32x32x16_bf16(b0, qf, p0, 0, 0, 0);
    p1 = __builtin_amdgcn_mfma_f32_32x32x16_bf16(b1, qf, p1, 0, 0, 0); }
}
template <int KS> DI void pv2_step(f32x16* o1, f32x16* o2, int vb, bf16x8 pa, bf16x8 pb) {
  const s16x4 l0 = tr_read<v_rd_off(0, KS, 0)>(vb), h0 = tr_read<v_rd_off(0, KS, 1)>(vb), l1 = tr_read<v_rd_off(1, KS, 0)>(vb), h1 = tr_read<v_rd_off(1, KS, 1)>(vb);
  const s16x4 l2 = tr_read<v_rd_off(2, KS, 0)>(vb), h2 = tr_read<v_rd_off(2, KS, 1)>(vb), l3 = tr_read<v_rd_off(3, KS, 0)>(vb), h3 = tr_read<v_rd_off(3, KS, 1)>(vb);
  asm volatile("s_waitcnt lgkmcnt(0)" ::: "memory"); SBAR();
#define PK(L, H) (bf16x8){L[0], L[1], L[2], L[3], H[0], H[1], H[2], H[3]}
  const bf16x8 v0 = PK(l0, h0), v1 = PK(l1, h1), v2 = PK(l2, h2), v3 = PK(l3, h3);
#undef PK
  o1[0] = __builtin_amdgcn_mfma_f32_32x32x16_bf16(pa, v0, o1[0], 0, 0, 0); o2[0] = __builtin_amdgcn_mfma_f32_32x32x16_bf16(pb, v0, o2[0], 0, 0, 0);
  o1[1] = __builtin_amdgcn_mfma_f32_32x32x16_bf16(pa, v1, o1[1], 0, 0, 0); o2[1] = __builtin_amdgcn_mfma_f32_32x32x16_bf16(pb, v1, o2[1], 0, 0, 0);
  o1[2] = __builtin_amdgcn_mfma_f32_32x32x16_bf16(pa, v2, o1[2], 0, 0, 0); o2[2] = __builtin_amdgcn_mfma_f32_32x32x16_bf16(pb, v2, o2[2], 0, 0, 0);
  o1[3] = __builtin_amdgcn_mfma_f32_32x32x16_bf16(pa, v3, o1[3], 0, 0, 0); o2[3] = __builtin_amdgcn_mfma_f32_32x32x16_bf16(pb, v3, o2[3], 0, 0, 0);
}
DI void attn_diff2(const bf16_t* __restrict__ Qg, int ldq, const bf16_t* __restrict__ Kg, int ldk, const bf16_t* __restrict__ Vg, int ldv, int seq, float scale,
                   char* lds, f32x16 (&o1)[4], f32x16 (&o2)[4], float (&rli1)[16], float (&rli2)[16]) {
  const float C = scale * 1.4426950408889634f, thr_raw = THR / scale;
  const int tid = tidx(), wid = tid >> 6, lane = tid & 63, r32 = lane & 31, hi = lane >> 5;
  char* V_lds = lds; char* K_lds = lds + D2_OFF_K; char* Q_lds = lds + D2_OFF_Q;
  float* wsl = (float*)(lds + D2_OFF_WS) + wid * 128; float* li1 = wsl; float* li2 = wsl + 32; float* al_l = wsl + 64;
#pragma unroll
  for (int i = 0; i < 8; ++i) { const int ch = tid + 512 * i, row = ch >> 4, cc = ch & 15;
    *(bf16x8*)(Q_lds + (cc >> 3) * D2_QM + row * 144 + (cc & 7) * 16) = ld8(Qg + (long)row * ldq + cc * 8); }
  const char* Q1row = Q_lds + (wid * 32 + r32) * 144; const char* Q2row = Q1row + D2_QM;
  const int sr = tid >> 4, sc = (tid & 15) * 8, vst0 = v_st(sr, sc), vst1 = v_st(32 + sr, sc);
  const int vb0 = (int)(uintptr_t)V_lds + v_rd_base(lane);
  const int kr = tid >> 3, kc = tid & 7, kw = kr * 144 + kc * 16;
  const bf16_t* kp = Kg + (long)kr * ldk + kc * 8;
  bf16x8 sv0, sv1, sk0, sk1;
#define SLOAD2(t) do { sv0 = ld8(&Vg[(long)((t) * 64 + sr) * ldv + sc]); sv1 = ld8(&Vg[(long)((t) * 64 + 32 + sr) * ldv + sc]); \
    sk0 = ld8(kp + (long)(t) * 64 * ldk); sk1 = ld8(kp + (long)(t) * 64 * ldk + 64); } while (0)
#define SWRITE2(b) do { *(bf16x8*)(V_lds + (b) * SHM_V + vst0) = sv0; *(bf16x8*)(V_lds + (b) * SHM_V + vst1) = sv1; \
    *(bf16x8*)(K_lds + (b) * D2_KBUF + kw) = sk0; *(bf16x8*)(K_lds + (b) * D2_KBUF + D2_KT + kw) = sk1; } while (0)
#define RESC2(o, a) do { if (__any((a) < 1.f)) { if (hi == 0) al_l[r32] = (a); asm volatile("s_waitcnt lgkmcnt(0)" ::: "memory"); \
    _Pragma("unroll") for (int d = 0; d < 4; ++d) _Pragma("unroll") for (int r = 0; r < 16; ++r) o[d][r] *= al_l[crow(r, hi)]; } } while (0)
  float m1 = -1e30f, m2 = -1e30f, l1 = 0.f, l2 = 0.f;
#pragma unroll
  for (int d = 0; d < 4; ++d) { o1[d] = f32x16{}; o2[d] = f32x16{}; }
  const int NT = seq / KVBLK;
  SLOAD2(0); asm volatile("s_waitcnt vmcnt(0)" ::: "memory"); SWRITE2(0); __syncthreads();
  if (1 < NT) SLOAD2(1);
  for (int t = 0; t < NT; ++t) {
    const int cur = t & 1;
    f32x16 p0, p1, q0, q1; float mn, al1, al2; bf16x8 a0, a1, a2, a3, b0, b1, b2, b3;
    qkt_l(p0, p1, K_lds + cur * D2_KBUF, Q1row, r32, hi);
    qkt_l(q0, q1, K_lds + cur * D2_KBUF + D2_KT, Q2row, r32, hi);
    partialSM(p0, p1, m1, mn, al1, C, thr_raw); finishSM(p0, p1, al1, l1, a0, a1, a2, a3);
    partialSM(q0, q1, m2, mn, al2, C, thr_raw); finishSM(q0, q1, al2, l2, b0, b1, b2, b3);
    RESC2(o1, al1); RESC2(o2, al2);
    if (t + 1 < NT) { SWRITE2(cur ^ 1); if (t + 2 < NT) SLOAD2(t + 2); }
    const int vb = vb0 + cur * (int)SHM_V;
    pv2_step<0>(o1, o2, vb, a0, b0); pv2_step<1>(o1, o2, vb, a1, b1); pv2_step<2>(o1, o2, vb, a2, b2); pv2_step<3>(o1, o2, vb, a3, b3);
    __syncthreads();
  }
  if (hi == 0) { li1[r32] = l1; li2[r32] = l2; } asm volatile("s_waitcnt lgkmcnt(0)" ::: "memory");
#pragma unroll
  for (int r = 0; r < 16; ++r) { rli1[r] = 1.f / li1[crow(r, hi)]; rli2[r] = 1.f / li2[crow(r, hi)]; }
  __syncthreads();
#undef SLOAD2
#undef SWRITE2
#undef RESC2
}
}

DI f32x4 mm16(const bf16_t* A, int lda, const bf16_t* Bt, int ldb, int K, f32x4 acc, int lane) {
  const bf16_t* ap = A + (lane & 15) * lda + 8 * (lane >> 4);
  const bf16_t* bp = Bt + (lane & 15) * ldb + 8 * (lane >> 4);
  for (int k0 = 0; k0 < K; k0 += 32) {
    const bf16x8 a = *(const bf16x8*)(ap + k0), b = *(const bf16x8*)(bp + k0);
    acc = __builtin_amdgcn_mfma_f32_16x16x32_bf16(a, b, acc, 0, 0, 0);
  }
  return acc;
}
constexpr int LP = 72;

DI int chunk_row0(int tc) { return tc * 64; }
DI int scan_idx(int tc, int dir) { return tc < 256 ? (dir == 0 ? 4 + tc : 4 + (255 - tc)) : (dir == 0 ? tc - 256 : 3 - (tc - 256)); }
DI void stream_bounds(int row0, int& lo, int& hi) { if (row0 < TL) { lo = 0; hi = TL; } else { lo = TL; hi = T; } }

DI void sincos_d(double a, float& c, float& s) {
  const double TWO_PI = 6.283185307179586476925287;
  const double k = rint(a / TWO_PI); const double r = a - k * TWO_PI; const double r2 = r * r;
  double ss = 1.0, cc = 1.0;
#pragma unroll
  for (int n = 13; n >= 1; --n) { ss = 1.0 - r2 / (double)((2 * n) * (2 * n + 1)) * ss; cc = 1.0 - r2 / (double)((2 * n - 1) * (2 * n)) * cc; }
  s = (float)(r * ss); c = (float)cc;
}
DI void phase_setup(const Params& p, unsigned char* lds) {
  const int tid = tidx();
  float* sx = (float*)lds;
  float* red = sx + 2048;
  float* MOD = (float*)(p.ws + WS_MOD);
  for (int i = tid; i < 1024; i += 512) { sx[i] = siluf(p.in[1][i]); sx[1024 + i] = siluf(p.in[3][i]); }
  __syncthreads();
  for (int item = blockIdx.x; item < 384; item += gridDim.x) {
    const int l = item / 192, cb = item % 192, cl = tid & 31, ks = tid >> 5;
    const float* w = p.in[4] + (size_t)l * 1024 * 6144 + cb * 32 + cl;
    float a0 = 0.f, a1 = 0.f;
    for (int k = ks * 64; k < ks * 64 + 64; ++k) { const float wv = w[(size_t)k * 6144]; a0 += sx[k] * wv; a1 += sx[1024 + k] * wv; }
    red[(0 * 16 + ks) * 32 + cl] = a0; red[(1 * 16 + ks) * 32 + cl] = a1;
    __syncthreads();
    if (tid < 64) { const int s = tid >> 5; float sum = 0.f;
      for (int q = 0; q < 16; ++q) sum += red[(s * 16 + q) * 32 + cl];
      MOD[(size_t)(l * 2 + s) * 6144 + cb * 32 + cl] = sum + p.in[5][l * 6144 + cb * 32 + cl]; }
    __syncthreads();
  }
  { float* acc = (float*)(p.ws + WS_ACC); for (int i = blockIdx.x * 512 + tid; i < 2 * TC * D; i += gridDim.x * 512) acc[i] = 0.f; }
  const int gt = blockIdx.x * 512 + tid;
  if (gt < 256 * 16) { const int pos = gt >> 4, i = gt & 15; const double inv = exp2(-(double)i / 16.0 * 13.287712379549449);
    float c, s; sincos_d((double)pos * inv, c, s); float* t = (float*)(p.ws + WS_TAB32) + gt * 2; t[0] = c; t[1] = s; }
  else if (gt < 256 * 16 + 256 * 8) { const int g2 = gt - 256 * 16; const int pos = g2 >> 3, i = g2 & 7; const double inv = exp2(-(double)i / 8.0 * 13.287712379549449);
    float c, s; sincos_d((double)pos * inv, c, s); float* t = (float*)(p.ws + WS_TAB16) + g2 * 2; t[0] = c; t[1] = s; }
  if (blockIdx.x == gridDim.x - 1 && tid < 128) {
    const int l = tid >> 6, lane = tid & 63; const float* lam = p.in[7] + l * 4 * 64;
    const float s1 = wave_sum(lam[lane] * lam[64 + lane]), s2 = wave_sum(lam[128 + lane] * lam[192 + lane]);
    const float lam_init = 0.8f - 0.6f * expf(-0.3f * (float)l);
    if (lane == 0) ((float*)(p.ws + WS_LAM))[l] = expf(s1) - expf(s2) + lam_init;
  }
}

DI void transpose_job(const float* __restrict__ src, int ld, int K, int nvalid, int npad, bf16_t* __restrict__ dst, unsigned char* lds, int wg0 = 0) {
  const int wave = tidx() >> 6, lane = tidx() & 63;
  float* scr = (float*)lds + wave * (64 * 33);
  if ((int)blockIdx.x < wg0) return;
  const int gw = ((int)blockIdx.x - wg0) * 8 + wave, NGW = ((int)gridDim.x - wg0) * 8;
  const int nblk = npad / 32, nitems = (K / 64) * nblk;
  for (int item = gw; item < nitems; item += NGW) {
    const int kb = item / nblk, nb = item % nblk, k0 = 64 * kb, n0 = 32 * nb;
    const int nn = n0 + (lane & 31); const bool ok = nn < nvalid;
#pragma unroll 8
    for (int i = 0; i < 32; ++i) { const int kk = 2 * i + (lane >> 5); scr[kk * 33 + (lane & 31)] = ok ? src[(size_t)(k0 + kk) * ld + nn] : 0.f; }
    LDS_WAIT();
    const int c = lane & 7;
#pragma unroll
    for (int j = 0; j < 4; ++j) { const int n = (lane >> 3) + 8 * j; const float* s = scr + (8 * c) * 33 + n;
      u32x4 o; o.x = cvtpk(s[0 * 33], s[1 * 33]); o.y = cvtpk(s[2 * 33], s[3 * 33]); o.z = cvtpk(s[4 * 33], s[5 * 33]); o.w = cvtpk(s[6 * 33], s[7 * 33]);
      *(u32x4*)(dst + (size_t)(n0 + n) * K + k0 + 8 * c) = o; }
    LDS_WAIT();
  }
}
DI void convert_layer_start(const Params& p, int l, unsigned char* lds) {
  const float* w_in = p.in[6] + (size_t)l * 1024 * 5056;
  bf16_t* wa = (bf16_t*)(p.ws + WS_WA);
  transpose_job(w_in + 1536, 5056, 1024, 1552, NB_B, (bf16_t*)((unsigned char*)wa + WA_B), lds);
}
DI void convert_layer_rest(const Params& p, int l, unsigned char* lds, int wg0) {
  const float* w_in = p.in[6] + (size_t)l * 1024 * 5056;
  bf16_t* wa = (bf16_t*)(p.ws + WS_WA); unsigned char* wb = p.ws + WS_WB;
  transpose_job(w_in + 3760, 5056, 1024, 1296, NB_D, (bf16_t*)((unsigned char*)wa + WA_D), lds, wg0);
  transpose_job(w_in + 0, 5056, 1024, 1536, 1536, (bf16_t*)((unsigned char*)wa + WA_AC), lds, wg0);
  transpose_job(w_in + 3088, 5056, 1024, 672, 768, (bf16_t*)((unsigned char*)wa + WA_AC) + (size_t)1536 * 1024, lds, wg0);
  transpose_job(p.in[15] + (size_t)l * 384 * 384, 384, 384, 384, 512, (bf16_t*)(wb + WB_UQ), lds, wg0);
  transpose_job(p.in[16] + (size_t)l * 256 * 768, 768, 256, 768, 768, (bf16_t*)(wb + WB_UKV), lds, wg0);
  for (int k = 0; k < 4; ++k) transpose_job(p.in[25] + ((size_t)l * 4 + k) * 512 * 1024, 1024, 512, 1024, 1024, (bf16_t*)(wb + WB_BR) + (size_t)k * 1024 * 512, lds, wg0);
  transpose_job(p.in[26] + (size_t)l * 1024 * 1024, 1024, 1024, 1024, 1024, (bf16_t*)(wb + WB_WO), lds, wg0);
}

DI void ln_stats(const f32x4 (&v)[4], float& mean, float& rstd) {
  float s = 0.f;
#pragma unroll
  for (int j = 0; j < 4; ++j) s += (v[j].x + v[j].y) + (v[j].z + v[j].w);
  mean = wave_sum(s) * (1.f / D); float s2 = 0.f;
#pragma unroll
  for (int j = 0; j < 4; ++j) { const f32x4 d = v[j] - mean; s2 += (d.x * d.x + d.y * d.y) + (d.z * d.z + d.w * d.w); }
  rstd = 1.f / sqrtf(wave_sum(s2) * (1.f / D) + EPS);
}
DI void phase_ln_mod(const float* xl, const float* xc, const float* mod_l, const float* mod_c, int sh_off, int sc_off, bf16_t* H, int nrows) {
  const int wave = tidx() >> 6, lane = tidx() & 63, stride = gridDim.x * 8;
  auto load_row = [&](int row, f32x4 (&v)[4]) { const float* xr = row >= TL ? xc + (size_t)(row - TL) * D : xl + (size_t)row * D;
#pragma unroll
    for (int j = 0; j < 4; ++j) v[j] = *(const f32x4*)(xr + 4 * lane + 256 * j); };
  int row = blockIdx.x * 8 + wave; f32x4 v[4];
  if (row < nrows) load_row(row, v);
  while (row < nrows) {
    const int nrow = row + stride; f32x4 vn[4];
    if (nrow < nrows) load_row(nrow, vn);
    const float* mod = row >= TL ? mod_c : mod_l;
    float mean, rstd; ln_stats(v, mean, rstd);
#pragma unroll
    for (int j = 0; j < 4; ++j) { const int c = 4 * lane + 256 * j; const f32x4 sh = *(const f32x4*)(mod + sh_off + c), sc = *(const f32x4*)(mod + sc_off + c);
      const f32x4 y = (v[j] - mean) * rstd * (sc + 1.f) + sh; u32x2 w; w.x = cvtpk(y.x, y.y); w.y = cvtpk(y.z, y.w);
      *(u32x2*)(H + (size_t)row * D + c) = w; }
#pragma unroll
    for (int j = 0; j < 4; ++j) v[j] = vn[j];
    row = nrow;
  }
}
DI void phase_ln_affine_mod(float* xl, float* xc, const float* g, const float* b, const float* mod_l, const float* mod_c, int sh_off, int sc_off, bf16_t* H, int nrows,
                            const float* cx = nullptr, const float* cacc = nullptr, const float* cg = nullptr, const float* cb = nullptr) {
  const int wave = tidx() >> 6, lane = tidx() & 63, stride = gridDim.x * 8;
  auto load_row = [&](int row, f32x4 (&v)[4]) {
    if (row >= TL && cacc) {
#pragma unroll
      for (int j = 0; j < 4; ++j) { const int c = 4 * lane + 256 * j; const size_t o = (size_t)(row - TL) * D + c;
        const f32x4 bb = cb ? *(const f32x4*)(cb + c) : (f32x4){0.f, 0.f, 0.f, 0.f};
        v[j] = *(const f32x4*)(cx + o) * ALPHA + *(const f32x4*)(cg + c) * (*(const f32x4*)(cacc + o) + bb); }
    } else { const float* xr = row >= TL ? xc + (size_t)(row - TL) * D : xl + (size_t)row * D;
#pragma unroll
      for (int j = 0; j < 4; ++j) v[j] = *(const f32x4*)(xr + 4 * lane + 256 * j); } };
  int row = blockIdx.x * 8 + wave; f32x4 v[4];
  if (row < nrows) load_row(row, v);
  while (row < nrows) {
    const int nrow = row + stride; f32x4 vn[4];
    if (nrow < nrows) load_row(nrow, vn);
    const bool isc = row >= TL; float* xr = isc ? xc + (size_t)(row - TL) * D : xl + (size_t)row * D; const float* mod = isc ? mod_c : mod_l;
    float mean, rstd; ln_stats(v, mean, rstd);
#pragma unroll
    for (int j = 0; j < 4; ++j) { const int c = 4 * lane + 256 * j; v[j] = (v[j] - mean) * rstd * *(const f32x4*)(g + c) + *(const f32x4*)(b + c); *(f32x4*)(xr + c) = v[j]; }
    if (H) {
      ln_stats(v, mean, rstd);
#pragma unroll
      for (int j = 0; j < 4; ++j) { const int c = 4 * lane + 256 * j; const f32x4 sh = *(const f32x4*)(mod + sh_off + c), sc = *(const f32x4*)(mod + sc_off + c);
        const f32x4 y = (v[j] - mean) * rstd * (sc + 1.f) + sh; u32x2 w; w.x = cvtpk(y.x, y.y); w.y = cvtpk(y.z, y.w);
        *(u32x2*)(H + (size_t)row * D + c) = w; }
    }
#pragma unroll
    for (int j = 0; j < 4; ++j) v[j] = vn[j];
    row = nrow;
  }
}

DI void phase_attn_prep(const Params& p, int l) {
  const int wave = tidx() >> 6, lane = tidx() & 63;
  bf16_t* PAC = (bf16_t*)(p.ws + WS_BIG + BG_PAC);
  const float* tab32 = (const float*)(p.ws + WS_TAB32); const float* tab16 = (const float*)(p.ws + WS_TAB16);
  const float* qn = p.in[13] + l * 384; const float* kvn = p.in[14] + l * 256;
  for (int row = blockIdx.x * 8 + wave; row < T; row += gridDim.x * 8) {
    bf16_t* pr = PAC + (size_t)row * NB_AC;
    if (row < TL) {
      const int prow = row >> 6, pcol = row & 63;
#pragma unroll
      for (int it = 0; it < 8; ++it) { const int pi = it * 64 + lane;
        const int unit = pi >> 5, q = pi & 31, sec = q >> 4, i = q & 15;
        const int e0 = unit * 64 + sec * 32 + i; const int pos = sec ? pcol : prow;
        const float cs = tab32[(pos * 16 + i) * 2], sn = tab32[(pos * 16 + i) * 2 + 1];
        const float x1 = bf2f(pr[e0]), x2 = bf2f(pr[e0 + 16]);
        pr[e0] = f2bf(x1 * cs - x2 * sn); pr[e0 + 16] = f2bf(x2 * cs + x1 * sn); }
      if (lane < 16) { const int sec = lane >> 3, i = lane & 7; const int e0 = 2176 + sec * 16 + i; const int pos = sec ? pcol : prow;
        const float cs = tab16[(pos * 8 + i) * 2], sn = tab16[(pos * 8 + i) * 2 + 1];
        const float x1 = bf2f(pr[e0]), x2 = bf2f(pr[e0 + 8]);
        pr[e0] = f2bf(x1 * cs - x2 * sn); pr[e0 + 8] = f2bf(x2 * cs + x1 * sn); }
    }
    { float v[6]; float ss = 0.f;
#pragma unroll
      for (int j = 0; j < 6; ++j) { v[j] = bf2f(pr[1536 + lane + 64 * j]); ss += v[j] * v[j]; }
      const float rs = 1.f / sqrtf(wave_sum(ss) * (1.f / 384.f) + EPS);
#pragma unroll
      for (int j = 0; j < 6; ++j) pr[1536 + lane + 64 * j] = f2bf(v[j] * rs * qn[lane + 64 * j]); }
    { float v[4]; float ss = 0.f;
#pragma unroll
      for (int j = 0; j < 4; ++j) { v[j] = bf2f(pr[1920 + lane + 64 * j]); ss += v[j] * v[j]; }
      const float rs = 1.f / sqrtf(wave_sum(ss) * (1.f / 256.f) + EPS);
#pragma unroll
      for (int j = 0; j < 4; ++j) pr[1920 + lane + 64 * j] = f2bf(v[j] * rs * kvn[lane + 64 * j]); }
  }
}
DI void phase_qup_rope(const Params& p) {
  const int wave = tidx() >> 6, lane = tidx() & 63;
  bf16_t* QUP = (bf16_t*)(p.ws + WS_BIG + BG_QUP); const float* tab16 = (const float*)(p.ws + WS_TAB16);
  for (int row = blockIdx.x * 8 + wave; row < TL; row += gridDim.x * 8) {
    const int prow = row >> 6, pcol = row & 63; bf16_t* pr = QUP + (size_t)row * 384;
    const int h = lane >> 4, q = lane & 15, sec = q >> 3, i = q & 7; const int e0 = h * 96 + 64 + sec * 16 + i; const int pos = sec ? pcol : prow;
    const float cs = tab16[(pos * 8 + i) * 2], sn = tab16[(pos * 8 + i) * 2 + 1];
    const float x1 = bf2f(pr[e0]), x2 = bf2f(pr[e0 + 8]);
    pr[e0] = f2bf(x1 * cs - x2 * sn); pr[e0 + 8] = f2bf(x2 * cs + x1 * sn);
  }
}

DI void attn_item_diff(const Params& p, int l, int q0, int h, int key0, int nkeys, char* lds) {
  const bf16_t* PAC = (const bf16_t*)(p.ws + WS_BIG + BG_PAC);
  bf16_t* OUT = (bf16_t*)(p.ws + WS_BR);
  const int tid = tidx(), wid = tid >> 6, lane = tid & 63, r32 = lane & 31, hi = lane >> 5;
  const float lam = ((const float*)(p.ws + WS_LAM))[l]; const float lam_init = 0.8f - 0.6f * expf(-0.3f * (float)l);
  f32x16 o1[4], o2[4]; float rli1[16], rli2[16];
  att::attn_diff2(PAC + (size_t)q0 * NB_AC + h * 128, NB_AC, PAC + (size_t)key0 * NB_AC + 512 + h * 128, NB_AC, PAC + (size_t)key0 * NB_AC + 1024 + h * 128, NB_AC,
                  nkeys, 0.125f, lds, o1, o2, rli1, rli2);
  const float* sw = p.in[8] + l * 128; const float og = 1.f - lam_init;
  float swv[4];
#pragma unroll
  for (int d0 = 0; d0 < 4; ++d0) swv[d0] = sw[d0 * 32 + r32] * og;
#pragma unroll
  for (int r = 0; r < 16; ++r) { float ss = 0.f; const float c1 = rli1[r], c2 = lam * rli2[r];
#pragma unroll
    for (int d0 = 0; d0 < 4; ++d0) { const float v = o1[d0][r] * c1 - o2[d0][r] * c2; o1[d0][r] = v; ss += v * v; }
#pragma unroll
    for (int off = 1; off < 32; off <<= 1) ss += __shfl_xor(ss, off);
    const float rs = 1.f / sqrtf(ss * (1.f / 128.f) + EPS);
    bf16_t* orow = OUT + (size_t)(q0 + wid * 32 + att::crow(r, hi)) * 512 + h * 128 + r32;
#pragma unroll
    for (int d0 = 0; d0 < 4; ++d0) orow[d0 * 32] = f2bf(o1[d0][r] * rs * swv[d0]); }
}
DI void attn_item_mla(const Params& p, int q0, int h, int key0, int nkeys, char* lds) {
  const bf16_t* PAC = (const bf16_t*)(p.ws + WS_BIG + BG_PAC);
  const bf16_t* QUP = (const bf16_t*)(p.ws + WS_BIG + BG_QUP); const bf16_t* KVUP = (const bf16_t*)(p.ws + WS_BIG + BG_KVUP);
  bf16_t* OUT = (bf16_t*)(p.ws + WS_BR) + (size_t)2 * T * 512;
  const int tid = tidx(), wid = tid >> 6, lane = tid & 63, r32 = lane & 31, hi = lane >> 5;
  f32x16 o[4]; float rli[16];
  if (q0 < TL) {
    bf16_t* QW = (bf16_t*)(p.ws + WS_BIG + BG_QUP); const float* tab16 = (const float*)(p.ws + WS_TAB16);
    for (int u = tid; u < 256 * 16; u += 512) { const int row = q0 + (u >> 4), q = u & 15, sec = q >> 3, i = q & 7;
      const int prow = row >> 6, pcol = row & 63, pos = sec ? pcol : prow; bf16_t* pr = QW + (size_t)row * 384 + h * 96 + 64 + sec * 16 + i;
      const float cs = tab16[(pos * 8 + i) * 2], sn = tab16[(pos * 8 + i) * 2 + 1];
      const float x1 = bf2f(pr[0]), x2 = bf2f(pr[8]);
      pr[0] = f2bf(x1 * cs - x2 * sn); pr[8] = f2bf(x2 * cs + x1 * sn); }
    __syncthreads();
  }
  att::attn_body<96>(QUP + (size_t)q0 * 384 + h * 96, 384, KVUP + (size_t)key0 * 768 + h * 192, 768, PAC + (size_t)key0 * NB_AC + 2176, NB_AC,
                     KVUP + (size_t)key0 * 768 + h * 192 + 64, 768, nkeys, 0.10206207261596575f, lds, o, rli);
#pragma unroll
  for (int r = 0; r < 16; ++r) { bf16_t* orow = OUT + (size_t)(q0 + wid * 32 + att::crow(r, hi)) * 512 + h * 128 + r32;
#pragma unroll
    for (int d0 = 0; d0 < 4; ++d0) orow[d0 * 32] = f2bf(o[d0][r] * rli[r]); }
}
DI void phase_attention(const Params& p, int l, char* lds) {
  const int c = blockIdx.x, G = gridDim.x;
  for (int it = c; it < 256; it += G) attn_item_diff(p, l, (it >> 2) * 256, it & 3, 0, T, lds);
  for (int it = c; it < 256; it += G) attn_item_mla(p, (it >> 2) * 256, it & 3, 0, T, lds);
  if (l == 0) {
    for (int it = c; it < 8; it += G) { if (it < 4) attn_item_diff(p, l, TL, it, TL, TC, lds); else attn_item_mla(p, TL, it - 4, TL, TC, lds); }
  }
}

DI float log_sigmoid(float x) { return fminf(x, 0.f) - log1pf(__expf(-fabsf(x))); }
DI float wave_scan_sum(float v, int lane, int dir) {
#pragma unroll
  for (int o = 1; o < 64; o <<= 1) { const float t = dir ? __shfl_down(v, o) : __shfl_up(v, o); const bool ok = dir ? (lane + o < 64) : (lane >= o); v += ok ? t : 0.f; }
  return v;
}
DI float wave_scan_max(float v, int lane, int dir) {
#pragma unroll
  for (int o = 1; o < 64; o <<= 1) { const float t = dir ? __shfl_down(v, o) : __shfl_up(v, o); const bool ok = dir ? (lane + o < 64) : (lane >= o); v = ok ? fmaxf(v, t) : v; }
  return v;
}
template <int NR, class F>
DI void conv_tile(const bf16_t* P, int ldp, int row0, int lo, int hi, const float* cw, int cw_ld, const float* cb, int gcol, int r0, int  , F&& out) {
  float w[5];
#pragma unroll
  for (int t = 0; t < 5; ++t) w[t] = cw[t * cw_ld];
  const float b = cb[0];
  float x[NR + 4];
#pragma unroll
  for (int i = 0; i < NR + 4; ++i) { const int row = row0 + r0 - 2 + i; const int rc = row < lo ? lo : (row >= hi ? hi - 1 : row);
    const float v = bf2f(P[(size_t)rc * ldp + gcol]); x[i] = (row >= lo && row < hi) ? v : 0.f; }
#pragma unroll
  for (int i = 0; i < NR; ++i) { const float y = b + w[0] * x[i] + w[1] * x[i + 1] + w[2] * x[i + 2] + w[3] * x[i + 3] + w[4] * x[i + 4]; out(r0 + i, siluf(y)); }
}
DI void phase_ml_s1(const Params& p, int l, unsigned char* lds) {
  const int tid = tidx(), wave = tid >> 6, lane = tid & 63;
  const bf16_t* PB = (const bf16_t*)(p.ws + WS_BIG + BG_PB);
  bf16_t* UC = (bf16_t*)(p.ws + WS_BIG + BG_UC); float* MSC = (float*)(p.ws + WS_BIG + BG_MSC);
  bf16_t* Vt = (bf16_t*)lds;
  bf16_t* Kt = Vt + 128 * LP;
  bf16_t* Kts = Kt + 64 * LP;
  float* wsv = (float*)(Kts + 64 * LP);
  const float* cw = p.in[9] + (size_t)l * 5 * 512; const float* cb = p.in[10] + l * 512; const float* gb = p.in[11] + l * 16;
  for (int item = blockIdx.x; item < 4 * NCH; item += gridDim.x) {
    const int h = item & 3, tc = item >> 2, row0 = chunk_row0(tc); int lo, hi; stream_bounds(row0, lo, hi);
    __syncthreads();
    {
      const int d = tid & 63, r0 = (tid >> 6) * 8; const int gc = 256 + h * 64 + d;
      conv_tile<8>(PB, NB_B, row0, lo, hi, cw + gc, 512, cb + gc, gc, r0, 8, [&](int r, float v) { Kt[d * LP + r] = f2bf(v * 0.125f); }); }
    {
      const int j = tid >> 3, e0 = (tid & 7) * 16; const bf16_t* src = PB + (size_t)(row0 + j) * NB_B + 512 + h * 128 + e0;
      const bf16x8 a = *(const bf16x8*)src, b = *(const bf16x8*)(src + 8);
#pragma unroll
      for (int i = 0; i < 8; ++i) { Vt[(e0 + i) * LP + j] = (bf16_t)a[i]; Vt[(e0 + 8 + i) * LP + j] = (bf16_t)b[i]; } }
    if (wave < 2) { const int dir = wave; const bf16_t* gr = PB + (size_t)(row0 + lane) * NB_B + 1536;
      const float ig = bf2f(gr[(2 * dir) * 4 + h]) + gb[(2 * dir) * 4 + h];
      const float lf = log_sigmoid(bf2f(gr[(2 * dir + 1) * 4 + h]) + gb[(2 * dir + 1) * 4 + h]);
      const float g = wave_scan_sum(lf, lane, dir); const float g_end = wave_sum(lf);
      const float ls = g_end - g + ig; const float m_loc = wave_max(ls);
      wsv[dir * 64 + lane] = __expf(ls - m_loc);
      if (lane == 0) { const int ch = h * 2 + dir, s = scan_idx(tc, dir); MSC[(0 * 8 + ch) * NCH + s] = g_end; MSC[(1 * 8 + ch) * NCH + s] = m_loc; } }
    __syncthreads();
    for (int dir = 0; dir < 2; ++dir) {
      const int ch = h * 2 + dir, s = scan_idx(tc, dir); bf16_t* urow = UC + ((size_t)ch * NCH + s) * MLROW;
      { const int d = tid >> 3, j0 = (tid & 7) * 8; float sum = 0.f;
#pragma unroll
        for (int i = 0; i < 8; ++i) { const bf16_t v = f2bf(bf2f(Kt[d * LP + j0 + i]) * wsv[dir * 64 + j0 + i]); Kts[d * LP + j0 + i] = v; sum += bf2f(v); }
        sum += __shfl_xor(sum, 1); sum += __shfl_xor(sum, 2); sum += __shfl_xor(sum, 4);
        if ((tid & 7) == 0) urow[8192 + d] = f2bf(sum); }
      __syncthreads();
#pragma unroll
      for (int dt = 0; dt < 4; ++dt) { f32x4 acc = {0.f, 0.f, 0.f, 0.f};
        acc = mm16(Vt + wave * 16 * LP, LP, Kts + dt * 16 * LP, LP, 64, acc, lane);
#pragma unroll
        for (int r = 0; r < 4; ++r) urow[(wave * 16 + (lane >> 4) * 4 + r) * 64 + dt * 16 + (lane & 15)] = f2bf(acc[r]); }
      __syncthreads();
    }
  }
}
DI void phase_ml_s2(const Params& p) {
  const bf16_t* __restrict__ UC = (const bf16_t*)(p.ws + WS_BIG + BG_UC); bf16_t* __restrict__ SC = (bf16_t*)(p.ws + WS_BIG + BG_SC);
  float* MSC = (float*)(p.ws + WS_BIG + BG_MSC);
  const int npairs = 8 * (MLROW / 2);
  for (int e = blockIdx.x * 512 + tidx(); e < npairs; e += gridDim.x * 512) {
    const int ch = e / (MLROW / 2), off = (e % (MLROW / 2)) * 2;
    const float* GE = MSC + (0 * 8 + ch) * NCH; const float* ML = MSC + (1 * 8 + ch) * NCH; float* MS = MSC + (2 * 8 + ch) * NCH;
    float m = 0.f, c0 = 0.f, c1 = 0.f;
    for (int s0 = 0; s0 < NCH; s0 += 26) {
      unsigned u[26];
#pragma unroll
      for (int q = 0; q < 26; ++q) u[q] = *(const unsigned*)(UC + ((size_t)ch * NCH + s0 + q) * MLROW + off);
      float gev[26], mlv[26];
#pragma unroll
      for (int q = 0; q < 26; ++q) { gev[q] = GE[s0 + q]; mlv[q] = ML[s0 + q]; }
#pragma unroll
      for (int q = 0; q < 26; ++q) { const int s = s0 + q;
        *(unsigned*)(SC + ((size_t)ch * NCH + s) * MLROW + off) = cvtpk(c0, c1);
        if (off == 0) MS[s] = m;
        const float ge = gev[q], ml = mlv[q]; const float mn = fmaxf(ge + m, ml); const float dec = __expf(ge + m - mn), sc = __expf(ml - mn);
        c0 = dec * c0 + sc * bflo(u[q]); c1 = dec * c1 + sc * bfhi(u[q]); m = mn; }
    }
  }
}
DI void phase_ml_s3(const Params& p, int l, unsigned char* lds, int ntc) {
  const int tid = tidx(), wave = tid >> 6, lane = tid & 63;
  const bf16_t* PB = (const bf16_t*)(p.ws + WS_BIG + BG_PB);
  const bf16_t* SC = (const bf16_t*)(p.ws + WS_BIG + BG_SC); const float* MSC = (const float*)(p.ws + WS_BIG + BG_MSC);
  bf16_t* OUT = (bf16_t*)(p.ws + WS_BR) + (size_t)1 * T * 512;
  bf16_t* Q = (bf16_t*)lds;
  bf16_t* Kk = Q + 64 * LP;
  bf16_t* W = Kk + 64 * LP;
  bf16_t* Vt = W + 64 * LP;
  bf16_t* Ct = Vt + 128 * LP;
  float* fa = (float*)(Ct + 128 * LP);
  float* gS = fa;
  float* bS = fa + 128;
  float* mjS = fa + 256;
  float* aiS = fa + 384;
  float* rdS = fa + 448;
  float* nS = fa + 512;
  float* ssS = fa + 576;
  const float* cw = p.in[9] + (size_t)l * 5 * 512; const float* cb = p.in[10] + l * 512; const float* gb = p.in[11] + l * 16;
  const float* nw = p.in[12] + l * 512;
  const int js = wave >> 1, eh = wave & 1;
  for (int item = blockIdx.x; item < 4 * ntc; item += gridDim.x) {
    const int h = item & 3, tc = item >> 2, row0 = chunk_row0(tc); int lo, hi; stream_bounds(row0, lo, hi);
    __syncthreads();
    { const int c = tid & 127, r0 = (tid >> 7) * 16; const int gc = (c < 64) ? h * 64 + c : 256 + h * 64 + (c - 64);
      bf16_t* dst = (c < 64) ? Q + c : Kk + (c - 64); const float scl = (c < 64) ? 1.f : 0.125f;
      conv_tile<16>(PB, NB_B, row0, lo, hi, cw + gc, 512, cb + gc, gc, r0, 16, [&](int r, float v) { dst[r * LP] = f2bf(v * scl); }); }
    { const int j = tid >> 3, e0 = (tid & 7) * 16; const bf16_t* src = PB + (size_t)(row0 + j) * NB_B + 512 + h * 128 + e0;
      const bf16x8 a = *(const bf16x8*)src, b = *(const bf16x8*)(src + 8);
#pragma unroll
      for (int i = 0; i < 8; ++i) { Vt[(e0 + i) * LP + j] = (bf16_t)a[i]; Vt[(e0 + 8 + i) * LP + j] = (bf16_t)b[i]; } }
    float mdir[2];
#pragma unroll
    for (int dir = 0; dir < 2; ++dir) mdir[dir] = MSC[(2 * 8 + h * 2 + dir) * NCH + scan_idx(tc, dir)];
    if (wave < 2) { const int dir = wave; const bf16_t* gr = PB + (size_t)(row0 + lane) * NB_B + 1536;
      const float ig = bf2f(gr[(2 * dir) * 4 + h]) + gb[(2 * dir) * 4 + h];
      const float lf = log_sigmoid(bf2f(gr[(2 * dir + 1) * 4 + h]) + gb[(2 * dir + 1) * 4 + h]);
      const float g = wave_scan_sum(lf, lane, dir); const float b = ig - g; const float bm = wave_scan_max(b, lane, dir);
      gS[dir * 64 + lane] = g; bS[dir * 64 + lane] = b; mjS[dir * 64 + lane] = g + fmaxf(dir ? mdir[1] : mdir[0], bm); }
    f32x4 hs[4];
#pragma unroll
    for (int t = 0; t < 4; ++t) hs[t] = (f32x4){0.f, 0.f, 0.f, 0.f};
#pragma unroll
    for (int dir = 0; dir < 2; ++dir) {
      const int ch = h * 2 + dir, s = scan_idx(tc, dir); const bf16_t* srow = SC + ((size_t)ch * NCH + s) * MLROW; const float m = mdir[dir];
      __syncthreads();
      for (int i = tid; i < 1024; i += 512) { const int e = i >> 3, d0 = (i & 7) * 8; *(bf16x8*)(Ct + e * LP + d0) = *(const bf16x8*)(srow + e * 64 + d0); }
      if (tid < 64) { nS[tid] = bf2f(srow[8192 + tid]); aiS[tid] = __expf(gS[dir * 64 + tid] + m - mjS[dir * 64 + tid]); }
#pragma unroll
      for (int tt = 0; tt < 2; ++tt) { const int it = eh * 2 + tt; f32x4 acc = {0.f, 0.f, 0.f, 0.f};
        acc = mm16(Q + js * 16 * LP, LP, Kk + it * 16 * LP, LP, 64, acc, lane);
        const int i = it * 16 + (lane & 15); const float bi = bS[dir * 64 + i];
#pragma unroll
        for (int r = 0; r < 4; ++r) { const int j = js * 16 + (lane >> 4) * 4 + r; const bool ok = dir ? (i >= j) : (i <= j);
          const float wv = ok ? __expf(gS[dir * 64 + j] + bi - mjS[dir * 64 + j]) * acc[r] : 0.f; W[j * LP + i] = f2bf(wv); } }
      __syncthreads();
      { const int j = tid >> 3, i0 = (tid & 7) * 8; float sw = 0.f, sq = 0.f;
#pragma unroll
        for (int i = 0; i < 8; ++i) { sw += bf2f(W[j * LP + i0 + i]); sq += bf2f(Q[j * LP + i0 + i]) * nS[i0 + i]; }
        sw += __shfl_xor(sw, 1); sw += __shfl_xor(sw, 2); sw += __shfl_xor(sw, 4); sq += __shfl_xor(sq, 1); sq += __shfl_xor(sq, 2); sq += __shfl_xor(sq, 4);
        if ((tid & 7) == 0) { const float den = sw + aiS[j] * sq; rdS[j] = 1.f / fmaxf(fabsf(den), __expf(-mjS[dir * 64 + j])); } }
      __syncthreads();
#pragma unroll
      for (int t = 0; t < 4; ++t) { const int et = eh * 4 + t; f32x4 a1 = {0.f, 0.f, 0.f, 0.f}, a2 = {0.f, 0.f, 0.f, 0.f};
        a1 = mm16(W + js * 16 * LP, LP, Vt + et * 16 * LP, LP, 64, a1, lane);
        a2 = mm16(Q + js * 16 * LP, LP, Ct + et * 16 * LP, LP, 64, a2, lane);
#pragma unroll
        for (int r = 0; r < 4; ++r) { const int j = js * 16 + (lane >> 4) * 4 + r; hs[t][r] += (a1[r] + aiS[j] * a2[r]) * rdS[j]; } }
    }
    { float ssq[4] = {0.f, 0.f, 0.f, 0.f};
#pragma unroll
      for (int t = 0; t < 4; ++t)
#pragma unroll
        for (int r = 0; r < 4; ++r) ssq[r] += hs[t][r] * hs[t][r];
#pragma unroll
      for (int r = 0; r < 4; ++r) { float s = ssq[r]; s += __shfl_xor(s, 1); s += __shfl_xor(s, 2); s += __shfl_xor(s, 4); s += __shfl_xor(s, 8);
        if ((lane & 15) == 0) ssS[(js * 16 + (lane >> 4) * 4 + r) * 2 + eh] = s; }
      __syncthreads();
      bf16_t ogr[4][4];
#pragma unroll
      for (int r = 0; r < 4; ++r)
#pragma unroll
        for (int t = 0; t < 4; ++t) ogr[r][t] = PB[(size_t)(row0 + js * 16 + (lane >> 4) * 4 + r) * NB_B + 1024 + h * 128 + (eh * 4 + t) * 16 + (lane & 15)];
#pragma unroll
      for (int r = 0; r < 4; ++r) { const int j = js * 16 + (lane >> 4) * 4 + r; const float rs = 1.f / sqrtf((ssS[j * 2] + ssS[j * 2 + 1]) * (1.f / 128.f) + EPS);
        const size_t row = (size_t)(row0 + j);
#pragma unroll
        for (int t = 0; t < 4; ++t) { const int e = (eh * 4 + t) * 16 + (lane & 15); const float og = sigmoidf(bf2f(ogr[r][t]));
          OUT[row * 512 + h * 128 + e] = f2bf(hs[t][r] * rs * nw[h * 128 + e] * og); } }
    }
  }
}

DI float softplusf(float x) { return fmaxf(x, 0.f) + log1pf(__expf(-fabsf(x))); }
struct SsdLds { bf16_t* Xt; bf16_t* Cm; bf16_t* Bm; bf16_t* Bmt; bf16_t* Sc; bf16_t* Hs; float* CB; float* sS; float* dtS; float* seS; float* ssS; };
DI SsdLds ssd_lds(unsigned char* lds) {
  SsdLds L; L.Xt = (bf16_t*)lds;
  L.Cm = L.Xt + 4 * 64 * LP;
  L.Bm = L.Cm + 64 * LP;
  L.Bmt = L.Bm + 64 * LP;
  L.Sc = L.Bmt + 64 * LP;
  L.Hs = L.Sc + 64 * LP;
  L.CB = (float*)(L.Hs + 64 * LP);
  L.sS = L.CB + 64 * 65;
  L.dtS = L.sS + 512;
  L.seS = L.dtS + 512;
  L.ssS = L.seS + 8;
  return L;
}
DI void ssd_load(const Params& p, int l, int g, int tc, const SsdLds& L) {
  const int tid = tidx(), wave = tid >> 6, lane = tid & 63;
  const bf16_t* PD = (const bf16_t*)(p.ws + WS_BIG + BG_PD);
  const float* cw = p.in[17] + (size_t)l * 5 * 768; const float* cb = p.in[18] + l * 768;
  const int row0 = chunk_row0(tc); int lo, hi; stream_bounds(row0, lo, hi);
  float xr[3][20], wr[3][5], br[3]; int cc[3], rr0[3];
#pragma unroll
  for (int k = 0; k < 3; ++k) { const int u = tid + 512 * k, c = u % 384, r0 = (u / 384) * 16; cc[k] = c; rr0[k] = r0;
    const int gc = c < 256 ? g * 256 + c : (c < 320 ? 512 + g * 64 + (c - 256) : 640 + g * 64 + (c - 320));
#pragma unroll
    for (int t = 0; t < 5; ++t) wr[k][t] = cw[t * 768 + gc];
    br[k] = cb[gc];
#pragma unroll
    for (int i = 0; i < 20; ++i) { const int row = row0 + r0 - 2 + i; const int rc = row < lo ? lo : (row >= hi ? hi - 1 : row);
      const float v = bf2f(PD[(size_t)rc * NB_D + 512 + gc]); xr[k][i] = (row >= lo && row < hi) ? v : 0.f; } }
#pragma unroll
  for (int k = 0; k < 3; ++k) { const int c = cc[k], r0 = rr0[k];
#pragma unroll
    for (int i = 0; i < 16; ++i) { const float y = br[k] + wr[k][0] * xr[k][i] + wr[k][1] * xr[k][i + 1] + wr[k][2] * xr[k][i + 2] + wr[k][3] * xr[k][i + 3] + wr[k][4] * xr[k][i + 4];
      const bf16_t vb = f2bf(siluf(y)); const int r = r0 + i;
      if (c < 256) L.Xt[c * LP + r] = vb;
      else if (c < 320) { L.Bm[r * LP + (c - 256)] = vb; L.Bmt[(c - 256) * LP + r] = vb; }
      else L.Cm[r * LP + (c - 320)] = vb; } }
  { const int hh = wave >> 1, dir = wave & 1, h = g * 4 + hh;
    const float dtb = p.in[19][l * 16 + dir * 8 + h], am = -__expf(p.in[20][l * 16 + dir * 8 + h]);
    const float dt = softplusf(bf2f(PD[(size_t)(row0 + lane) * NB_D + 1280 + dir * 8 + h]) + dtb); const float a = dt * am;
    const float s = wave_scan_sum(a, lane, dir); const float se = wave_sum(a);
    L.sS[wave * 64 + lane] = s; L.dtS[wave * 64 + lane] = dt; if (lane == 0) L.seS[wave] = se; }
}
DI bf16x8 pack8(const float (&v)[8]) { u32x4 w; w.x = cvtpk(v[0], v[1]); w.y = cvtpk(v[2], v[3]); w.z = cvtpk(v[4], v[5]); w.w = cvtpk(v[6], v[7]); return __builtin_bit_cast(bf16x8, w); }
DI void unpack8(const bf16x8 b, float (&v)[8]) { const u32x4 w = __builtin_bit_cast(u32x4, b); v[0] = bflo(w.x); v[1] = bfhi(w.x); v[2] = bflo(w.y); v[3] = bfhi(w.y); v[4] = bflo(w.z); v[5] = bfhi(w.z); v[6] = bflo(w.w); v[7] = bfhi(w.w); }
DI void phase_ssd_s1(const Params& p, int l, unsigned char* lds) {
  const int tid = tidx(), wave = tid >> 6, lane = tid & 63, l15 = lane & 15, lq = lane >> 4;
  const SsdLds L = ssd_lds(lds);
  bf16_t* UH = (bf16_t*)(p.ws + WS_BIG + BG_UH); float* DE = (float*)(p.ws + WS_BIG + BG_DE);
  for (int item = blockIdx.x; item < 2 * NCH; item += gridDim.x) {
    const int g = item & 1, tc = item >> 1;
    __syncthreads();
    ssd_load(p, l, g, tc, L);
    __syncthreads();
    const int hd = wave, hh = hd >> 1, dir = hd & 1, h = g * 4 + hh, ch = h * 2 + dir, s = scan_idx(tc, dir);
    const float se = L.seS[hd];
    if (lane == 0) DE[ch * NCH + s] = __expf(se);
    float cf[2][8];
#pragma unroll
    for (int ks = 0; ks < 2; ++ks)
#pragma unroll
      for (int e = 0; e < 8; ++e) { const int i = ks * 32 + 8 * lq + e; cf[ks][e] = __expf(se - L.sS[hd * 64 + i]) * L.dtS[hd * 64 + i]; }
    bf16x8 bfr[4][2];
#pragma unroll
    for (int nt = 0; nt < 4; ++nt)
#pragma unroll
      for (int ks = 0; ks < 2; ++ks) { float v[8]; unpack8(*(const bf16x8*)(L.Bmt + (nt * 16 + l15) * LP + ks * 32 + 8 * lq), v);
#pragma unroll
        for (int e = 0; e < 8; ++e) v[e] *= cf[ks][e];
        bfr[nt][ks] = pack8(v); }
    bf16_t* urow = UH + ((size_t)ch * NCH + s) * 4096;
#pragma unroll
    for (int pt = 0; pt < 4; ++pt) { const bf16_t* ap = L.Xt + (hh * 64 + pt * 16 + l15) * LP + 8 * lq;
      const bf16x8 a0 = *(const bf16x8*)ap, a1 = *(const bf16x8*)(ap + 32);
#pragma unroll
      for (int nt = 0; nt < 4; ++nt) { f32x4 acc = {0.f, 0.f, 0.f, 0.f};
        acc = __builtin_amdgcn_mfma_f32_16x16x32_bf16(a0, bfr[nt][0], acc, 0, 0, 0);
        acc = __builtin_amdgcn_mfma_f32_16x16x32_bf16(a1, bfr[nt][1], acc, 0, 0, 0);
#pragma unroll
        for (int r = 0; r < 4; ++r) urow[(pt * 16 + lq * 4 + r) * 64 + nt * 16 + l15] = f2bf(acc[r]); } }
  }
}
DI void phase_ssd_s2(const Params& p) {
  const bf16_t* __restrict__ UH = (const bf16_t*)(p.ws + WS_BIG + BG_UH); bf16_t* __restrict__ SH = (bf16_t*)(p.ws + WS_BIG + BG_SH);
  const float* DE = (const float*)(p.ws + WS_BIG + BG_DE);
  const int npairs = 16 * 2048;
  for (int e = blockIdx.x * 512 + tidx(); e < npairs; e += gridDim.x * 512) {
    const int ch = e >> 11, off = (e & 2047) * 2; float c0 = 0.f, c1 = 0.f;
    for (int s0 = 0; s0 < NCH; s0 += 26) {
      unsigned u[26];
#pragma unroll
      for (int q = 0; q < 26; ++q) u[q] = *(const unsigned*)(UH + ((size_t)ch * NCH + s0 + q) * 4096 + off);
      float dev[26];
#pragma unroll
      for (int q = 0; q < 26; ++q) dev[q] = DE[ch * NCH + s0 + q];
#pragma unroll
      for (int q = 0; q < 26; ++q) { const int s = s0 + q;
        *(unsigned*)(SH + ((size_t)ch * NCH + s) * 4096 + off) = cvtpk(c0, c1);
        const float dec = dev[q]; c0 = dec * c0 + bflo(u[q]); c1 = dec * c1 + bfhi(u[q]); }
    }
  }
}
DI void phase_ssd_s3(const Params& p, int l, unsigned char* lds, int ntc) {
  const int tid = tidx(), wave = tid >> 6, lane = tid & 63, l15 = lane & 15, lq = lane >> 4;
  const SsdLds L = ssd_lds(lds);
  const bf16_t* PD = (const bf16_t*)(p.ws + WS_BIG + BG_PD);
  const bf16_t* SH = (const bf16_t*)(p.ws + WS_BIG + BG_SH);
  bf16_t* OUT = (bf16_t*)(p.ws + WS_BR) + (size_t)3 * T * 512;
  const float* dsk = p.in[21] + l * 8; const float* nw = p.in[22] + l * 512;
  float* ssq4 = L.CB + 64 * 65;
  ssq4 = L.ssS + 128;
  const int hh = wave >> 1, jh = wave & 1;
  for (int item = blockIdx.x; item < 2 * ntc; item += gridDim.x) {
    const int g = item & 1, tc = item >> 1, row0 = chunk_row0(tc), h = g * 4 + hh;
    __syncthreads();
    ssd_load(p, l, g, tc, L);
    __syncthreads();
#pragma unroll
    for (int tt = 0; tt < 2; ++tt) { const int t = wave * 2 + tt, jt = t >> 2, it = t & 3; f32x4 acc = {0.f, 0.f, 0.f, 0.f};
      acc = mm16(L.Cm + jt * 16 * LP, LP, L.Bm + it * 16 * LP, LP, 64, acc, lane);
#pragma unroll
      for (int r = 0; r < 4; ++r) L.CB[(jt * 16 + lq * 4 + r) * 65 + it * 16 + l15] = acc[r]; }
    __syncthreads();
    const float dk = dsk[h];
#pragma unroll 1
    for (int jl = 0; jl < 2; ++jl) { const int jt = jh * 2 + jl, j = jt * 16 + l15;
      f32x4 ys[4];
#pragma unroll
      for (int b = 0; b < 4; ++b) ys[b] = (f32x4){0.f, 0.f, 0.f, 0.f};
#pragma unroll 1
      for (int dir = 0; dir < 2; ++dir) { const int hd = hh * 2 + dir, ch = h * 2 + dir, s = scan_idx(tc, dir);
        const bf16_t* srow = SH + ((size_t)ch * NCH + s) * 4096;
        bf16x8 bh[4][2];
#pragma unroll
        for (int pt = 0; pt < 4; ++pt) { bh[pt][0] = *(const bf16x8*)(srow + (pt * 16 + l15) * 64 + 8 * lq); bh[pt][1] = *(const bf16x8*)(srow + (pt * 16 + l15) * 64 + 32 + 8 * lq); }
        const float sj = L.sS[hd * 64 + j];
        bf16x8 asc[2], acm[2];
#pragma unroll
        for (int ks = 0; ks < 2; ++ks) { float v[8];
#pragma unroll
          for (int e = 0; e < 8; ++e) { const int ii = ks * 32 + 8 * lq + e; const bool ok = dir ? (ii >= j) : (ii <= j);
            v[e] = ok ? __expf(sj - L.sS[hd * 64 + ii]) * L.CB[j * 65 + ii] * L.dtS[hd * 64 + ii] : 0.f; }
          asc[ks] = pack8(v); acm[ks] = *(const bf16x8*)(L.Cm + j * LP + ks * 32 + 8 * lq); }
        float ej[4];
#pragma unroll
        for (int r = 0; r < 4; ++r) ej[r] = __expf(L.sS[hd * 64 + jt * 16 + lq * 4 + r]);
#pragma unroll
        for (int pt = 0; pt < 4; ++pt) { const bf16_t* xp = L.Xt + (hh * 64 + pt * 16 + l15) * LP + 8 * lq;
          f32x4 a1 = {0.f, 0.f, 0.f, 0.f}, a2 = {0.f, 0.f, 0.f, 0.f};
          a1 = __builtin_amdgcn_mfma_f32_16x16x32_bf16(asc[0], *(const bf16x8*)xp, a1, 0, 0, 0);
          a1 = __builtin_amdgcn_mfma_f32_16x16x32_bf16(asc[1], *(const bf16x8*)(xp + 32), a1, 0, 0, 0);
          a2 = __builtin_amdgcn_mfma_f32_16x16x32_bf16(acm[0], bh[pt][0], a2, 0, 0, 0);
          a2 = __builtin_amdgcn_mfma_f32_16x16x32_bf16(acm[1], bh[pt][1], a2, 0, 0, 0);
#pragma unroll
          for (int r = 0; r < 4; ++r) ys[pt][r] += a1[r] + ej[r] * a2[r]; }
      }
      bf16_t zr[4][4];
#pragma unroll
      for (int r = 0; r < 4; ++r)
#pragma unroll
        for (int pt = 0; pt < 4; ++pt) zr[r][pt] = PD[(size_t)(row0 + jt * 16 + lq * 4 + r) * NB_D + h * 64 + pt * 16 + l15];
#pragma unroll
      for (int r = 0; r < 4; ++r) { const int jr = jt * 16 + lq * 4 + r; float sq = 0.f;
#pragma unroll
        for (int pt = 0; pt < 4; ++pt) { const int pp = pt * 16 + l15;
          const float z = bf2f(zr[r][pt]);
          const float v = (ys[pt][r] + dk * bf2f(L.Xt[(hh * 64 + pp) * LP + jr])) * siluf(z);
          const bf16_t vb = f2bf(v); const float vr = bf2f(vb); sq += vr * vr;
          OUT[(size_t)(row0 + jr) * 512 + g * 256 + hh * 64 + pp] = vb; }
        sq += __shfl_xor(sq, 1); sq += __shfl_xor(sq, 2); sq += __shfl_xor(sq, 4); sq += __shfl_xor(sq, 8);
        if (l15 == 0) ssq4[jr * 4 + hh] = sq; }
    }
    __syncthreads();
#pragma unroll 1
    for (int jl = 0; jl < 2; ++jl) {
      bf16_t ov[4][4];
#pragma unroll
      for (int r = 0; r < 4; ++r)
#pragma unroll
        for (int pt = 0; pt < 4; ++pt) ov[r][pt] = OUT[(size_t)(row0 + (jh * 2 + jl) * 16 + lq * 4 + r) * 512 + g * 256 + hh * 64 + pt * 16 + l15];
#pragma unroll
      for (int r = 0; r < 4; ++r) { const int jr = (jh * 2 + jl) * 16 + lq * 4 + r;
        const float tot = (ssq4[jr * 4 + 0] + ssq4[jr * 4 + 1]) + (ssq4[jr * 4 + 2] + ssq4[jr * 4 + 3]);
        const float rs = 1.f / sqrtf(tot * (1.f / 256.f) + EPS);
#pragma unroll
        for (int pt = 0; pt < 4; ++pt) { const int c = g * 256 + hh * 64 + pt * 16 + l15;
          OUT[(size_t)(row0 + jr) * 512 + c] = f2bf(bf2f(ov[r][pt]) * rs * nw[c]); } }
    }
  }
}

extern __shared__ __attribute__((aligned(16))) unsigned char dyn_lds[];

#define XB_TMO      128
#define XB_XCNT(j)  (256  + 64 * (j))
#define XB_XSUB(j)  (1280 + 64 * (j))
#define XB_XGEN(j)  (2304 + 64 * (j))
#define XB_TOP      3328
#define XB_TOPGEN   3392
#define XCD_BAR_WORDS 3456
#define XB_SPIN_CAP (1u << 18)
DI unsigned xb_ld(unsigned* p)              { return __hip_atomic_load(p, __ATOMIC_RELAXED, __HIP_MEMORY_SCOPE_AGENT); }
DI unsigned xb_add(unsigned* p, unsigned v) { return __hip_atomic_fetch_add(p, v, __ATOMIC_RELAXED, __HIP_MEMORY_SCOPE_AGENT); }
DI unsigned xb_xcc_id() { return (unsigned)__builtin_amdgcn_s_getreg((3 << 11) | 20) & 0xFu; }
#define XB_SPIN(cond, bar) do { unsigned _sp = 0; while (cond) { __builtin_amdgcn_s_sleep(1); \
    if ((++_sp & 255u) == 0u) { if (xb_ld(&(bar)[XB_TMO])) break; if (_sp > XB_SPIN_CAP) { atomicAdd(&(bar)[XB_TMO], 1u); break; } } } } while (0)
DI void xcd_barrier_complete(unsigned* bar, unsigned x, unsigned& nloc, unsigned& nx) {
  const unsigned G = gridDim.x;
  unsigned sum, cnt, mine, sp = 0u;
  for (;;) {
    sum = 0u; cnt = 0u; mine = 0u;
#pragma unroll
    for (unsigned j = 0; j < 16; ++j) { const unsigned c = xb_ld(&bar[XB_XCNT(j)]); sum += c; cnt += (c > 0u) ? 1u : 0u; mine = (j == x) ? c : mine; }
    if (sum == G) break;
    __builtin_amdgcn_s_sleep(1);
    if ((++sp & 255u) == 0u) { if (xb_ld(&bar[XB_TMO])) break; if (sp > XB_SPIN_CAP) { atomicAdd(&bar[XB_TMO], 1u); break; } }
  }
  nloc = mine > 0u ? mine : 1u; nx = cnt > 0u ? cnt : 1u;
}
DI void xcd_barrier(unsigned* bar, volatile LAS unsigned* st) {
  asm volatile("s_waitcnt vmcnt(0)" ::: "memory");
  __syncthreads();
  if (tidx() == 0) {
    const unsigned x = xb_xcc_id();
    __builtin_amdgcn_s_waitcnt(0);
    unsigned nloc = st[0], nx = st[1];
    if (nloc == 0u) { xcd_barrier_complete(bar, x, nloc, nx); st[0] = nloc; st[1] = nx; }
    const unsigned old = xb_add(&bar[XB_XSUB(x)], 1u);
    const unsigned gen = old / nloc;
    if (old + 1u == (gen + 1u) * nloc) {
      __builtin_amdgcn_fence(__ATOMIC_RELEASE, "agent");
      asm volatile("s_waitcnt vmcnt(0)" ::: "memory");
      const unsigned og = xb_add(&bar[XB_TOP], 1u);
      const unsigned tg = og / nx;
      if (og + 1u == (tg + 1u) * nx) xb_add(&bar[XB_TOPGEN], 1u);
      else XB_SPIN(xb_ld(&bar[XB_TOPGEN]) == tg, bar);
      __builtin_amdgcn_fence(__ATOMIC_ACQUIRE, "agent");
      xb_add(&bar[XB_XGEN(x)], 1u);
      asm volatile("s_waitcnt vmcnt(0)" ::: "memory");
    } else {
      XB_SPIN(xb_ld(&bar[XB_XGEN(x)]) == gen, bar);
      __builtin_amdgcn_fence(__ATOMIC_ACQUIRE, "agent");
      asm volatile("s_waitcnt vmcnt(0)" ::: "memory");
    }
  }
  __syncthreads();
}

#ifndef REP_ATTN
#define REP_ATTN 1
#endif
#ifndef REP_SCAN
#define REP_SCAN 1
#endif
#ifndef DBG_STOP
#define DBG_STOP 0
#endif
DI void dbg_dump_br(const Params& p, int mode) {
  const bf16_t* BR = (const bf16_t*)(p.ws + WS_BR);
  for (size_t i = (size_t)blockIdx.x * 512 + tidx(); i < (size_t)TL * 1024; i += (size_t)gridDim.x * 512) {
    const size_t row = i >> 10; const int c = (int)(i & 1023), cc = c & 511, hf = c >> 9;
    float v = 0.f;
    if (mode == 0) v = bf2f(BR[((size_t)(hf * 2) * T + row) * 512 + cc]) + bf2f(BR[((size_t)(hf * 2 + 1) * T + row) * 512 + cc]);
    else if (mode == 1) v = bf2f(BR[((size_t)(hf ? 3 : 1) * T + row) * 512 + cc]);
    else if (mode == 2) v = bf2f(BR[((size_t)(hf ? 2 : 0) * T + row) * 512 + cc]);
    p.out[i] = v;
  }
}

DI void dbg_dump_raw(const Params& p, size_t byte_off, size_t cnt = (size_t)TL * 1024) {
  const bf16_t* src = (const bf16_t*)(p.ws + WS_BIG + byte_off);
  for (size_t i = (size_t)blockIdx.x * 512 + tidx(); i < (size_t)TL * 1024; i += (size_t)gridDim.x * 512) p.out[i] = i < cnt ? bf2f(src[i]) : 0.f;
}
typedef const __attribute__((address_space(4))) Params* KP;
DI const Params* launder(KP kp) { asm volatile("" : "+s"(kp)); return (const Params*)kp; }
#define PL (*launder(kp))
DI void gsync_(KP kp) { xcd_barrier((unsigned*)(PL.ws + WS_BAR), (volatile LAS unsigned*)((LAS unsigned char*)dyn_lds + LDS_PHASE)); }
#define gsync(g) gsync_(kp)
template <int l>
DI bool layer_fwd(KP kp, cg::grid_group& grid) {
  unsigned char* lds = dyn_lds; LAS unsigned char* ldsl = (LAS unsigned char*)dyn_lds;
  const int c = blockIdx.x, G = gridDim.x;
  unsigned char* ws = PL.ws;
  const float* MOD = (const float*)(ws + WS_MOD);
  bf16_t* H = (bf16_t*)(ws + WS_H); float* XC = (float*)(ws + WS_XC);
  const bf16_t* WA = (const bf16_t*)(ws + WS_WA); unsigned char* WB = ws + WS_WB; unsigned char* BIG = ws + WS_BIG;
    const float* mod_l = MOD + (size_t)(l * 2 + 0) * 6144; const float* mod_c = MOD + (size_t)(l * 2 + 1) * 6144;
    const float* xin_l = (l == 0) ? PL.in[0] : PL.out; const float* xin_c = (l == 0) ? PL.in[2] : XC;
    const int Mm = (l == 0) ? T : TL;
    const int ntc = (l == 0) ? NCH : 256;
    { pg8::Sched S{(const char*)H, (size_t)D * 2, (const char*)WA + WA_B, 1024, T / 256, NB_B / 256, G, c};
      pg8::EpiStore E{(bf16_t*)(BIG + BG_PB), NB_B, NB_B}; pg8::gemm_phase(ldsl, S, E); }
    gsync(grid);
    if (DBG_STOP == 7 && l == 0) { dbg_dump_raw(PL, BG_PB); return true; }
    if (DBG_STOP == 8 && l == 0) { dbg_dump_raw(PL, BG_PB + (size_t)TL * 1024 * 2, (size_t)T * NB_B - (size_t)TL * 1024); return true; }
    for (int rep = 0; rep < REP_SCAN; ++rep) {
    phase_ml_s1(PL, l, lds);
    gsync(grid);
    if (DBG_STOP == 4 && l == 0) { dbg_dump_raw(PL, BG_UC); return true; }
    phase_ml_s2(PL);
    convert_layer_rest(PL, l, lds, (8 * (MLROW / 2) + 511) / 512);
    gsync(grid);
    if (DBG_STOP == 5 && l == 0) { dbg_dump_raw(PL, BG_SC); return true; }
    phase_ml_s3(PL, l, lds, ntc);
    gsync(grid);
    }
    if (DBG_STOP == 6 && l == 0) { dbg_dump_br(PL, 1); return true; }
    { pg8::Sched S{(const char*)H, (size_t)D * 2, (const char*)WA + WA_D, 1024, T / 256, NB_D / 256, G, c};
      pg8::EpiStore E{(bf16_t*)(BIG + BG_PD), NB_D, NB_D}; pg8::gemm_phase(ldsl, S, E); }
    gsync(grid);
    for (int rep = 0; rep < REP_SCAN; ++rep) {
    phase_ssd_s1(PL, l, lds);
    gsync(grid);
    phase_ssd_s2(PL);
    gsync(grid);
    phase_ssd_s3(PL, l, lds, ntc);
    gsync(grid);
    }
    { pg8::Sched S{(const char*)H, (size_t)D * 2, (const char*)WA + WA_AC, 1024, T / 256, NB_AC / 256, G, c};
      pg8::EpiStore E{(bf16_t*)(BIG + BG_PAC), NB_AC, NB_AC}; pg8::gemm_phase(ldsl, S, E); }
    gsync(grid);
    phase_attn_prep(PL, l);
    for (int k = 0; k < 4; ++k) transpose_job(PL.in[23] + ((size_t)l * 4 + k) * 1024 * 1024, 1024, 1024, 1024, 1024, (bf16_t*)(ws + WS_WA) + (size_t)k * 1024 * 1024, lds);
    gsync(grid);
    { pg8::Sched S{(const char*)(BIG + BG_PAC) + 1536 * 2, (size_t)NB_AC * 2, (const char*)WB + WB_UQ, 384, T / 256, 2, G, c};
      pg8::EpiStore E{(bf16_t*)(BIG + BG_QUP), 384, 384}; pg8::gemm_phase(ldsl, S, E); }
    { pg8::Sched S{(const char*)(BIG + BG_PAC) + 1920 * 2, (size_t)NB_AC * 2, (const char*)WB + WB_UKV, 256, T / 256, 3, G, c};
      pg8::EpiStore E{(bf16_t*)(BIG + BG_KVUP), 768, 768}; pg8::gemm_phase(ldsl, S, E); }
    gsync(grid);
    for (int rep = 0; rep < REP_ATTN; ++rep) { phase_attention(PL, l, (char*)lds);
    gsync(grid); }
    if (DBG_STOP == 1 && l == 0) { dbg_dump_br(PL, 0); return true; }
    if (DBG_STOP == 2 && l == 0) { dbg_dump_br(PL, 1); return true; }
    if (DBG_STOP == 3 && l == 0) { dbg_dump_br(PL, 2); return true; }
    { pg8::Sched S{(const char*)H, (size_t)D * 2, (const char*)WA, 1024, Mm / 256, 16, G, c};
      pg8::EpiAct<0> E{(bf16_t*)BIG, 4096, PL.in[24] + (size_t)l * 4096}; pg8::gemm_phase(ldsl, S, E); }
    gsync(grid);
    { pg8::HSched S{(const char*)(ws + WS_BR), (size_t)512 * 2, (size_t)T * 512 * 2, (const char*)WB + WB_BR, (size_t)1024 * 512 * 2, 512, Mm / 256, 4, G, c};
      pg8::EpiHorner E{(const bf16_t*)BIG, H}; pg8::gemm_phase(ldsl, S, E); }
    transpose_job(PL.in[29] + (size_t)l * 1024 * 4096, 4096, 1024, 4096, 4096, (bf16_t*)(ws + WS_WA), lds);
    gsync(grid);
    { pg8::Sched S{(const char*)H, (size_t)D * 2, (const char*)WB + WB_WO, 1024, TL / 256, 4, G, c};
      pg8::EpiResid E{xin_l, xin_c, PL.out, XC, mod_l + 2048, mod_c + 2048, nullptr}; pg8::gemm_phase(ldsl, S, E); }
    if (l == 0) {
      pg8::KSched S{(const char*)(H + (size_t)TL * D), (size_t)D * 2, (const char*)WB + WB_WO, 1024, 256, 4, 4, G, (c + G / 2) % G};
      pg8::EpiAtomic E{(float*)(ws + WS_ACC)}; pg8::gemm_phase(ldsl, S, E); }
    gsync(grid);
    if (l == 0) phase_ln_affine_mod(PL.out, XC, PL.in[27] + l * 1024, PL.in[28] + l * 1024, mod_l, mod_c, 3072, 4096, H, Mm, PL.in[2], (const float*)(ws + WS_ACC), mod_c + 2048, nullptr);
    else phase_ln_affine_mod(PL.out, XC, PL.in[27] + l * 1024, PL.in[28] + l * 1024, mod_l, mod_c, 3072, 4096, H, Mm);
    transpose_job(PL.in[31] + (size_t)l * 4096 * 1024, 1024, 4096, 1024, 1024, (bf16_t*)WB, lds);
    gsync(grid);
    { pg8::Sched S{(const char*)H, (size_t)D * 2, (const char*)WA, 1024, Mm / 256, 16, G, c};
      pg8::EpiAct<1> E{(bf16_t*)BIG, 4096, PL.in[30] + (size_t)l * 4096}; pg8::gemm_phase(ldsl, S, E); }
    gsync(grid);
    { pg8::Sched S{(const char*)BIG, (size_t)4096 * 2, (const char*)WB, 4096, TL / 256, 4, G, c};
      pg8::EpiResid E{PL.out, XC, PL.out, XC, mod_l + 5120, mod_c + 5120, PL.in[32] + l * 1024}; pg8::gemm_phase(ldsl, S, E); }
    if (l == 0) {
      pg8::KSched S{(const char*)BIG + (size_t)TL * 4096 * 2, (size_t)4096 * 2, (const char*)WB, 4096, 1024, 4, 4, G, (c + G / 2) % G};
      pg8::EpiAtomic E{(float*)(ws + WS_ACC) + (size_t)TC * D}; pg8::gemm_phase(ldsl, S, E); }
    gsync(grid);
    if (l == 0) {
      const float* m1l = MOD + (size_t)(2 + 0) * 6144; const float* m1c = MOD + (size_t)(2 + 1) * 6144;
      phase_ln_affine_mod(PL.out, XC, PL.in[33], PL.in[34], m1l, m1c, 0, 1024, H, T, XC, (const float*)(ws + WS_ACC) + (size_t)TC * D, mod_c + 5120, PL.in[32]);
      convert_layer_start(PL, 1, lds);
      gsync(grid);
    } else {
      phase_ln_affine_mod(PL.out, XC, PL.in[33] + 1024, PL.in[34] + 1024, mod_l, mod_c, 0, 1024, nullptr, TL);
    }
  return false;
}
__global__ void __launch_bounds__(512) fwd_megakernel(Params p_unused) {
  cg::grid_group grid = cg::this_grid();
  unsigned char* lds = dyn_lds;
  KP kp = (KP)__builtin_amdgcn_kernarg_segment_ptr();
  { volatile LAS unsigned* st = (volatile LAS unsigned*)((LAS unsigned char*)dyn_lds + LDS_PHASE);
    if (tidx() == 0) { st[0] = 0u; st[1] = 0u; (void)xb_add((unsigned*)(PL.ws + WS_BAR) + XB_XCNT(xb_xcc_id()), 1u); }
    __syncthreads();
    if (PL.out == nullptr) grid.sync(); }
  phase_setup(PL, lds);
  __syncthreads();
  convert_layer_start(PL, 0, lds);
  gsync(grid);
  { const Params& p = PL; const float* MOD = (const float*)(p.ws + WS_MOD);
    phase_ln_mod(p.in[0], p.in[2], MOD + 0 * 6144, MOD + 1 * 6144, 0, 1024, (bf16_t*)(p.ws + WS_H), T); }
  gsync(grid);
  if (layer_fwd<0>(kp, grid)) return;
  layer_fwd<1>(kp, grid);
}

extern "C" void kernel_launch(void* const* d_in, const int* in_sizes, int n_in, void* d_out, int out_size, void* d_ws, size_t ws_size, hipStream_t stream) {
  static int grid_blocks = 0;
  if (grid_blocks == 0) {
    if (n_in != 35 || out_size != TL * D || ws_size < WS_END) { fprintf(stderr, "kernel_launch: unexpected shapes: n_in %d out %d ws %zu (need %zu)\n", n_in, out_size, ws_size, (size_t)WS_END); grid_blocks = -1; return; }
    int dev = 0, cus = 0, per_cu = 0;
    (void)hipGetDevice(&dev);
    (void)hipDeviceGetAttribute(&cus, hipDeviceAttributeMultiprocessorCount, dev);
    (void)hipFuncSetAttribute((const void*)fwd_megakernel, hipFuncAttributeMaxDynamicSharedMemorySize, LDS_BYTES);
    (void)hipOccupancyMaxActiveBlocksPerMultiprocessor(&per_cu, (const void*)fwd_megakernel, 512, LDS_BYTES);
    if (per_cu < 1) per_cu = 1;
    grid_blocks = cus * 1;
    fprintf(stderr, "kernel_launch: grid %d (cus %d, occupancy %d), ws %zu need %zu\n", grid_blocks, cus, per_cu, ws_size, (size_t)WS_END);
  }
  if (grid_blocks < 0) return;
  Params p{};
  for (int i = 0; i < 35; ++i) p.in[i] = (const float*)d_in[i];
  p.out = (float*)d_out; p.ws = (unsigned char*)d_ws;
  (void)hipMemsetAsync((unsigned char*)d_ws + WS_BAR, 0, XCD_BAR_WORDS * 4, stream);
  void* args[] = {&p};
  hipError_t e = hipLaunchCooperativeKernel((void*)fwd_megakernel, dim3(grid_blocks), dim3(512), args, LDS_BYTES, stream);
  if (e != hipSuccess) fprintf(stderr, "cooperative launch failed: %s (grid %d)\n", hipGetErrorString(e), grid_blocks);
}
```

```cpp
#include <hip/hip_runtime.h>
#include <hip/hip_cooperative_groups.h>
#include <cstdio>
#include <cstdint>
namespace cg = cooperative_groups;
#define DI __device__ __forceinline__
#define LAS __attribute__((address_space(3)))
typedef unsigned short bf16_t;
typedef short bf16x8 __attribute__((ext_vector_type(8)));
typedef short s16x4 __attribute__((ext_vector_type(4)));
typedef float f32x4 __attribute__((ext_vector_type(4)));
typedef float f32x16 __attribute__((ext_vector_type(16)));
typedef unsigned u32x4 __attribute__((ext_vector_type(4)));
typedef unsigned u32x2 __attribute__((ext_vector_type(2)));

constexpr int TL = 16384, TC = 256, T = TL + TC, D = 1024, FF = 4096;
constexpr int NCH = T / 64;
constexpr float ALPHA = 1.4142135623730951f;
constexpr float EPS = 1e-6f;
constexpr int NB_B = 1792, NB_D = 1536, NB_AC = 2304;
constexpr int LDS_PHASE = 156672;
constexpr int LDS_BYTES = LDS_PHASE + 16;
constexpr int MLROW = 8192 + 64;

constexpr size_t al256(size_t x) { return (x + 255) / 256 * 256; }
constexpr size_t WS_TAB32 = 0;
constexpr size_t WS_TAB16 = WS_TAB32 + 256 * 16 * 2 * 4;
constexpr size_t WS_LAM = WS_TAB16 + 256 * 8 * 2 * 4;
constexpr size_t WS_MOD = WS_LAM + 256;
constexpr size_t WS_BAR = al256(WS_MOD + 2 * 2 * 6144 * 4);
constexpr size_t WS_XC = al256(WS_BAR + 16384);
constexpr size_t WS_ACC = al256(WS_XC + (size_t)TC * D * 4);
constexpr size_t WS_WA = al256(WS_ACC + (size_t)2 * TC * D * 4);
constexpr size_t WS_WB = al256(WS_WA + (size_t)5632 * 1024 * 2);
constexpr size_t WS_H = al256(WS_WB + (size_t)4096 * 1024 * 2);
constexpr size_t WS_BR = al256(WS_H + (size_t)T * D * 2);
constexpr size_t WS_BIG = al256(WS_BR + (size_t)4 * T * 512 * 2);
constexpr size_t BIG_BYTES = (size_t)T * 4096 * 2;
constexpr size_t WS_END = WS_BIG + BIG_BYTES;
constexpr size_t BG_PB = 0;
constexpr size_t BG_UC = al256(BG_PB + (size_t)T * NB_B * 2);
constexpr size_t BG_SC = al256(BG_UC + (size_t)8 * NCH * MLROW * 2);
constexpr size_t BG_MSC = al256(BG_SC + (size_t)8 * NCH * MLROW * 2);
constexpr size_t BG_ML_END = BG_MSC + 3 * 8 * NCH * 4;
static_assert(BG_ML_END <= BIG_BYTES, "mlstm overlay");
constexpr size_t BG_PD = 0;
constexpr size_t BG_UH = al256(BG_PD + (size_t)T * NB_D * 2);
constexpr size_t BG_SH = al256(BG_UH + (size_t)16 * NCH * 4096 * 2);
constexpr size_t BG_DE = al256(BG_SH + (size_t)16 * NCH * 4096 * 2);
constexpr size_t BG_SSD_END = BG_DE + 16 * NCH * 4;
static_assert(BG_SSD_END <= BIG_BYTES, "ssd overlay");
constexpr size_t BG_PAC = 0;
constexpr size_t BG_QUP = al256(BG_PAC + (size_t)T * NB_AC * 2);
constexpr size_t BG_KVUP = al256(BG_QUP + (size_t)T * 384 * 2);
static_assert(BG_KVUP + (size_t)T * 768 * 2 <= BIG_BYTES, "attn overlay");
constexpr size_t WB_UQ = 0, WB_UKV = 512 * 384 * 2, WB_BR = WB_UKV + 768 * 256 * 2, WB_WO = WB_BR + (size_t)4 * 1024 * 512 * 2;
static_assert(WB_WO + 1024 * 1024 * 2 <= (size_t)4096 * 1024 * 2, "slot B");
constexpr size_t WA_B = 0, WA_D = (size_t)NB_B * 1024 * 2, WA_AC = WA_D + (size_t)NB_D * 1024 * 2;

struct Params { const float* in[35]; float* out; unsigned char* ws; };

typedef __bf16 bf16x2_t __attribute__((ext_vector_type(2)));
typedef float f32x2_t __attribute__((ext_vector_type(2)));
DI unsigned cvtpk(float lo, float hi) { f32x2_t v = {lo, hi}; bf16x2_t b = __builtin_convertvector(v, bf16x2_t); return __builtin_bit_cast(unsigned, b); }
DI bf16_t f2bf(float x) { return (bf16_t)(cvtpk(x, 0.f) & 0xffffu); }
DI float bf2f(bf16_t v) { return __uint_as_float((unsigned)v << 16); }
DI float bflo(unsigned w) { return __uint_as_float(w << 16); }
DI float bfhi(unsigned w) { return __uint_as_float(w & 0xffff0000u); }
DI float wave_sum(float v) {
#pragma unroll
  for (int o = 1; o < 64; o <<= 1) v += __shfl_xor(v, o);
  return v;
}
DI float wave_max(float v) {
#pragma unroll
  for (int o = 1; o < 64; o <<= 1) v = fmaxf(v, __shfl_xor(v, o));
  return v;
}
DI float sigmoidf(float x) { return __builtin_amdgcn_rcpf(1.f + __expf(-x)); }
DI float siluf(float x) { return x / (1.f + __expf(-x)); }
DI int tidx() { int t = (int)__builtin_amdgcn_workitem_id_x(); asm volatile("" : "+v"(t)); return t; }
#define LDS_WAIT() asm volatile("s_waitcnt lgkmcnt(0)" ::: "memory")

namespace pg8 {
constexpr int BM = 256, BK = 64, HALF = 128, HTB = HALF * BK * 2, STAGE_BYTES = 8 * HTB, NXCD = 8, WGM = 8;
DI int lds_byte(int r, int c) { const int st = (r >> 4) * 2 + (c >> 5), rr = r & 15, cc = c & 31, ob = rr * 64 + cc * 2; return st * 1024 + (ob ^ (((ob >> 9) & 1) << 5)); }
DI void stage_rc(int b, int& R, int& C) { const int st = b / 1024, sb = b % 1024, swz = sb ^ (((sb >> 9) & 1) << 5); R = (st >> 1) * 16 + swz / 64; C = (st & 1) * 32 + (swz % 64) / 2; }
DI int perm32(int rho) { const int n = rho >> 4, i = rho & 15; return 8 * (i >> 2) + 4 * n + (i & 3); }
struct Unit { int pm, pn, k; };
DI void tile_order(int L, int nM, int nN, int& pm, int& pn) {
  const int nwg = nM * nN; int wgid = L;
  { const int q = nwg / NXCD, r = nwg % NXCD, xcd = wgid % NXCD, off = wgid / NXCD; wgid = (xcd < r ? xcd * (q + 1) : r * (q + 1) + (xcd - r) * q) + off; }
  const int nig = WGM * nN, gid = wgid / nig, fm = gid * WGM, gsz = (nM - fm) < WGM ? (nM - fm) : WGM;
  pm = fm + ((wgid % nig) % gsz); pn = (wgid % nig) / gsz;
}
struct Sched {
  const char* A; size_t lda_b; const char* Bt; int K; int nM, nN, G, c;
  DI bool next(int i, Unit& u) const { const long L = (long)i * G + c; if (L >= (long)nM * nN) return false; tile_order((int)L, nM, nN, u.pm, u.pn); u.k = 0; return true; }
  DI const char* a_ptr(const Unit& u) const { return A + (size_t)u.pm * BM * lda_b; }
  DI const char* b_ptr(const Unit& u) const { return Bt + (size_t)u.pn * BM * K * 2; }
  DI int ldb_e() const { return K; }
};
struct HSched {
  const char* A; size_t lda_b; size_t a_ks; const char* Bt; size_t b_ks; int K; int nM, nN, G, c;
  DI bool next(int i, Unit& u) const { const long L = (long)(i >> 2) * G + c; if (L >= (long)nM * nN) return false; tile_order((int)L, nM, nN, u.pm, u.pn); u.k = i & 3; return true; }
  DI const char* a_ptr(const Unit& u) const { return A + (size_t)u.k * a_ks + (size_t)u.pm * BM * lda_b; }
  DI const char* b_ptr(const Unit& u) const { return Bt + (size_t)u.k * b_ks + (size_t)u.pn * BM * K * 2; }
  DI int ldb_e() const { return K; }
};
struct KSched {
  const char* A; size_t lda_b; const char* Bt; int ldb; int K; int nks, nN, G, c;
  DI bool next(int i, Unit& u) const { const long L = (long)i * G + c; if (L >= (long)nN * nks) return false; u.pm = 0; u.pn = (int)(L % nN); u.k = (int)(L / nN); return true; }
  DI const char* a_ptr(const Unit& u) const { return A + (size_t)u.k * K * 2; }
  DI const char* b_ptr(const Unit& u) const { return Bt + ((size_t)u.pn * BM * ldb + (size_t)u.k * K) * 2; }
  DI int ldb_e() const { return ldb; }
};

template <class Epi, class SchedT>
DI void gemm_phase(LAS unsigned char* lds, const SchedT& S, const Epi& E) {
  const int tid = tidx(), wid = __builtin_amdgcn_readfirstlane(tid >> 6), lane = tid & 63, wr = wid >> 2, wc = wid & 3, fr = lane & 15, fq = lane >> 4;
  const int K = S.K, nt = K / BK, ldb = S.ldb_e();
  unsigned voffA[2], voffB[2];
#pragma unroll
  for (int i = 0; i < 2; ++i) { int R, C; stage_rc(tid * 16 + i * 8192, R, C); const int Rb = Epi::PERM ? ((R & ~31) + perm32(R & 31)) : R;
    voffA[i] = (unsigned)(R * (int)S.lda_b + C * 2); voffB[i] = (unsigned)(Rb * ldb + C) * 2u; }
  const size_t kstep = (size_t)(BK * 2);
  const size_t hsA = (size_t)HALF * S.lda_b, hsB = (size_t)HALF * ldb * 2;
  const unsigned ldsw = (unsigned)wid * 1024u;
  const int aoff = lds_byte(wr * 64 + fr, fq * 8), boff = lds_byte(wc * 32 + fr, fq * 8);
#define PG8_SA(b, h) (((b) * 2 + (h)) * HTB)
#define PG8_SB(b, h) ((4 + (b) * 2 + (h)) * HTB)
#define PG8_STAGE(bufoff, gbase, voff) do { _Pragma("unroll") for (int _i = 0; _i < 2; ++_i) \
    __builtin_amdgcn_global_load_lds((const unsigned*)((const char*)(gbase) + (voff)[_i]), (LAS unsigned*)(lds + (bufoff) + ldsw + _i * 8192), 16, 0, 0); } while (0)
#define PG8_LDA(dst, b, h) do { _Pragma("unroll") for (int m = 0; m < 4; ++m) _Pragma("unroll") for (int k = 0; k < 2; ++k) dst[m][k] = *(const LAS bf16x8*)(lds + PG8_SA(b, h) + aoff + m * 2048 + k * 1024); } while (0)
#define PG8_LDB(dst, b, h) do { _Pragma("unroll") for (int n = 0; n < 2; ++n) _Pragma("unroll") for (int k = 0; k < 2; ++k) dst[n][k] = *(const LAS bf16x8*)(lds + PG8_SB(b, h) + boff + n * 2048 + k * 1024); } while (0)
#define PG8_MMA(ai, bj, At, Bt) do { __builtin_amdgcn_s_setprio(1); _Pragma("unroll") for (int m = 0; m < 4; ++m) _Pragma("unroll") for (int n = 0; n < 2; ++n) _Pragma("unroll") for (int k = 0; k < 2; ++k) \
    acc[ai][bj][m][n] = __builtin_amdgcn_mfma_f32_16x16x32_bf16(Bt[n][k], At[m][k], acc[ai][bj][m][n], 0, 0, 0); __builtin_amdgcn_s_setprio(0); } while (0)
#define PG8_WAIT_V(n) asm volatile("s_waitcnt vmcnt(" #n ")" ::: "memory")
#define PG8_WAIT_L(n) asm volatile("s_waitcnt lgkmcnt(" #n ")" ::: "memory")
#define PG8_BAR __builtin_amdgcn_s_barrier()
#define PG8_SCHED __builtin_amdgcn_sched_barrier(0)
  Unit cur, nxt; int ui = 0;
  if (!S.next(0, cur)) return;
  f32x4 acc[2][2][4][2];
#pragma unroll
  for (int a = 0; a < 2; ++a)
#pragma unroll
    for (int b = 0; b < 2; ++b)
#pragma unroll
      for (int m = 0; m < 4; ++m)
#pragma unroll
        for (int n = 0; n < 2; ++n) acc[a][b][m][n] = (f32x4){0.f, 0.f, 0.f, 0.f};
  bf16x8 At[4][2], B0[2][2], B1[2][2];
  const char* cA = S.a_ptr(cur); const char* cB = S.b_ptr(cur);
  PG8_STAGE(PG8_SB(0, 0), cB, voffB); PG8_STAGE(PG8_SA(0, 0), cA, voffA); PG8_STAGE(PG8_SB(0, 1), cB + hsB, voffB); PG8_STAGE(PG8_SA(0, 1), cA + hsA, voffA);
  if (wr == 1) PG8_BAR;
  PG8_WAIT_V(4); PG8_BAR;
  PG8_STAGE(PG8_SB(1, 0), cB + kstep, voffB); PG8_STAGE(PG8_SA(1, 0), cA + kstep, voffA); PG8_STAGE(PG8_SB(1, 1), cB + hsB + kstep, voffB);
  PG8_WAIT_V(6); PG8_BAR;
  for (;;) {
    const bool has_next = S.next(ui + 1, nxt);
    const char* nA = has_next ? S.a_ptr(nxt) : cA; const char* nB = has_next ? S.b_ptr(nxt) : cB;
    for (int t = 0; t < nt; t += 2) {
      const bool last = (t == nt - 2);
      const char* a1 = cA + (size_t)(t + 1) * kstep;
      const char* a2 = last ? nA : cA + (size_t)(t + 2) * kstep; const char* b2 = last ? nB : cB + (size_t)(t + 2) * kstep;
      const char* a3 = a2 + kstep; const char* b3 = b2 + kstep;
      PG8_LDB(B0, 0, 0); PG8_SCHED; PG8_LDA(At, 0, 0); PG8_STAGE(PG8_SA(1, 1), a1 + hsA, voffA);
      PG8_WAIT_L(8); PG8_BAR; PG8_WAIT_L(0); PG8_MMA(0, 0, At, B0); PG8_BAR; PG8_SCHED;
      PG8_LDB(B1, 0, 1); PG8_STAGE(PG8_SB(0, 0), b2, voffB);
      PG8_BAR; PG8_WAIT_L(0); PG8_MMA(0, 1, At, B1); PG8_BAR;
      PG8_LDA(At, 0, 1); PG8_STAGE(PG8_SA(0, 0), a2, voffA);
      PG8_BAR; PG8_WAIT_L(0); PG8_MMA(1, 0, At, B0); PG8_BAR; PG8_SCHED;
      PG8_STAGE(PG8_SB(0, 1), b2 + hsB, voffB);
      PG8_WAIT_V(6); PG8_BAR; PG8_MMA(1, 1, At, B1); PG8_BAR;
      PG8_LDB(B0, 1, 0); PG8_SCHED; PG8_LDA(At, 1, 0); PG8_STAGE(PG8_SA(0, 1), a2 + hsA, voffA);
      PG8_WAIT_L(8); PG8_BAR; PG8_WAIT_L(0); PG8_MMA(0, 0, At, B0); PG8_BAR; PG8_SCHED;
      PG8_LDB(B1, 1, 1); PG8_STAGE(PG8_SB(1, 0), b3, voffB);
      PG8_BAR; PG8_WAIT_L(0); PG8_MMA(0, 1, At, B1); PG8_BAR;
      PG8_LDA(At, 1, 1); PG8_STAGE(PG8_SA(1, 0), a3, voffA);
      PG8_BAR; PG8_WAIT_L(0); PG8_MMA(1, 0, At, B0); PG8_BAR; PG8_SCHED;
      PG8_STAGE(PG8_SB(1, 1), b3 + hsB, voffB);
      PG8_WAIT_V(6); PG8_BAR; PG8_MMA(1, 1, At, B1); PG8_BAR;
    }
    const bool zero = E(acc, cur, wr, wc, fr, fq);
    if (zero) {
#pragma unroll
      for (int a = 0; a < 2; ++a)
#pragma unroll
        for (int b = 0; b < 2; ++b)
#pragma unroll
          for (int m = 0; m < 4; ++m)
#pragma unroll
            for (int n = 0; n < 2; ++n) acc[a][b][m][n] = (f32x4){0.f, 0.f, 0.f, 0.f};
    }
    if (!has_next) break;
    cur = nxt; cA = nA; cB = nB; ++ui;
  }
  PG8_WAIT_V(0);
  if (wr == 0) PG8_BAR;
  PG8_BAR;
#undef PG8_SA
#undef PG8_SB
#undef PG8_STAGE
#undef PG8_LDA
#undef PG8_LDB
#undef PG8_MMA
#undef PG8_WAIT_V
#undef PG8_WAIT_L
#undef PG8_BAR
#undef PG8_SCHED
}

typedef f32x4 Acc[2][2][4][2];
struct EpiStore {
  static constexpr bool PERM = true;
  bf16_t* O; int ldc; int ncols;
  DI bool operator()(Acc& acc, const Unit& u, int wr, int wc, int fr, int fq) const {
    const int row0 = u.pm * BM + wr * 64 + fr, col0 = u.pn * BM + wc * 32 + 8 * fq;
#pragma unroll
    for (int ai = 0; ai < 2; ++ai)
#pragma unroll
      for (int m = 0; m < 4; ++m) { bf16_t* rowp = O + (size_t)(row0 + ai * HALF + m * 16) * ldc;
#pragma unroll
        for (int bj = 0; bj < 2; ++bj) { const int col = col0 + bj * HALF; const f32x4 v0 = acc[ai][bj][m][0], v1 = acc[ai][bj][m][1];
          u32x4 w; w.x = cvtpk(v0[0], v0[1]); w.y = cvtpk(v0[2], v0[3]); w.z = cvtpk(v1[0], v1[1]); w.w = cvtpk(v1[2], v1[3]);
          if (col < ncols) *(u32x4*)(rowp + col) = w; } }
    return true;
  }
};
template <int ACT> struct EpiAct {
  static constexpr bool PERM = true;
  bf16_t* O; int ldc; const float* bias;
  DI bool operator()(Acc& acc, const Unit& u, int wr, int wc, int fr, int fq) const {
    const int row0 = u.pm * BM + wr * 64 + fr, col0 = u.pn * BM + wc * 32 + 8 * fq;
    f32x4 bv[2][2];
#pragma unroll
    for (int bj = 0; bj < 2; ++bj)
#pragma unroll
      for (int n = 0; n < 2; ++n) bv[bj][n] = *(const f32x4*)(bias + col0 + bj * HALF + 4 * n);
#pragma unroll
    for (int ai = 0; ai < 2; ++ai)
#pragma unroll
      for (int m = 0; m < 4; ++m) { bf16_t* rowp = O + (size_t)(row0 + ai * HALF + m * 16) * ldc + col0;
#pragma unroll
        for (int bj = 0; bj < 2; ++bj) { f32x4 v0 = acc[ai][bj][m][0] + bv[bj][0], v1 = acc[ai][bj][m][1] + bv[bj][1];
#pragma unroll
          for (int j = 0; j < 4; ++j) {
            if (ACT == 0) { v0[j] = sigmoidf(v0[j]); v1[j] = sigmoidf(v1[j]); }
            else { const float a = fmaxf(v0[j], 0.f), b = fmaxf(v1[j], 0.f); v0[j] = a * a; v1[j] = b * b; } }
          u32x4 w; w.x = cvtpk(v0[0], v0[1]); w.y = cvtpk(v0[2], v0[3]); w.z = cvtpk(v1[0], v1[1]); w.w = cvtpk(v1[2], v1[3]);
          *(u32x4*)(rowp + bj * HALF) = w; } }
    return true;
  }
};
struct EpiHorner {
  static constexpr bool PERM = true;
  const bf16_t* G; bf16_t* Z;
  DI bool operator()(Acc& acc, const Unit& u, int wr, int wc, int fr, int fq) const {
    const int row0 = u.pm * BM + wr * 64 + fr, col0 = u.pn * BM + wc * 32 + 8 * fq, k = u.k;
    const int k1 = k < 3 ? k + 1 : k;
#pragma unroll
    for (int ai = 0; ai < 2; ++ai)
#pragma unroll
      for (int m = 0; m < 4; ++m) { const size_t row = (size_t)(row0 + ai * HALF + m * 16);
        u32x4 s0[2], s1[2];
#pragma unroll
        for (int bj = 0; bj < 2; ++bj) { s0[bj] = *(const u32x4*)(G + row * 4096 + k * 1024 + col0 + bj * HALF); s1[bj] = *(const u32x4*)(G + row * 4096 + k1 * 1024 + col0 + bj * HALF); }
#pragma unroll
        for (int bj = 0; bj < 2; ++bj) { const int col = col0 + bj * HALF;
          float f[8] = {bflo(s0[bj].x), bfhi(s0[bj].x), bflo(s0[bj].y), bfhi(s0[bj].y), bflo(s0[bj].z), bfhi(s0[bj].z), bflo(s0[bj].w), bfhi(s0[bj].w)};
          if (k < 3) { const float d[8] = {bflo(s1[bj].x), bfhi(s1[bj].x), bflo(s1[bj].y), bfhi(s1[bj].y), bflo(s1[bj].z), bfhi(s1[bj].z), bflo(s1[bj].w), bfhi(s1[bj].w)};
#pragma unroll
            for (int j = 0; j < 8; ++j) f[j] = f[j] * __builtin_amdgcn_rcpf(d[j]); }
          f32x4 v0 = acc[ai][bj][m][0], v1 = acc[ai][bj][m][1];
#pragma unroll
          for (int j = 0; j < 4; ++j) { v0[j] *= f[j]; v1[j] *= f[4 + j]; }
          acc[ai][bj][m][0] = v0; acc[ai][bj][m][1] = v1;
          if (k == 3) { u32x4 w; w.x = cvtpk(v0[0], v0[1]); w.y = cvtpk(v0[2], v0[3]); w.z = cvtpk(v1[0], v1[1]); w.w = cvtpk(v1[2], v1[3]);
            *(u32x4*)(Z + row * 1024 + col) = w; } } }
    return k == 3;
  }
};
struct EpiResid {
  static constexpr bool PERM = false;
  const float* xin_l; const float* xin_c; float* out_l; float* out_c; const float* g_l; const float* g_c; const float* bias;
  DI bool operator()(Acc& acc, const Unit& u, int wr, int wc, int fr, int fq) const {
    const bool isc = u.pm >= TL / BM;
    const float* xin = isc ? xin_c - (size_t)TL * D : xin_l; float* out = isc ? out_c - (size_t)TL * D : out_l; const float* g = isc ? g_c : g_l;
    const int row0 = u.pm * BM + wr * 64 + fr, col0 = u.pn * BM + wc * 32 + 4 * fq;
    f32x4 gv[2][2], bv[2][2];
#pragma unroll
    for (int bj = 0; bj < 2; ++bj)
#pragma unroll
      for (int n = 0; n < 2; ++n) { gv[bj][n] = *(const f32x4*)(g + col0 + bj * HALF + n * 16); bv[bj][n] = bias ? *(const f32x4*)(bias + col0 + bj * HALF + n * 16) : (f32x4){0.f, 0.f, 0.f, 0.f}; }
#pragma unroll
    for (int ai = 0; ai < 2; ++ai)
#pragma unroll
      for (int m = 0; m < 4; ++m) { const size_t off = (size_t)(row0 + ai * HALF + m * 16) * D + col0;
        f32x4 xv[2][2];
#pragma unroll
        for (int bj = 0; bj < 2; ++bj)
#pragma unroll
          for (int n = 0; n < 2; ++n) xv[bj][n] = *(const f32x4*)(xin + off + bj * HALF + n * 16);
#pragma unroll
        for (int bj = 0; bj < 2; ++bj)
#pragma unroll
          for (int n = 0; n < 2; ++n) *(f32x4*)(out + off + bj * HALF + n * 16) = xv[bj][n] * ALPHA + gv[bj][n] * (acc[ai][bj][m][n] + bv[bj][n]); }
    return true;
  }
};
struct EpiAtomic {
  static constexpr bool PERM = false;
  float* ACC;
  DI bool operator()(Acc& acc, const Unit& u, int wr, int wc, int fr, int fq) const {
    const int row0 = wr * 64 + fr, col0 = u.pn * BM + wc * 32 + 4 * fq;
#pragma unroll
    for (int ai = 0; ai < 2; ++ai)
#pragma unroll
      for (int m = 0; m < 4; ++m) { float* rp = ACC + (size_t)(row0 + ai * HALF + m * 16) * D + col0;
#pragma unroll
        for (int bj = 0; bj < 2; ++bj)
#pragma unroll
          for (int n = 0; n < 2; ++n)
#pragma unroll
            for (int e = 0; e < 4; ++e) (void)__hip_atomic_fetch_add(rp + bj * HALF + n * 16 + e, acc[ai][bj][m][n][e], __ATOMIC_RELAXED, __HIP_MEMORY_SCOPE_AGENT); }
    return true;
  }
};
}

namespace att {
constexpr int QBLK = 32, KVBLK = 64;
constexpr float THR = 8.f;
constexpr size_t SHM_V = KVBLK * 128 * 2;
constexpr size_t OFF_K = 3 * SHM_V, OFF_WS = OFF_K + 3 * 64 * 208, OFF_O1 = OFF_WS + 8 * 64 * 4;
static_assert(OFF_O1 + 65536 <= LDS_PHASE, "attn lds");
#define SBAR() __builtin_amdgcn_sched_barrier(0)
DI int crow(int r, int hi) { return (r & 3) + 8 * (r >> 2) + 4 * hi; }
DI bf16x8 ld8(const bf16_t* p) { return *reinterpret_cast<const bf16x8*>(p); }

DI void partialSM(f32x16& p0, f32x16& p1, float& m_reg, float& mn, float& alpha, const float C, const float thr_raw) {
  float pmax = p0[0];
#pragma unroll
  for (int r = 1; r < 16; ++r) pmax = fmaxf(pmax, p0[r]);
#pragma unroll
  for (int r = 0; r < 16; ++r) pmax = fmaxf(pmax, p1[r]);
  { auto rr = __builtin_amdgcn_permlane32_swap(__float_as_uint(pmax), __float_as_uint(pmax), false, false);
    pmax = fmaxf(__uint_as_float(rr[0]), __uint_as_float(rr[1])); }
  if (__builtin_expect(__all(pmax - m_reg <= thr_raw), 1)) { mn = m_reg; alpha = 1.f; }
  else { mn = fmaxf(m_reg, pmax); alpha = __builtin_amdgcn_exp2f((m_reg - mn) * C); m_reg = mn; }
  const float mnC = -mn * C;
#pragma unroll
  for (int r = 0; r < 16; ++r) p0[r] = fmaf(p0[r], C, mnC);
#pragma unroll
  for (int r = 0; r < 16; ++r) p1[r] = fmaf(p1[r], C, mnC);
#pragma unroll
  for (int r = 0; r < 16; ++r) p0[r] = __builtin_amdgcn_exp2f(p0[r]);
}
DI void finishSM(f32x16& p0, f32x16& p1, float alpha, float& l_reg, bf16x8& pa0, bf16x8& pa1, bf16x8& pa2, bf16x8& pa3) {
#pragma unroll
  for (int r = 0; r < 16; ++r) p1[r] = __builtin_amdgcn_exp2f(p1[r]);
  float ps = 0;
#pragma unroll
  for (int r = 0; r < 16; ++r) ps += p0[r];
#pragma unroll
  for (int r = 0; r < 16; ++r) ps += p1[r];
  { auto rr = __builtin_amdgcn_permlane32_swap(__float_as_uint(ps), __float_as_uint(ps), false, false);
    ps = __uint_as_float(rr[0]) + __uint_as_float(rr[1]); }
  l_reg = l_reg * alpha + ps;
#define PK4(P, BASE, OUT) do { unsigned a0 = cvtpk(P[BASE + 0], P[BASE + 1]), a1 = cvtpk(P[BASE + 2], P[BASE + 3]);   \
    unsigned b0 = cvtpk(P[BASE + 4], P[BASE + 5]), b1 = cvtpk(P[BASE + 6], P[BASE + 7]);                              \
    auto r0 = __builtin_amdgcn_permlane32_swap(a0, b0, false, false); auto r1 = __builtin_amdgcn_permlane32_swap(a1, b1, false, false); \
    u32x4 w = {r0[0], r1[0], r0[1], r1[1]}; OUT = *reinterpret_cast<bf16x8*>(&w); } while (0)
  PK4(p0, 0, pa0); PK4(p0, 8, pa1); PK4(p1, 0, pa2); PK4(p1, 8, pa3);
#undef PK4
}
template <int DQK>
DI void qkt(f32x16& p0, f32x16& p1, const char* Ks, const bf16x8* qr, int r32, int hi) {
  constexpr int KP = DQK * 2 + 16;
  p0 = f32x16{}; p1 = f32x16{};
#pragma unroll
  for (int d0 = 0; d0 < DQK / 16; ++d0) { const int cb = (d0 * 16 + hi * 8) * 2;
    bf16x8 b0 = *reinterpret_cast<const bf16x8*>(Ks + r32 * KP + cb);
    bf16x8 b1 = *reinterpret_cast<const bf16x8*>(Ks + (32 + r32) * KP + cb);
    p0 = __builtin_amdgcn_mfma_f32_32x32x16_bf16(b0, qr[d0], p0, 0, 0, 0);
    p1 = __builtin_amdgcn_mfma_f32_32x32x16_bf16(b1, qr[d0], p1, 0, 0, 0); }
}
DI int v_st(int k, int c) { const int kk = (k & ~0xC) | ((k & 4) << 1) | ((k & 8) >> 1); return ((kk >> 3) * 4 + (c >> 5)) * 512 + ((kk & 7) * 32 + (c & 31)) * 2; }
DI int v_rd_base(int lane) { return ((lane & 3) << 3) | (((lane >> 2) & 3) << 6) | (((lane >> 4) & 1) << 5) | (((lane >> 5) & 1) << 8); }
constexpr int v_rd_off(int d0, int ks, int half) { return d0 * 512 + ks * 4096 + half * 2048; }
template <int OFF> DI s16x4 tr_read(int vb) {
  s16x4 r; asm volatile("ds_read_b64_tr_b16 %0, %1 offset:%2" : "=&v"(r) : "v"(vb), "i"(OFF) : "memory"); return r;
}
template <int D0> DI void pv_one(f32x16& od, int vb, bf16x8 pa0, bf16x8 pa1, bf16x8 pa2, bf16x8 pa3) {
  const s16x4 l0 = tr_read<v_rd_off(D0, 0, 0)>(vb), h0 = tr_read<v_rd_off(D0, 0, 1)>(vb), l1 = tr_read<v_rd_off(D0, 1, 0)>(vb), h1 = tr_read<v_rd_off(D0, 1, 1)>(vb);
  const s16x4 l2 = tr_read<v_rd_off(D0, 2, 0)>(vb), h2 = tr_read<v_rd_off(D0, 2, 1)>(vb), l3 = tr_read<v_rd_off(D0, 3, 0)>(vb), h3 = tr_read<v_rd_off(D0, 3, 1)>(vb);
  asm volatile("s_waitcnt lgkmcnt(0)" ::: "memory"); SBAR();
#define PK(L, H) (bf16x8){L[0], L[1], L[2], L[3], H[0], H[1], H[2], H[3]}
  od = __builtin_amdgcn_mfma_f32_32x32x16_bf16(pa0, PK(l0, h0), od, 0, 0, 0);
  od = __builtin_amdgcn_mfma_f32_32x32x16_bf16(pa1, PK(l1, h1), od, 0, 0, 0);
  od = __builtin_amdgcn_mfma_f32_32x32x16_bf16(pa2, PK(l2, h2), od, 0, 0, 0);
  od = __builtin_amdgcn_mfma_f32_32x32x16_bf16(pa3, PK(l3, h3), od, 0, 0, 0);
#undef PK
}
template <int KS> DI void pv_step(f32x16* o, int vb, bf16x8 pa) {
  const s16x4 l0 = tr_read<v_rd_off(0, KS, 0)>(vb), h0 = tr_read<v_rd_off(0, KS, 1)>(vb), l1 = tr_read<v_rd_off(1, KS, 0)>(vb), h1 = tr_read<v_rd_off(1, KS, 1)>(vb);
  const s16x4 l2 = tr_read<v_rd_off(2, KS, 0)>(vb), h2 = tr_read<v_rd_off(2, KS, 1)>(vb), l3 = tr_read<v_rd_off(3, KS, 0)>(vb), h3 = tr_read<v_rd_off(3, KS, 1)>(vb);
  asm volatile("s_waitcnt lgkmcnt(0)" ::: "memory"); SBAR();
#define PK(L, H) (bf16x8){L[0], L[1], L[2], L[3], H[0], H[1], H[2], H[3]}
  o[0] = __builtin_amdgcn_mfma_f32_32x32x16_bf16(pa, PK(l0, h0), o[0], 0, 0, 0);
  o[1] = __builtin_amdgcn_mfma_f32_32x32x16_bf16(pa, PK(l1, h1), o[1], 0, 0, 0);
  o[2] = __builtin_amdgcn_mfma_f32_32x32x16_bf16(pa, PK(l2, h2), o[2], 0, 0, 0);
  o[3] = __builtin_amdgcn_mfma_f32_32x32x16_bf16(pa, PK(l3, h3), o[3], 0, 0, 0);
#undef PK
}
DI void pv_d0(f32x16* o, int vb, bf16x8 pa0, bf16x8 pa1, bf16x8 pa2, bf16x8 pa3) {
  pv_step<0>(o, vb, pa0); pv_step<1>(o, vb, pa1); pv_step<2>(o, vb, pa2); pv_step<3>(o, vb, pa3);
}

template <int DQK>
DI void attn_body(const bf16_t* __restrict__ Qb, int ldq, const bf16_t* __restrict__ K0, int ldk0, const bf16_t* __restrict__ K1, int ldk1,
                  const bf16_t* __restrict__ Vh, int ldv, int seq, float scale, char* lds, f32x16 (&o)[4], float (&rli)[16]) {
  constexpr int KP = DQK * 2 + 16, SHM_K = 64 * KP, CPR = DQK / 8;
  const float C = scale * 1.4426950408889634f, thr_raw = THR / scale;
  const int tid = tidx(), wid = tid >> 6, lane = tid & 63, r32 = lane & 31, hi = lane >> 5;
  char* V_lds = lds; char* K_lds = lds + OFF_K;
  float* wsl = (float*)(lds + OFF_WS) + wid * 64; float* li_l = wsl; float* al_l = wsl + 32;
  float m_reg = -1e30f, l_reg = 0; bf16x8 qr[DQK / 16];
#pragma unroll
  for (int d = 0; d < 4; ++d) o[d] = f32x16{};
  const bf16_t* Qw = Qb + (long)(wid * QBLK + r32) * ldq + hi * 8;
#pragma unroll
  for (int d0 = 0; d0 < DQK / 16; ++d0) qr[d0] = ld8(Qw + d0 * 16);
  const int sr = tid >> 4, sc = (tid & 15) * 8, vst0 = v_st(sr, sc), vst1 = v_st(32 + sr, sc);
  const int vb0 = (int)(uintptr_t)V_lds + v_rd_base(lane);
  const int kc0 = tid, kc1 = 512 + (tid & 255);
  const int kr0 = kc0 / CPR, kcc0 = kc0 % CPR, kr1 = (DQK == 96) ? kc1 / CPR : 0, kcc1 = (DQK == 96) ? kc1 % CPR : 0;
  const bf16_t* kp0 = (kcc0 < 8) ? K0 + (long)kr0 * ldk0 + kcc0 * 8 : K1 + (long)kr0 * ldk1 + (kcc0 - 8) * 8;
  const long kst0 = (kcc0 < 8) ? (long)64 * ldk0 : (long)64 * ldk1;
  const bf16_t* kp1 = (kcc1 < 8) ? K0 + (long)kr1 * ldk0 + kcc1 * 8 : K1 + (long)kr1 * ldk1 + (kcc1 - 8) * 8;
  const long kst1 = (kcc1 < 8) ? (long)64 * ldk0 : (long)64 * ldk1;
  const int kw0 = kr0 * KP + kcc0 * 16, kw1 = kr1 * KP + kcc1 * 16;
  struct { bf16x8 vs0, vs1, ks0, ks1; } sr_[2];
#define SLOAD(i, t) do { sr_[i].vs0 = ld8(&Vh[(long)((t) * 64 + sr) * ldv + sc]); sr_[i].vs1 = ld8(&Vh[(long)((t) * 64 + 32 + sr) * ldv + sc]); \
    sr_[i].ks0 = ld8(kp0 + (long)(t) * kst0); if (DQK == 96) sr_[i].ks1 = ld8(kp1 + (long)(t) * kst1); } while (0)
#define SWRITE(b, i) do { *(bf16x8*)(V_lds + (b) * SHM_V + vst0) = sr_[i].vs0; *(bf16x8*)(V_lds + (b) * SHM_V + vst1) = sr_[i].vs1; \
    *(bf16x8*)(K_lds + (b) * SHM_K + kw0) = sr_[i].ks0; if (DQK == 96) *(bf16x8*)(K_lds + (b) * SHM_K + kw1) = sr_[i].ks1; } while (0)
#define SWAIT() do { if (DQK == 96) asm volatile("s_waitcnt vmcnt(4)" ::: "memory"); else asm volatile("s_waitcnt vmcnt(3)" ::: "memory"); } while (0)
#define RESC(a) do { if (__any((a) < 1.f)) { if (hi == 0) al_l[r32] = (a); asm volatile("s_waitcnt lgkmcnt(0)" ::: "memory"); \
    _Pragma("unroll") for (int d = 0; d < 4; ++d) _Pragma("unroll") for (int r = 0; r < 16; ++r) o[d][r] *= al_l[crow(r, hi)]; } } while (0)
  f32x16 pA0, pA1, pB0, pB1; float mnA, mnB, alA, alB; bf16x8 pa0, pa1, pa2, pa3; const int NT = seq / KVBLK;
  constexpr int SE = 0, SO = 1;
  SLOAD(SE, 0); asm volatile("s_waitcnt vmcnt(0)" ::: "memory"); SWRITE(0, SE); __syncthreads();
  qkt<DQK>(pA0, pA1, K_lds, qr, r32, hi); partialSM(pA0, pA1, m_reg, mnA, alA, C, thr_raw);
  SLOAD(SO, 1); if (2 < NT) SLOAD(SE, 2);
  SWAIT(); SWRITE(1, SO); __syncthreads();
  int b = 1;
  for (int j = 1; j + 1 < NT; j += 2) {
    const int b1 = (b == 2) ? 0 : b + 1, b2 = (b == 0) ? 2 : b - 1;
    SBAR(); qkt<DQK>(pB0, pB1, K_lds + b * SHM_K, qr, r32, hi);
    finishSM(pA0, pA1, alA, l_reg, pa0, pa1, pa2, pa3); SBAR();
    SLOAD(SO, j + 2); SBAR();
    pv_d0(o, vb0 + b2 * (int)SHM_V, pa0, pa1, pa2, pa3); partialSM(pB0, pB1, m_reg, mnB, alB, C, thr_raw);
    SWAIT(); SWRITE(b1, SE);
    RESC(alB); __syncthreads();
    SBAR(); qkt<DQK>(pA0, pA1, K_lds + b1 * SHM_K, qr, r32, hi);
    finishSM(pB0, pB1, alB, l_reg, pa0, pa1, pa2, pa3); SBAR();
    if (j + 3 < NT) SLOAD(SE, j + 3); SBAR();
    pv_d0(o, vb0 + b * (int)SHM_V, pa0, pa1, pa2, pa3); partialSM(pA0, pA1, m_reg, mnA, alA, C, thr_raw);
    SWAIT(); SWRITE(b2, SO);
    RESC(alA); __syncthreads();
    b = b2;
  }
  { const int b2 = (b == 0) ? 2 : b - 1;
    SBAR(); qkt<DQK>(pB0, pB1, K_lds + b * SHM_K, qr, r32, hi);
    finishSM(pA0, pA1, alA, l_reg, pa0, pa1, pa2, pa3); SBAR();
    pv_d0(o, vb0 + b2 * (int)SHM_V, pa0, pa1, pa2, pa3); partialSM(pB0, pB1, m_reg, mnB, alB, C, thr_raw);
    RESC(alB);
    finishSM(pB0, pB1, alB, l_reg, pa0, pa1, pa2, pa3); SBAR();
    pv_d0(o, vb0 + b * (int)SHM_V, pa0, pa1, pa2, pa3); }
  if (hi == 0) li_l[r32] = l_reg; asm volatile("s_waitcnt lgkmcnt(0)" ::: "memory");
#pragma unroll
  for (int r = 0; r < 16; ++r) rli[r] = 1.f / li_l[crow(r, hi)];
  __syncthreads();
#undef SLOAD
#undef SWRITE
#undef SWAIT
#undef RESC
}

constexpr int D2_KT = 64 * 144, D2_KBUF = 2 * D2_KT, D2_OFF_K = 2 * (int)SHM_V, D2_OFF_Q = D2_OFF_K + 2 * D2_KBUF, D2_QM = 256 * 144, D2_OFF_WS = D2_OFF_Q + 2 * D2_QM;
static_assert(D2_OFF_WS + 8 * 512 <= LDS_PHASE, "diff2 lds");
DI void qkt_l(f32x16& p0, f32x16& p1, const char* Ks, const char* Qrow, int r32, int hi) {
  p0 = f32x16{}; p1 = f32x16{};
#pragma unroll
  for (int d0 = 0; d0 < 4; ++d0) { const int cb = (d0 * 16 + hi * 8) * 2;
    const bf16x8 qf = *reinterpret_cast<const bf16x8*>(Qrow + cb);
    const bf16x8 b0 = *reinterpret_cast<const bf16x8*>(Ks + r32 * 144 + cb);
    const bf16x8 b1 = *reinterpret_cast<const bf16x8*>(Ks + (32 + r32) * 144 + cb);
    p0 = __builtin_amdgcn_mfma_f32_32x32x16_bf16(b0, qf, p0, 0, 0, 0);
    p1 = __builtin_amdgcn_mfma_f32_32x32x16_bf16(b1, qf, p1, 0, 0, 0); }
}
template <int KS> DI void pv2_step(f32x16* o1, f32x16* o2, int vb, bf16x8 pa, bf16x8 pb) {
  const s16x4 l0 = tr_read<v_rd_off(0, KS, 0)>(vb), h0 = tr_read<v_rd_off(0, KS, 1)>(vb), l1 = tr_read<v_rd_off(1, KS, 0)>(vb), h1 = tr_read<v_rd_off(1, KS, 1)>(vb);
  const s16x4 l2 = tr_read<v_rd_off(2, KS, 0)>(vb), h2 = tr_read<v_rd_off(2, KS, 1)>(vb), l3 = tr_read<v_rd_off(3, KS, 0)>(vb), h3 = tr_read<v_rd_off(3, KS, 1)>(vb);
  asm volatile("s_waitcnt lgkmcnt(0)" ::: "memory"); SBAR();
#define PK(L, H) (bf16x8){L[0], L[1], L[2], L[3], H[0], H[1], H[2], H[3]}
  const bf16x8 v0 = PK(l0, h0), v1 = PK(l1, h1), v2 = PK(l2, h2), v3 = PK(l3, h3);
#undef PK
  o1[0] = __builtin_amdgcn_mfma_f32_32x32x16_bf16(pa, v0, o1[0], 0, 0, 0); o2[0] = __builtin_amdgcn_mfma_f32_32x32x16_bf16(pb, v0, o2[0], 0, 0, 0);
  o1[1] = __builtin_amdgcn_mfma_f32_32x32x16_bf16(pa, v1, o1[1], 0, 0, 0); o2[1] = __builtin_amdgcn_mfma_f32_32x32x16_bf16(pb, v1, o2[1], 0, 0, 0);
  o1[2] = __builtin_amdgcn_mfma_f32_32x32x16_bf16(pa, v2, o1[2], 0, 0, 0); o2[2] = __builtin_amdgcn_mfma_f32_32x32x16_bf16(pb, v2, o2[2], 0, 0, 0);
  o1[3] = __builtin_amdgcn_mfma_f32_32x32x16_bf16(pa, v3, o1[3], 0, 0, 0); o2[3] = __builtin_amdgcn_mfma_f32_32x32x16_bf16(pb, v3, o2[3], 0, 0, 0);
}
DI void attn_diff2(const bf16_t* __restrict__ Qg, int ldq, const bf16_t* __restrict__ Kg, int ldk, const bf16_t* __restrict__ Vg, int ldv, int seq, float scale,
                   char* lds, f32x16 (&o1)[4], f32x16 (&o2)[4], float (&rli1)[16], float (&rli2)[16]) {
  const float C = scale * 1.4426950408889634f, thr_raw = THR / scale;
  const int tid = tidx(), wid = tid >> 6, lane = tid & 63, r32 = lane & 31, hi = lane >> 5;
  char* V_lds = lds; char* K_lds = lds + D2_OFF_K; char* Q_lds = lds + D2_OFF_Q;
  float* wsl = (float*)(lds + D2_OFF_WS) + wid * 128; float* li1 = wsl; float* li2 = wsl + 32; float* al_l = wsl + 64;
#pragma unroll
  for (int i = 0; i < 8; ++i) { const int ch = tid + 512 * i, row = ch >> 4, cc = ch & 15;
    *(bf16x8*)(Q_lds + (cc >> 3) * D2_QM + row * 144 + (cc & 7) * 16) = ld8(Qg + (long)row * ldq + cc * 8); }
  const char* Q1row = Q_lds + (wid * 32 + r32) * 144; const char* Q2row = Q1row + D2_QM;
  const int sr = tid >> 4, sc = (tid & 15) * 8, vst0 = v_st(sr, sc), vst1 = v_st(32 + sr, sc);
  const int vb0 = (int)(uintptr_t)V_lds + v_rd_base(lane);
  const int kr = tid >> 3, kc = tid & 7, kw = kr * 144 + kc * 16;
  const bf16_t* kp = Kg + (long)kr * ldk + kc * 8;
  bf16x8 sv0, sv1, sk0, sk1;
#define SLOAD2(t) do { sv0 = ld8(&Vg[(long)((t) * 64 + sr) * ldv + sc]); sv1 = ld8(&Vg[(long)((t) * 64 + 32 + sr) * ldv + sc]); \
    sk0 = ld8(kp + (long)(t) * 64 * ldk); sk1 = ld8(kp + (long)(t) * 64 * ldk + 64); } while (0)
#define SWRITE2(b) do { *(bf16x8*)(V_lds + (b) * SHM_V + vst0) = sv0; *(bf16x8*)(V_lds + (b) * SHM_V + vst1) = sv1; \
    *(bf16x8*)(K_lds + (b) * D2_KBUF + kw) = sk0; *(bf16x8*)(K_lds + (b) * D2_KBUF + D2_KT + kw) = sk1; } while (0)
#define RESC2(o, a) do { if (__any((a) < 1.f)) { if (hi == 0) al_l[r32] = (a); asm volatile("s_waitcnt lgkmcnt(0)" ::: "memory"); \
    _Pragma("unroll") for (int d = 0; d < 4; ++d) _Pragma("unroll") for (int r = 0; r < 16; ++r) o[d][r] *= al_l[crow(r, hi)]; } } while (0)
  float m1 = -1e30f, m2 = -1e30f, l1 = 0.f, l2 = 0.f;
#pragma unroll
  for (int d = 0; d < 4; ++d) { o1[d] = f32x16{}; o2[d] = f32x16{}; }
  const int NT = seq / KVBLK;
  SLOAD2(0); asm volatile("s_waitcnt vmcnt(0)" ::: "memory"); SWRITE2(0); __syncthreads();
  if (1 < NT) SLOAD2(1);
  for (int t = 0; t < NT; ++t) {
    const int cur = t & 1;
    f32x16 p0, p1, q0, q1; float mn, al1, al2; bf16x8 a0, a1, a2, a3, b0, b1, b2, b3;
    qkt_l(p0, p1, K_lds + cur * D2_KBUF, Q1row, r32, hi);
    qkt_l(q0, q1, K_lds + cur * D2_KBUF + D2_KT, Q2row, r32, hi);
    partialSM(p0, p1, m1, mn, al1, C, thr_raw); finishSM(p0, p1, al1, l1, a0, a1, a2, a3);
    partialSM(q0, q1, m2, mn, al2, C, thr_raw); finishSM(q0, q1, al2, l2, b0, b1, b2, b3);
    RESC2(o1, al1); RESC2(o2, al2);
    if (t + 1 < NT) { SWRITE2(cur ^ 1); if (t + 2 < NT) SLOAD2(t + 2); }
    const int vb = vb0 + cur * (int)SHM_V;
    pv2_step<0>(o1, o2, vb, a0, b0); pv2_step<1>(o1, o2, vb, a1, b1); pv2_step<2>(o1, o2, vb, a2, b2); pv2_step<3>(o1, o2, vb, a3, b3);
    __syncthreads();
  }
  if (hi == 0) { li1[r32] = l1; li2[r32] = l2; } asm volatile("s_waitcnt lgkmcnt(0)" ::: "memory");
#pragma unroll
  for (int r = 0; r < 16; ++r) { rli1[r] = 1.f / li1[crow(r, hi)]; rli2[r] = 1.f / li2[crow(r, hi)]; }
  __syncthreads();
#undef SLOAD2
#undef SWRITE2
#undef RESC2
}
}

DI f32x4 mm16(const bf16_t* A, int lda, const bf16_t* Bt, int ldb, int K, f32x4 acc, int lane) {
  const bf16_t* ap = A + (lane & 15) * lda + 8 * (lane >> 4);
  const bf16_t* bp = Bt + (lane & 15) * ldb + 8 * (lane >> 4);
  for (int k0 = 0; k0 < K; k0 += 32) {
    const bf16x8 a = *(const bf16x8*)(ap + k0), b = *(const bf16x8*)(bp + k0);
    acc = __builtin_amdgcn_mfma_f32_16x16x32_bf16(a, b, acc, 0, 0, 0);
  }
  return acc;
}
constexpr int LP = 72;

DI int chunk_row0(int tc) { return tc * 64; }
DI int scan_idx(int tc, int dir) { return tc < 256 ? (dir == 0 ? 4 + tc : 4 + (255 - tc)) : (dir == 0 ? tc - 256 : 3 - (tc - 256)); }
DI void stream_bounds(int row0, int& lo, int& hi) { if (row0 < TL) { lo = 0; hi = TL; } else { lo = TL; hi = T; } }

DI void sincos_d(double a, float& c, float& s) {
  const double TWO_PI = 6.283185307179586476925287;
  const double k = rint(a / TWO_PI); const double r = a - k * TWO_PI; const double r2 = r * r;
  double ss = 1.0, cc = 1.0;
#pragma unroll
  for (int n = 13; n >= 1; --n) { ss = 1.0 - r2 / (double)((2 * n) * (2 * n + 1)) * ss; cc = 1.0 - r2 / (double)((2 * n - 1) * (2 * n)) * cc; }
  s = (float)(r * ss); c = (float)cc;
}
DI void phase_setup(const Params& p, unsigned char* lds) {
  const int tid = tidx();
  float* sx = (float*)lds;
  float* red = sx + 2048;
  float* MOD = (float*)(p.ws + WS_MOD);
  for (int i = tid; i < 1024; i += 512) { sx[i] = siluf(p.in[1][i]); sx[1024 + i] = siluf(p.in[3][i]); }
  __syncthreads();
  for (int item = blockIdx.x; item < 384; item += gridDim.x) {
    const int l = item / 192, cb = item % 192, cl = tid & 31, ks = tid >> 5;
    const float* w = p.in[4] + (size_t)l * 1024 * 6144 + cb * 32 + cl;
    float a0 = 0.f, a1 = 0.f;
    for (int k = ks * 64; k < ks * 64 + 64; ++k) { const float wv = w[(size_t)k * 6144]; a0 += sx[k] * wv; a1 += sx[1024 + k] * wv; }
    red[(0 * 16 + ks) * 32 + cl] = a0; red[(1 * 16 + ks) * 32 + cl] = a1;
    __syncthreads();
    if (tid < 64) { const int s = tid >> 5; float sum = 0.f;
      for (int q = 0; q < 16; ++q) sum += red[(s * 16 + q) * 32 + cl];
      MOD[(size_t)(l * 2 + s) * 6144 + cb * 32 + cl] = sum + p.in[5][l * 6144 + cb * 32 + cl]; }
    __syncthreads();
  }
  { float* acc = (float*)(p.ws + WS_ACC); for (int i = blockIdx.x * 512 + tid; i < 2 * TC * D; i += gridDim.x * 512) acc[i] = 0.f; }
  const int gt = blockIdx.x * 512 + tid;
  if (gt < 256 * 16) { const int pos = gt >> 4, i = gt & 15; const double inv = exp2(-(double)i / 16.0 * 13.287712379549449);
    float c, s; sincos_d((double)pos * inv, c, s); float* t = (float*)(p.ws + WS_TAB32) + gt * 2; t[0] = c; t[1] = s; }
  else if (gt < 256 * 16 + 256 * 8) { const int g2 = gt - 256 * 16; const int pos = g2 >> 3, i = g2 & 7; const double inv = exp2(-(double)i / 8.0 * 13.287712379549449);
    float c, s; sincos_d((double)pos * inv, c, s); float* t = (float*)(p.ws + WS_TAB16) + g2 * 2; t[0] = c; t[1] = s; }
  if (blockIdx.x == gridDim.x - 1 && tid < 128) {
    const int l = tid >> 6, lane = tid & 63; const float* lam = p.in[7] + l * 4 * 64;
    const float s1 = wave_sum(lam[lane] * lam[64 + lane]), s2 = wave_sum(lam[128 + lane] * lam[192 + lane]);
    const float lam_init = 0.8f - 0.6f * expf(-0.3f * (float)l);
    if (lane == 0) ((float*)(p.ws + WS_LAM))[l] = expf(s1) - expf(s2) + lam_init;
  }
}

DI void transpose_job(const float* __restrict__ src, int ld, int K, int nvalid, int npad, bf16_t* __restrict__ dst, unsigned char* lds, int wg0 = 0) {
  const int wave = tidx() >> 6, lane = tidx() & 63;
  float* scr = (float*)lds + wave * (64 * 33);
  if ((int)blockIdx.x < wg0) return;
  const int gw = ((int)blockIdx.x - wg0) * 8 + wave, NGW = ((int)gridDim.x - wg0) * 8;
  const int nblk = npad / 32, nitems = (K / 64) * nblk;
  for (int item = gw; item < nitems; item += NGW) {
    const int kb = item / nblk, nb = item % nblk, k0 = 64 * kb, n0 = 32 * nb;
    const int nn = n0 + (lane & 31); const bool ok = nn < nvalid;
    float tv[32];
#pragma unroll
    for (int i = 0; i < 32; ++i) { const int kk = 2 * i + (lane >> 5); tv[i] = ok ? src[(size_t)(k0 + kk) * ld + nn] : 0.f; }
#pragma unroll
    for (int i = 0; i < 32; ++i) { const int kk = 2 * i + (lane >> 5); scr[kk * 33 + (lane & 31)] = tv[i]; }
    LDS_WAIT();
    const int c = lane & 7;
#pragma unroll
    for (int j = 0; j < 4; ++j) { const int n = (lane >> 3) + 8 * j; const float* s = scr + (8 * c) * 33 + n;
      u32x4 o; o.x = cvtpk(s[0 * 33], s[1 * 33]); o.y = cvtpk(s[2 * 33], s[3 * 33]); o.z = cvtpk(s[4 * 33], s[5 * 33]); o.w = cvtpk(s[6 * 33], s[7 * 33]);
      *(u32x4*)(dst + (size_t)(n0 + n) * K + k0 + 8 * c) = o; }
    LDS_WAIT();
  }
}
DI void convert_layer_start(const Params& p, int l, unsigned char* lds) {
  const float* w_in = p.in[6] + (size_t)l * 1024 * 5056;
  bf16_t* wa = (bf16_t*)(p.ws + WS_WA);
  transpose_job(w_in + 1536, 5056, 1024, 1552, NB_B, (bf16_t*)((unsigned char*)wa + WA_B), lds);
}
DI void convert_layer_rest(const Params& p, int l, unsigned char* lds, int wg0) {
  const float* w_in = p.in[6] + (size_t)l * 1024 * 5056;
  bf16_t* wa = (bf16_t*)(p.ws + WS_WA); unsigned char* wb = p.ws + WS_WB;
  transpose_job(w_in + 3760, 5056, 1024, 1296, NB_D, (bf16_t*)((unsigned char*)wa + WA_D), lds, wg0);
  transpose_job(w_in + 0, 5056, 1024, 1536, 1536, (bf16_t*)((unsigned char*)wa + WA_AC), lds, wg0);
  transpose_job(w_in + 3088, 5056, 1024, 672, 768, (bf16_t*)((unsigned char*)wa + WA_AC) + (size_t)1536 * 1024, lds, wg0);
  transpose_job(p.in[15] + (size_t)l * 384 * 384, 384, 384, 384, 512, (bf16_t*)(wb + WB_UQ), lds, wg0);
  transpose_job(p.in[16] + (size_t)l * 256 * 768, 768, 256, 768, 768, (bf16_t*)(wb + WB_UKV), lds, wg0);
  for (int k = 0; k < 4; ++k) transpose_job(p.in[25] + ((size_t)l * 4 + k) * 512 * 1024, 1024, 512, 1024, 1024, (bf16_t*)(wb + WB_BR) + (size_t)k * 1024 * 512, lds, wg0);
  transpose_job(p.in[26] + (size_t)l * 1024 * 1024, 1024, 1024, 1024, 1024, (bf16_t*)(wb + WB_WO), lds, wg0);
}

DI void ln_stats(const f32x4 (&v)[4], float& mean, float& rstd) {
  float s = 0.f;
#pragma unroll
  for (int j = 0; j < 4; ++j) s += (v[j].x + v[j].y) + (v[j].z + v[j].w);
  mean = wave_sum(s) * (1.f / D); float s2 = 0.f;
#pragma unroll
  for (int j = 0; j < 4; ++j) { const f32x4 d = v[j] - mean; s2 += (d.x * d.x + d.y * d.y) + (d.z * d.z + d.w * d.w); }
  rstd = 1.f / sqrtf(wave_sum(s2) * (1.f / D) + EPS);
}
DI void phase_ln_mod(const float* xl, const float* xc, const float* mod_l, const float* mod_c, int sh_off, int sc_off, bf16_t* H, int nrows) {
  const int wave = tidx() >> 6, lane = tidx() & 63, stride = gridDim.x * 8;
  auto load_row = [&](int row, f32x4 (&v)[4]) { const float* xr = row >= TL ? xc + (size_t)(row - TL) * D : xl + (size_t)row * D;
#pragma unroll
    for (int j = 0; j < 4; ++j) v[j] = *(const f32x4*)(xr + 4 * lane + 256 * j); };
  int row = blockIdx.x * 8 + wave; f32x4 v[4];
  if (row < nrows) load_row(row, v);
  while (row < nrows) {
    const int nrow = row + stride; f32x4 vn[4];
    if (nrow < nrows) load_row(nrow, vn);
    const float* mod = row >= TL ? mod_c : mod_l;
    f32x4 shv[4], scv[4];
#pragma unroll
    for (int j = 0; j < 4; ++j) { const int c = 4 * lane + 256 * j; shv[j] = *(const f32x4*)(mod + sh_off + c); scv[j] = *(const f32x4*)(mod + sc_off + c); }
    float mean, rstd; ln_stats(v, mean, rstd);
#pragma unroll
    for (int j = 0; j < 4; ++j) { const int c = 4 * lane + 256 * j;
      const f32x4 y = (v[j] - mean) * rstd * (scv[j] + 1.f) + shv[j]; u32x2 w; w.x = cvtpk(y.x, y.y); w.y = cvtpk(y.z, y.w);
      *(u32x2*)(H + (size_t)row * D + c) = w; }
#pragma unroll
    for (int j = 0; j < 4; ++j) v[j] = vn[j];
    row = nrow;
  }
}
DI void phase_ln_affine_mod(float* xl, float* xc, const float* g, const float* b, const float* mod_l, const float* mod_c, int sh_off, int sc_off, bf16_t* H, int nrows,
                            const float* cx = nullptr, const float* cacc = nullptr, const float* cg = nullptr, const float* cb = nullptr) {
  const int wave = tidx() >> 6, lane = tidx() & 63, stride = gridDim.x * 8;
  auto load_row = [&](int row, f32x4 (&v)[4]) {
    if (row >= TL && cacc) {
#pragma unroll
      for (int j = 0; j < 4; ++j) { const int c = 4 * lane + 256 * j; const size_t o = (size_t)(row - TL) * D + c;
        const f32x4 bb = cb ? *(const f32x4*)(cb + c) : (f32x4){0.f, 0.f, 0.f, 0.f};
        v[j] = *(const f32x4*)(cx + o) * ALPHA + *(const f32x4*)(cg + c) * (*(const f32x4*)(cacc + o) + bb); }
    } else { const float* xr = row >= TL ? xc + (size_t)(row - TL) * D : xl + (size_t)row * D;
#pragma unroll
      for (int j = 0; j < 4; ++j) v[j] = *(const f32x4*)(xr + 4 * lane + 256 * j); } };
  int row = blockIdx.x * 8 + wave; f32x4 v[4];
  if (row < nrows) load_row(row, v);
  while (row < nrows) {
    const int nrow = row + stride; f32x4 vn[4];
    if (nrow < nrows) load_row(nrow, vn);
    const bool isc = row >= TL; float* xr = isc ? xc + (size_t)(row - TL) * D : xl + (size_t)row * D; const float* mod = isc ? mod_c : mod_l;
    f32x4 gvv[4], bvv[4], shv[4], scv[4];
#pragma unroll
    for (int j = 0; j < 4; ++j) { const int c = 4 * lane + 256 * j; gvv[j] = *(const f32x4*)(g + c); bvv[j] = *(const f32x4*)(b + c);
      if (H) { shv[j] = *(const f32x4*)(mod + sh_off + c); scv[j] = *(const f32x4*)(mod + sc_off + c); } }
    float mean, rstd; ln_stats(v, mean, rstd);
#pragma unroll
    for (int j = 0; j < 4; ++j) { const int c = 4 * lane + 256 * j; v[j] = (v[j] - mean) * rstd * gvv[j] + bvv[j]; *(f32x4*)(xr + c) = v[j]; }
    if (H) {
      ln_stats(v, mean, rstd);
#pragma unroll
      for (int j = 0; j < 4; ++j) { const int c = 4 * lane + 256 * j;
        const f32x4 y = (v[j] - mean) * rstd * (scv[j] + 1.f) + shv[j]; u32x2 w; w.x = cvtpk(y.x, y.y); w.y = cvtpk(y.z, y.w);
        *(u32x2*)(H + (size_t)row * D + c) = w; }
    }
#pragma unroll
    for (int j = 0; j < 4; ++j) v[j] = vn[j];
    row = nrow;
  }
}

DI void phase_attn_prep(const Params& p, int l) {
  const int wave = tidx() >> 6, lane = tidx() & 63;
  bf16_t* PAC = (bf16_t*)(p.ws + WS_BIG + BG_PAC);
  const float* tab32 = (const float*)(p.ws + WS_TAB32); const float* tab16 = (const float*)(p.ws + WS_TAB16);
  const float* qn = p.in[13] + l * 384; const float* kvn = p.in[14] + l * 256;
  for (int row = blockIdx.x * 8 + wave; row < T; row += gridDim.x * 8) {
    bf16_t* pr = PAC + (size_t)row * NB_AC;
    if (row < TL) {
      const int prow = row >> 6, pcol = row & 63;
#pragma unroll
      for (int it = 0; it < 8; ++it) { const int pi = it * 64 + lane;
        const int unit = pi >> 5, q = pi & 31, sec = q >> 4, i = q & 15;
        const int e0 = unit * 64 + sec * 32 + i; const int pos = sec ? pcol : prow;
        const float cs = tab32[(pos * 16 + i) * 2], sn = tab32[(pos * 16 + i) * 2 + 1];
        const float x1 = bf2f(pr[e0]), x2 = bf2f(pr[e0 + 16]);
        pr[e0] = f2bf(x1 * cs - x2 * sn); pr[e0 + 16] = f2bf(x2 * cs + x1 * sn); }
      if (lane < 16) { const int sec = lane >> 3, i = lane & 7; const int e0 = 2176 + sec * 16 + i; const int pos = sec ? pcol : prow;
        const float cs = tab16[(pos * 8 + i) * 2], sn = tab16[(pos * 8 + i) * 2 + 1];
        const float x1 = bf2f(pr[e0]), x2 = bf2f(pr[e0 + 8]);
        pr[e0] = f2bf(x1 * cs - x2 * sn); pr[e0 + 8] = f2bf(x2 * cs + x1 * sn); }
    }
    { float v[6]; float ss = 0.f;
#pragma unroll
      for (int j = 0; j < 6; ++j) { v[j] = bf2f(pr[1536 + lane + 64 * j]); ss += v[j] * v[j]; }
      const float rs = 1.f / sqrtf(wave_sum(ss) * (1.f / 384.f) + EPS);
#pragma unroll
      for (int j = 0; j < 6; ++j) pr[1536 + lane + 64 * j] = f2bf(v[j] * rs * qn[lane + 64 * j]); }
    { float v[4]; float ss = 0.f;
#pragma unroll
      for (int j = 0; j < 4; ++j) { v[j] = bf2f(pr[1920 + lane + 64 * j]); ss += v[j] * v[j]; }
      const float rs = 1.f / sqrtf(wave_sum(ss) * (1.f / 256.f) + EPS);
#pragma unroll
      for (int j = 0; j < 4; ++j) pr[1920 + lane + 64 * j] = f2bf(v[j] * rs * kvn[lane + 64 * j]); }
  }
}
DI void phase_qup_rope(const Params& p) {
  const int wave = tidx() >> 6, lane = tidx() & 63;
  bf16_t* QUP = (bf16_t*)(p.ws + WS_BIG + BG_QUP); const float* tab16 = (const float*)(p.ws + WS_TAB16);
  for (int row = blockIdx.x * 8 + wave; row < TL; row += gridDim.x * 8) {
    const int prow = row >> 6, pcol = row & 63; bf16_t* pr = QUP + (size_t)row * 384;
    const int h = lane >> 4, q = lane & 15, sec = q >> 3, i = q & 7; const int e0 = h * 96 + 64 + sec * 16 + i; const int pos = sec ? pcol : prow;
    const float cs = tab16[(pos * 8 + i) * 2], sn = tab16[(pos * 8 + i) * 2 + 1];
    const float x1 = bf2f(pr[e0]), x2 = bf2f(pr[e0 + 8]);
    pr[e0] = f2bf(x1 * cs - x2 * sn); pr[e0 + 8] = f2bf(x2 * cs + x1 * sn);
  }
}

DI void attn_item_diff(const Params& p, int l, int q0, int h, int key0, int nkeys, char* lds) {
  const bf16_t* PAC = (const bf16_t*)(p.ws + WS_BIG + BG_PAC);
  bf16_t* OUT = (bf16_t*)(p.ws + WS_BR);
  const int tid = tidx(), wid = tid >> 6, lane = tid & 63, r32 = lane & 31, hi = lane >> 5;
  const float lam = ((const float*)(p.ws + WS_LAM))[l]; const float lam_init = 0.8f - 0.6f * expf(-0.3f * (float)l);
  f32x16 o1[4], o2[4]; float rli1[16], rli2[16];
  att::attn_diff2(PAC + (size_t)q0 * NB_AC + h * 128, NB_AC, PAC + (size_t)key0 * NB_AC + 512 + h * 128, NB_AC, PAC + (size_t)key0 * NB_AC + 1024 + h * 128, NB_AC,
                  nkeys, 0.125f, lds, o1, o2, rli1, rli2);
  const float* sw = p.in[8] + l * 128; const float og = 1.f - lam_init;
  float swv[4];
#pragma unroll
  for (int d0 = 0; d0 < 4; ++d0) swv[d0] = sw[d0 * 32 + r32] * og;
#pragma unroll
  for (int r = 0; r < 16; ++r) { float ss = 0.f; const float c1 = rli1[r], c2 = lam * rli2[r];
#pragma unroll
    for (int d0 = 0; d0 < 4; ++d0) { const float v = o1[d0][r] * c1 - o2[d0][r] * c2; o1[d0][r] = v; ss += v * v; }
#pragma unroll
    for (int off = 1; off < 32; off <<= 1) ss += __shfl_xor(ss, off);
    const float rs = 1.f / sqrtf(ss * (1.f / 128.f) + EPS);
    bf16_t* orow = OUT + (size_t)(q0 + wid * 32 + att::crow(r, hi)) * 512 + h * 128 + r32;
#pragma unroll
    for (int d0 = 0; d0 < 4; ++d0) orow[d0 * 32] = f2bf(o1[d0][r] * rs * swv[d0]); }
}
DI void attn_item_mla(const Params& p, int q0, int h, int key0, int nkeys, char* lds) {
  const bf16_t* PAC = (const bf16_t*)(p.ws + WS_BIG + BG_PAC);
  const bf16_t* QUP = (const bf16_t*)(p.ws + WS_BIG + BG_QUP); const bf16_t* KVUP = (const bf16_t*)(p.ws + WS_BIG + BG_KVUP);
  bf16_t* OUT = (bf16_t*)(p.ws + WS_BR) + (size_t)2 * T * 512;
  const int tid = tidx(), wid = tid >> 6, lane = tid & 63, r32 = lane & 31, hi = lane >> 5;
  f32x16 o[4]; float rli[16];
  if (q0 < TL) {
    bf16_t* QW = (bf16_t*)(p.ws + WS_BIG + BG_QUP); const float* tab16 = (const float*)(p.ws + WS_TAB16);
    bf16_t qa[8], qb[8];
#pragma unroll
    for (int k = 0; k < 8; ++k) { const int u = tid + 512 * k, row = q0 + (u >> 4), q = u & 15, sec = q >> 3, i = q & 7;
      const bf16_t* pr = QW + (size_t)row * 384 + h * 96 + 64 + sec * 16 + i; qa[k] = pr[0]; qb[k] = pr[8]; }
#pragma unroll
    for (int k = 0; k < 8; ++k) { const int u = tid + 512 * k, row = q0 + (u >> 4), q = u & 15, sec = q >> 3, i = q & 7;
      const int prow = row >> 6, pcol = row & 63, pos = sec ? pcol : prow; bf16_t* pr = QW + (size_t)row * 384 + h * 96 + 64 + sec * 16 + i;
      const float cs = tab16[(pos * 8 + i) * 2], sn = tab16[(pos * 8 + i) * 2 + 1];
      const float x1 = bf2f(qa[k]), x2 = bf2f(qb[k]);
      pr[0] = f2bf(x1 * cs - x2 * sn); pr[8] = f2bf(x2 * cs + x1 * sn); }
    __syncthreads();
  }
  att::attn_body<96>(QUP + (size_t)q0 * 384 + h * 96, 384, KVUP + (size_t)key0 * 768 + h * 192, 768, PAC + (size_t)key0 * NB_AC + 2176, NB_AC,
                     KVUP + (size_t)key0 * 768 + h * 192 + 64, 768, nkeys, 0.10206207261596575f, lds, o, rli);
#pragma unroll
  for (int r = 0; r < 16; ++r) { bf16_t* orow = OUT + (size_t)(q0 + wid * 32 + att::crow(r, hi)) * 512 + h * 128 + r32;
#pragma unroll
    for (int d0 = 0; d0 < 4; ++d0) orow[d0 * 32] = f2bf(o[d0][r] * rli[r]); }
}
DI void phase_attention(const Params& p, int l, char* lds) {
  const int c = blockIdx.x, G = gridDim.x;
  for (int it = c; it < 256; it += G) attn_item_diff(p, l, (it >> 2) * 256, it & 3, 0, T, lds);
  for (int it = c; it < 256; it += G) attn_item_mla(p, (it >> 2) * 256, it & 3, 0, T, lds);
  if (l == 0) {
    for (int it = c; it < 8; it += G) { if (it < 4) attn_item_diff(p, l, TL, it, TL, TC, lds); else attn_item_mla(p, TL, it - 4, TL, TC, lds); }
  }
}

DI float log_sigmoid(float x) { return fminf(x, 0.f) - log1pf(__expf(-fabsf(x))); }
DI float wave_scan_sum(float v, int lane, int dir) {
#pragma unroll
  for (int o = 1; o < 64; o <<= 1) { const float t = dir ? __shfl_down(v, o) : __shfl_up(v, o); const bool ok = dir ? (lane + o < 64) : (lane >= o); v += ok ? t : 0.f; }
  return v;
}
DI float wave_scan_max(float v, int lane, int dir) {
#pragma unroll
  for (int o = 1; o < 64; o <<= 1) { const float t = dir ? __shfl_down(v, o) : __shfl_up(v, o); const bool ok = dir ? (lane + o < 64) : (lane >= o); v = ok ? fmaxf(v, t) : v; }
  return v;
}
template <int NR, class F>
DI void conv_tile(const bf16_t* P, int ldp, int row0, int lo, int hi, const float* cw, int cw_ld, const float* cb, int gcol, int r0, int  , F&& out) {
  float w[5];
#pragma unroll
  for (int t = 0; t < 5; ++t) w[t] = cw[t * cw_ld];
  const float b = cb[0];
  float x[NR + 4];
#pragma unroll
  for (int i = 0; i < NR + 4; ++i) { const int row = row0 + r0 - 2 + i; const int rc = row < lo ? lo : (row >= hi ? hi - 1 : row);
    const float v = bf2f(P[(size_t)rc * ldp + gcol]); x[i] = (row >= lo && row < hi) ? v : 0.f; }
#pragma unroll
  for (int i = 0; i < NR; ++i) { const float y = b + w[0] * x[i] + w[1] * x[i + 1] + w[2] * x[i + 2] + w[3] * x[i + 3] + w[4] * x[i + 4]; out(r0 + i, siluf(y)); }
}
DI void phase_ml_s1(const Params& p, int l, unsigned char* lds) {
  const int tid = tidx(), wave = tid >> 6, lane = tid & 63;
  const bf16_t* PB = (const bf16_t*)(p.ws + WS_BIG + BG_PB);
  bf16_t* UC = (bf16_t*)(p.ws + WS_BIG + BG_UC); float* MSC = (float*)(p.ws + WS_BIG + BG_MSC);
  bf16_t* Vt = (bf16_t*)lds;
  bf16_t* Kt = Vt + 128 * LP;
  bf16_t* Kts = Kt + 64 * LP;
  float* wsv = (float*)(Kts + 64 * LP);
  const float* cw = p.in[9] + (size_t)l * 5 * 512; const float* cb = p.in[10] + l * 512; const float* gb = p.in[11] + l * 16;
  for (int item = blockIdx.x; item < 4 * NCH; item += gridDim.x) {
    const int h = item & 3, tc = item >> 2, row0 = chunk_row0(tc); int lo, hi; stream_bounds(row0, lo, hi);
    __syncthreads();
    {
      const int d = tid & 63, r0 = (tid >> 6) * 8; const int gc = 256 + h * 64 + d;
      conv_tile<8>(PB, NB_B, row0, lo, hi, cw + gc, 512, cb + gc, gc, r0, 8, [&](int r, float v) { Kt[d * LP + r] = f2bf(v * 0.125f); }); }
    {
      const int j = tid >> 3, e0 = (tid & 7) * 16; const bf16_t* src = PB + (size_t)(row0 + j) * NB_B + 512 + h * 128 + e0;
      const bf16x8 a = *(const bf16x8*)src, b = *(const bf16x8*)(src + 8);
#pragma unroll
      for (int i = 0; i < 8; ++i) { Vt[(e0 + i) * LP + j] = (bf16_t)a[i]; Vt[(e0 + 8 + i) * LP + j] = (bf16_t)b[i]; } }
    if (wave < 2) { const int dir = wave; const bf16_t* gr = PB + (size_t)(row0 + lane) * NB_B + 1536;
      const float ig = bf2f(gr[(2 * dir) * 4 + h]) + gb[(2 * dir) * 4 + h];
      const float lf = log_sigmoid(bf2f(gr[(2 * dir + 1) * 4 + h]) + gb[(2 * dir + 1) * 4 + h]);
      const float g = wave_scan_sum(lf, lane, dir); const float g_end = wave_sum(lf);
      const float ls = g_end - g + ig; const float m_loc = wave_max(ls);
      wsv[dir * 64 + lane] = __expf(ls - m_loc);
      if (lane == 0) { const int ch = h * 2 + dir, s = scan_idx(tc, dir); MSC[(0 * 8 + ch) * NCH + s] = g_end; MSC[(1 * 8 + ch) * NCH + s] = m_loc; } }
    __syncthreads();
    for (int dir = 0; dir < 2; ++dir) {
      const int ch = h * 2 + dir, s = scan_idx(tc, dir); bf16_t* urow = UC + ((size_t)ch * NCH + s) * MLROW;
      { const int d = tid >> 3, j0 = (tid & 7) * 8; float sum = 0.f;
#pragma unroll
        for (int i = 0; i < 8; ++i) { const bf16_t v = f2bf(bf2f(Kt[d * LP + j0 + i]) * wsv[dir * 64 + j0 + i]); Kts[d * LP + j0 + i] = v; sum += bf2f(v); }
        sum += __shfl_xor(sum, 1); sum += __shfl_xor(sum, 2); sum += __shfl_xor(sum, 4);
        if ((tid & 7) == 0) urow[8192 + d] = f2bf(sum); }
      __syncthreads();
#pragma unroll
      for (int dt = 0; dt < 4; ++dt) { f32x4 acc = {0.f, 0.f, 0.f, 0.f};
        acc = mm16(Vt + wave * 16 * LP, LP, Kts + dt * 16 * LP, LP, 64, acc, lane);
#pragma unroll
        for (int r = 0; r < 4; ++r) urow[(wave * 16 + (lane >> 4) * 4 + r) * 64 + dt * 16 + (lane & 15)] = f2bf(acc[r]); }
      __syncthreads();
    }
  }
}
DI void phase_ml_s2(const Params& p) {
  const bf16_t* __restrict__ UC = (const bf16_t*)(p.ws + WS_BIG + BG_UC); bf16_t* __restrict__ SC = (bf16_t*)(p.ws + WS_BIG + BG_SC);
  float* MSC = (float*)(p.ws + WS_BIG + BG_MSC);
  const int npairs = 8 * (MLROW / 2);
  for (int e = blockIdx.x * 512 + tidx(); e < npairs; e += gridDim.x * 512) {
    const int ch = e / (MLROW / 2), off = (e % (MLROW / 2)) * 2;
    const float* GE = MSC + (0 * 8 + ch) * NCH; const float* ML = MSC + (1 * 8 + ch) * NCH; float* MS = MSC + (2 * 8 + ch) * NCH;
    float m = 0.f, c0 = 0.f, c1 = 0.f;
    for (int s0 = 0; s0 < NCH; s0 += 26) {
      unsigned u[26];
#pragma unroll
      for (int q = 0; q < 26; ++q) u[q] = *(const unsigned*)(UC + ((size_t)ch * NCH + s0 + q) * MLROW + off);
      float gev[26], mlv[26];
#pragma unroll
      for (int q = 0; q < 26; ++q) { gev[q] = GE[s0 + q]; mlv[q] = ML[s0 + q]; }
#pragma unroll
      for (int q = 0; q < 26; ++q) { const int s = s0 + q;
        *(unsigned*)(SC + ((size_t)ch * NCH + s) * MLROW + off) = cvtpk(c0, c1);
        if (off == 0) MS[s] = m;
        const float ge = gev[q], ml = mlv[q]; const float mn = fmaxf(ge + m, ml); const float dec = __expf(ge + m - mn), sc = __expf(ml - mn);
        c0 = dec * c0 + sc * bflo(u[q]); c1 = dec * c1 + sc * bfhi(u[q]); m = mn; }
    }
  }
}
DI void phase_ml_s3(const Params& p, int l, unsigned char* lds, int ntc) {
  const int tid = tidx(), wave = tid >> 6, lane = tid & 63;
  const bf16_t* PB = (const bf16_t*)(p.ws + WS_BIG + BG_PB);
  const bf16_t* SC = (const bf16_t*)(p.ws + WS_BIG + BG_SC); const float* MSC = (const float*)(p.ws + WS_BIG + BG_MSC);
  bf16_t* OUT = (bf16_t*)(p.ws + WS_BR) + (size_t)1 * T * 512;
  bf16_t* Q = (bf16_t*)lds;
  bf16_t* Kk = Q + 64 * LP;
  bf16_t* W = Kk + 64 * LP;
  bf16_t* Vt = W + 64 * LP;
  bf16_t* Ct = Vt + 128 * LP;
  float* fa = (float*)(Ct + 128 * LP);
  float* gS = fa;
  float* bS = fa + 128;
  float* mjS = fa + 256;
  float* aiS = fa + 384;
  float* rdS = fa + 448;
  float* nS = fa + 512;
  float* ssS = fa + 576;
  const float* cw = p.in[9] + (size_t)l * 5 * 512; const float* cb = p.in[10] + l * 512; const float* gb = p.in[11] + l * 16;
  const float* nw = p.in[12] + l * 512;
  const int js = wave >> 1, eh = wave & 1;
  for (int item = blockIdx.x; item < 4 * ntc; item += gridDim.x) {
    const int h = item & 3, tc = item >> 2, row0 = chunk_row0(tc); int lo, hi; stream_bounds(row0, lo, hi);
    __syncthreads();
    { const int c = tid & 127, r0 = (tid >> 7) * 16; const int gc = (c < 64) ? h * 64 + c : 256 + h * 64 + (c - 64);
      bf16_t* dst = (c < 64) ? Q + c : Kk + (c - 64); const float scl = (c < 64) ? 1.f : 0.125f;
      conv_tile<16>(PB, NB_B, row0, lo, hi, cw + gc, 512, cb + gc, gc, r0, 16, [&](int r, float v) { dst[r * LP] = f2bf(v * scl); }); }
    { const int j = tid >> 3, e0 = (tid & 7) * 16; const bf16_t* src = PB + (size_t)(row0 + j) * NB_B + 512 + h * 128 + e0;
      const bf16x8 a = *(const bf16x8*)src, b = *(const bf16x8*)(src + 8);
#pragma unroll
      for (int i = 0; i < 8; ++i) { Vt[(e0 + i) * LP + j] = (bf16_t)a[i]; Vt[(e0 + 8 + i) * LP + j] = (bf16_t)b[i]; } }
    float mdir[2];
#pragma unroll
    for (int dir = 0; dir < 2; ++dir) mdir[dir] = MSC[(2 * 8 + h * 2 + dir) * NCH + scan_idx(tc, dir)];
    if (wave < 2) { const int dir = wave; const bf16_t* gr = PB + (size_t)(row0 + lane) * NB_B + 1536;
      const float ig = bf2f(gr[(2 * dir) * 4 + h]) + gb[(2 * dir) * 4 + h];
      const float lf = log_sigmoid(bf2f(gr[(2 * dir + 1) * 4 + h]) + gb[(2 * dir + 1) * 4 + h]);
      const float g = wave_scan_sum(lf, lane, dir); const float b = ig - g; const float bm = wave_scan_max(b, lane, dir);
      gS[dir * 64 + lane] = g; bS[dir * 64 + lane] = b; mjS[dir * 64 + lane] = g + fmaxf(dir ? mdir[1] : mdir[0], bm); }
    f32x4 hs[4];
#pragma unroll
    for (int t = 0; t < 4; ++t) hs[t] = (f32x4){0.f, 0.f, 0.f, 0.f};
#pragma unroll
    for (int dir = 0; dir < 2; ++dir) {
      const int ch = h * 2 + dir, s = scan_idx(tc, dir); const bf16_t* srow = SC + ((size_t)ch * NCH + s) * MLROW; const float m = mdir[dir];
      __syncthreads();
      for (int i = tid; i < 1024; i += 512) { const int e = i >> 3, d0 = (i & 7) * 8; *(bf16x8*)(Ct + e * LP + d0) = *(const bf16x8*)(srow + e * 64 + d0); }
      if (tid < 64) { nS[tid] = bf2f(srow[8192 + tid]); aiS[tid] = __expf(gS[dir * 64 + tid] + m - mjS[dir * 64 + tid]); }
#pragma unroll
      for (int tt = 0; tt < 2; ++tt) { const int it = eh * 2 + tt; f32x4 acc = {0.f, 0.f, 0.f, 0.f};
        acc = mm16(Q + js * 16 * LP, LP, Kk + it * 16 * LP, LP, 64, acc, lane);
        const int i = it * 16 + (lane & 15); const float bi = bS[dir * 64 + i];
#pragma unroll
        for (int r = 0; r < 4; ++r) { const int j = js * 16 + (lane >> 4) * 4 + r; const bool ok = dir ? (i >= j) : (i <= j);
          const float wv = ok ? __expf(gS[dir * 64 + j] + bi - mjS[dir * 64 + j]) * acc[r] : 0.f; W[j * LP + i] = f2bf(wv); } }
      __syncthreads();
      { const int j = tid >> 3, i0 = (tid & 7) * 8; float sw = 0.f, sq = 0.f;
#pragma unroll
        for (int i = 0; i < 8; ++i) { sw += bf2f(W[j * LP + i0 + i]); sq += bf2f(Q[j * LP + i0 + i]) * nS[i0 + i]; }
        sw += __shfl_xor(sw, 1); sw += __shfl_xor(sw, 2); sw += __shfl_xor(sw, 4); sq += __shfl_xor(sq, 1); sq += __shfl_xor(sq, 2); sq += __shfl_xor(sq, 4);
        if ((tid & 7) == 0) { const float den = sw + aiS[j] * sq; rdS[j] = 1.f / fmaxf(fabsf(den), __expf(-mjS[dir * 64 + j])); } }
      __syncthreads();
#pragma unroll
      for (int t = 0; t < 4; ++t) { const int et = eh * 4 + t; f32x4 a1 = {0.f, 0.f, 0.f, 0.f}, a2 = {0.f, 0.f, 0.f, 0.f};
        a1 = mm16(W + js * 16 * LP, LP, Vt + et * 16 * LP, LP, 64, a1, lane);
        a2 = mm16(Q + js * 16 * LP, LP, Ct + et * 16 * LP, LP, 64, a2, lane);
#pragma unroll
        for (int r = 0; r < 4; ++r) { const int j = js * 16 + (lane >> 4) * 4 + r; hs[t][r] += (a1[r] + aiS[j] * a2[r]) * rdS[j]; } }
    }
    { float ssq[4] = {0.f, 0.f, 0.f, 0.f};
#pragma unroll
      for (int t = 0; t < 4; ++t)
#pragma unroll
        for (int r = 0; r < 4; ++r) ssq[r] += hs[t][r] * hs[t][r];
#pragma unroll
      for (int r = 0; r < 4; ++r) { float s = ssq[r]; s += __shfl_xor(s, 1); s += __shfl_xor(s, 2); s += __shfl_xor(s, 4); s += __shfl_xor(s, 8);
        if ((lane & 15) == 0) ssS[(js * 16 + (lane >> 4) * 4 + r) * 2 + eh] = s; }
      __syncthreads();
      float nwv[4];
#pragma unroll
      for (int t = 0; t < 4; ++t) nwv[t] = nw[h * 128 + (eh * 4 + t) * 16 + (lane & 15)];
      bf16_t ogr[4][4];
#pragma unroll
      for (int r = 0; r < 4; ++r)
#pragma unroll
        for (int t = 0; t < 4; ++t) ogr[r][t] = PB[(size_t)(row0 + js * 16 + (lane >> 4) * 4 + r) * NB_B + 1024 + h * 128 + (eh * 4 + t) * 16 + (lane & 15)];
#pragma unroll
      for (int r = 0; r < 4; ++r) { const int j = js * 16 + (lane >> 4) * 4 + r; const float rs = 1.f / sqrtf((ssS[j * 2] + ssS[j * 2 + 1]) * (1.f / 128.f) + EPS);
        const size_t row = (size_t)(row0 + j);
#pragma unroll
        for (int t = 0; t < 4; ++t) { const int e = (eh * 4 + t) * 16 + (lane & 15); const float og = sigmoidf(bf2f(ogr[r][t]));
          OUT[row * 512 + h * 128 + e] = f2bf(hs[t][r] * rs * nwv[t] * og); } }
    }
  }
}

DI float softplusf(float x) { return fmaxf(x, 0.f) + log1pf(__expf(-fabsf(x))); }
struct SsdLds { bf16_t* Xt; bf16_t* Cm; bf16_t* Bm; bf16_t* Bmt; bf16_t* Sc; bf16_t* Hs; float* CB; float* sS; float* dtS; float* seS; float* ssS; };
DI SsdLds ssd_lds(unsigned char* lds) {
  SsdLds L; L.Xt = (bf16_t*)lds;
  L.Cm = L.Xt + 4 * 64 * LP;
  L.Bm = L.Cm + 64 * LP;
  L.Bmt = L.Bm + 64 * LP;
  L.Sc = L.Bmt + 64 * LP;
  L.Hs = L.Sc + 64 * LP;
  L.CB = (float*)(L.Hs + 64 * LP);
  L.sS = L.CB + 64 * 65;
  L.dtS = L.sS + 512;
  L.seS = L.dtS + 512;
  L.ssS = L.seS + 8;
  return L;
}
DI void ssd_load(const Params& p, int l, int g, int tc, const SsdLds& L) {
  const int tid = tidx(), wave = tid >> 6, lane = tid & 63;
  const bf16_t* PD = (const bf16_t*)(p.ws + WS_BIG + BG_PD);
  const float* cw = p.in[17] + (size_t)l * 5 * 768; const float* cb = p.in[18] + l * 768;
  const int row0 = chunk_row0(tc); int lo, hi; stream_bounds(row0, lo, hi);
  float xr[3][20], wr[3][5], br[3]; int cc[3], rr0[3];
#pragma unroll
  for (int k = 0; k < 3; ++k) { const int u = tid + 512 * k, c = u % 384, r0 = (u / 384) * 16; cc[k] = c; rr0[k] = r0;
    const int gc = c < 256 ? g * 256 + c : (c < 320 ? 512 + g * 64 + (c - 256) : 640 + g * 64 + (c - 320));
#pragma unroll
    for (int t = 0; t < 5; ++t) wr[k][t] = cw[t * 768 + gc];
    br[k] = cb[gc];
#pragma unroll
    for (int i = 0; i < 20; ++i) { const int row = row0 + r0 - 2 + i; const int rc = row < lo ? lo : (row >= hi ? hi - 1 : row);
      const float v = bf2f(PD[(size_t)rc * NB_D + 512 + gc]); xr[k][i] = (row >= lo && row < hi) ? v : 0.f; } }
#pragma unroll
  for (int k = 0; k < 3; ++k) { const int c = cc[k], r0 = rr0[k];
#pragma unroll
    for (int i = 0; i < 16; ++i) { const float y = br[k] + wr[k][0] * xr[k][i] + wr[k][1] * xr[k][i + 1] + wr[k][2] * xr[k][i + 2] + wr[k][3] * xr[k][i + 3] + wr[k][4] * xr[k][i + 4];
      const bf16_t vb = f2bf(siluf(y)); const int r = r0 + i;
      if (c < 256) L.Xt[c * LP + r] = vb;
      else if (c < 320) { L.Bm[r * LP + (c - 256)] = vb; L.Bmt[(c - 256) * LP + r] = vb; }
      else L.Cm[r * LP + (c - 320)] = vb; } }
  { const int hh = wave >> 1, dir = wave & 1, h = g * 4 + hh;
    const float dtb = p.in[19][l * 16 + dir * 8 + h], am = -__expf(p.in[20][l * 16 + dir * 8 + h]);
    const float dt = softplusf(bf2f(PD[(size_t)(row0 + lane) * NB_D + 1280 + dir * 8 + h]) + dtb); const float a = dt * am;
    const float s = wave_scan_sum(a, lane, dir); const float se = wave_sum(a);
    L.sS[wave * 64 + lane] = s; L.dtS[wave * 64 + lane] = dt; if (lane == 0) L.seS[wave] = se; }
}
DI bf16x8 pack8(const float (&v)[8]) { u32x4 w; w.x = cvtpk(v[0], v[1]); w.y = cvtpk(v[2], v[3]); w.z = cvtpk(v[4], v[5]); w.w = cvtpk(v[6], v[7]); return __builtin_bit_cast(bf16x8, w); }
DI void unpack8(const bf16x8 b, float (&v)[8]) { const u32x4 w = __builtin_bit_cast(u32x4, b); v[0] = bflo(w.x); v[1] = bfhi(w.x); v[2] = bflo(w.y); v[3] = bfhi(w.y); v[4] = bflo(w.z); v[5] = bfhi(w.z); v[6] = bflo(w.w); v[7] = bfhi(w.w); }
DI void phase_ssd_s1(const Params& p, int l, unsigned char* lds) {
  const int tid = tidx(), wave = tid >> 6, lane = tid & 63, l15 = lane & 15, lq = lane >> 4;
  const SsdLds L = ssd_lds(lds);
  bf16_t* UH = (bf16_t*)(p.ws + WS_BIG + BG_UH); float* DE = (float*)(p.ws + WS_BIG + BG_DE);
  for (int item = blockIdx.x; item < 2 * NCH; item += gridDim.x) {
    const int g = item & 1, tc = item >> 1;
    __syncthreads();
    ssd_load(p, l, g, tc, L);
    __syncthreads();
    const int hd = wave, hh = hd >> 1, dir = hd & 1, h = g * 4 + hh, ch = h * 2 + dir, s = scan_idx(tc, dir);
    const float se = L.seS[hd];
    if (lane == 0) DE[ch * NCH + s] = __expf(se);
    float cf[2][8];
#pragma unroll
    for (int ks = 0; ks < 2; ++ks)
#pragma unroll
      for (int e = 0; e < 8; ++e) { const int i = ks * 32 + 8 * lq + e; cf[ks][e] = __expf(se - L.sS[hd * 64 + i]) * L.dtS[hd * 64 + i]; }
    bf16x8 bfr[4][2];
#pragma unroll
    for (int nt = 0; nt < 4; ++nt)
#pragma unroll
      for (int ks = 0; ks < 2; ++ks) { float v[8]; unpack8(*(const bf16x8*)(L.Bmt + (nt * 16 + l15) * LP + ks * 32 + 8 * lq), v);
#pragma unroll
        for (int e = 0; e < 8; ++e) v[e] *= cf[ks][e];
        bfr[nt][ks] = pack8(v); }
    bf16_t* urow = UH + ((size_t)ch * NCH + s) * 4096;
#pragma unroll
    for (int pt = 0; pt < 4; ++pt) { const bf16_t* ap = L.Xt + (hh * 64 + pt * 16 + l15) * LP + 8 * lq;
      const bf16x8 a0 = *(const bf16x8*)ap, a1 = *(const bf16x8*)(ap + 32);
#pragma unroll
      for (int nt = 0; nt < 4; ++nt) { f32x4 acc = {0.f, 0.f, 0.f, 0.f};
        acc = __builtin_amdgcn_mfma_f32_16x16x32_bf16(a0, bfr[nt][0], acc, 0, 0, 0);
        acc = __builtin_amdgcn_mfma_f32_16x16x32_bf16(a1, bfr[nt][1], acc, 0, 0, 0);
#pragma unroll
        for (int r = 0; r < 4; ++r) urow[(pt * 16 + lq * 4 + r) * 64 + nt * 16 + l15] = f2bf(acc[r]); } }
  }
}
DI void phase_ssd_s2(const Params& p) {
  const bf16_t* __restrict__ UH = (const bf16_t*)(p.ws + WS_BIG + BG_UH); bf16_t* __restrict__ SH = (bf16_t*)(p.ws + WS_BIG + BG_SH);
  const float* DE = (const float*)(p.ws + WS_BIG + BG_DE);
  const int npairs = 16 * 2048;
  for (int e = blockIdx.x * 512 + tidx(); e < npairs; e += gridDim.x * 512) {
    const int ch = e >> 11, off = (e & 2047) * 2; float c0 = 0.f, c1 = 0.f;
    for (int s0 = 0; s0 < NCH; s0 += 26) {
      unsigned u[26];
#pragma unroll
      for (int q = 0; q < 26; ++q) u[q] = *(const unsigned*)(UH + ((size_t)ch * NCH + s0 + q) * 4096 + off);
      float dev[26];
#pragma unroll
      for (int q = 0; q < 26; ++q) dev[q] = DE[ch * NCH + s0 + q];
#pragma unroll
      for (int q = 0; q < 26; ++q) { const int s = s0 + q;
        *(unsigned*)(SH + ((size_t)ch * NCH + s) * 4096 + off) = cvtpk(c0, c1);
        const float dec = dev[q]; c0 = dec * c0 + bflo(u[q]); c1 = dec * c1 + bfhi(u[q]); }
    }
  }
}
DI void phase_ssd_s3(const Params& p, int l, unsigned char* lds, int ntc) {
  const int tid = tidx(), wave = tid >> 6, lane = tid & 63, l15 = lane & 15, lq = lane >> 4;
  const SsdLds L = ssd_lds(lds);
  const bf16_t* PD = (const bf16_t*)(p.ws + WS_BIG + BG_PD);
  const bf16_t* SH = (const bf16_t*)(p.ws + WS_BIG + BG_SH);
  bf16_t* OUT = (bf16_t*)(p.ws + WS_BR) + (size_t)3 * T * 512;
  const float* dsk = p.in[21] + l * 8; const float* nw = p.in[22] + l * 512;
  float* ssq4 = L.CB + 64 * 65;
  ssq4 = L.ssS + 128;
  const int hh = wave >> 1, jh = wave & 1;
  for (int item = blockIdx.x; item < 2 * ntc; item += gridDim.x) {
    const int g = item & 1, tc = item >> 1, row0 = chunk_row0(tc), h = g * 4 + hh;
    __syncthreads();
    ssd_load(p, l, g, tc, L);
    __syncthreads();
#pragma unroll
    for (int tt = 0; tt < 2; ++tt) { const int t = wave * 2 + tt, jt = t >> 2, it = t & 3; f32x4 acc = {0.f, 0.f, 0.f, 0.f};
      acc = mm16(L.Cm + jt * 16 * LP, LP, L.Bm + it * 16 * LP, LP, 64, acc, lane);
#pragma unroll
      for (int r = 0; r < 4; ++r) L.CB[(jt * 16 + lq * 4 + r) * 65 + it * 16 + l15] = acc[r]; }
    __syncthreads();
    const float dk = dsk[h];
#pragma unroll 1
    for (int jl = 0; jl < 2; ++jl) { const int jt = jh * 2 + jl, j = jt * 16 + l15;
      f32x4 ys[4];
#pragma unroll
      for (int b = 0; b < 4; ++b) ys[b] = (f32x4){0.f, 0.f, 0.f, 0.f};
#pragma unroll 1
      for (int dir = 0; dir < 2; ++dir) { const int hd = hh * 2 + dir, ch = h * 2 + dir, s = scan_idx(tc, dir);
        const bf16_t* srow = SH + ((size_t)ch * NCH + s) * 4096;
        bf16x8 bh[4][2];
#pragma unroll
        for (int pt = 0; pt < 4; ++pt) { bh[pt][0] = *(const bf16x8*)(srow + (pt * 16 + l15) * 64 + 8 * lq); bh[pt][1] = *(const bf16x8*)(srow + (pt * 16 + l15) * 64 + 32 + 8 * lq); }
        const float sj = L.sS[hd * 64 + j];
        bf16x8 asc[2], acm[2];
#pragma unroll
        for (int ks = 0; ks < 2; ++ks) { float v[8];
#pragma unroll
          for (int e = 0; e < 8; ++e) { const int ii = ks * 32 + 8 * lq + e; const bool ok = dir ? (ii >= j) : (ii <= j);
            v[e] = ok ? __expf(sj - L.sS[hd * 64 + ii]) * L.CB[j * 65 + ii] * L.dtS[hd * 64 + ii] : 0.f; }
          asc[ks] = pack8(v); acm[ks] = *(const bf16x8*)(L.Cm + j * LP + ks * 32 + 8 * lq); }
        float ej[4];
#pragma unroll
        for (int r = 0; r < 4; ++r) ej[r] = __expf(L.sS[hd * 64 + jt * 16 + lq * 4 + r]);
#pragma unroll
        for (int pt = 0; pt < 4; ++pt) { const bf16_t* xp = L.Xt + (hh * 64 + pt * 16 + l15) * LP + 8 * lq;
          f32x4 a1 = {0.f, 0.f, 0.f, 0.f}, a2 = {0.f, 0.f, 0.f, 0.f};
          a1 = __builtin_amdgcn_mfma_f32_16x16x32_bf16(asc[0], *(const bf16x8*)xp, a1, 0, 0, 0);
          a1 = __builtin_amdgcn_mfma_f32_16x16x32_bf16(asc[1], *(const bf16x8*)(xp + 32), a1, 0, 0, 0);
          a2 = __builtin_amdgcn_mfma_f32_16x16x32_bf16(acm[0], bh[pt][0], a2, 0, 0, 0);
          a2 = __builtin_amdgcn_mfma_f32_16x16x32_bf16(acm[1], bh[pt][1], a2, 0, 0, 0);
#pragma unroll
          for (int r = 0; r < 4; ++r) ys[pt][r] += a1[r] + ej[r] * a2[r]; }
      }
      bf16_t zr[4][4];
#pragma unroll
      for (int r = 0; r < 4; ++r)
#pragma unroll
        for (int pt = 0; pt < 4; ++pt) zr[r][pt] = PD[(size_t)(row0 + jt * 16 + lq * 4 + r) * NB_D + h * 64 + pt * 16 + l15];
#pragma unroll
      for (int r = 0; r < 4; ++r) { const int jr = jt * 16 + lq * 4 + r; float sq = 0.f;
#pragma unroll
        for (int pt = 0; pt < 4; ++pt) { const int pp = pt * 16 + l15;
          const float z = bf2f(zr[r][pt]);
          const float v = (ys[pt][r] + dk * bf2f(L.Xt[(hh * 64 + pp) * LP + jr])) * siluf(z);
          const bf16_t vb = f2bf(v); const float vr = bf2f(vb); sq += vr * vr;
          OUT[(size_t)(row0 + jr) * 512 + g * 256 + hh * 64 + pp] = vb; }
        sq += __shfl_xor(sq, 1); sq += __shfl_xor(sq, 2); sq += __shfl_xor(sq, 4); sq += __shfl_xor(sq, 8);
        if (l15 == 0) ssq4[jr * 4 + hh] = sq; }
    }
    __syncthreads();
#pragma unroll 1
    for (int jl = 0; jl < 2; ++jl) {
      float nwv[4];
#pragma unroll
      for (int pt = 0; pt < 4; ++pt) nwv[pt] = nw[g * 256 + hh * 64 + pt * 16 + l15];
      bf16_t ov[4][4];
#pragma unroll
      for (int r = 0; r < 4; ++r)
#pragma unroll
        for (int pt = 0; pt < 4; ++pt) ov[r][pt] = OUT[(size_t)(row0 + (jh * 2 + jl) * 16 + lq * 4 + r) * 512 + g * 256 + hh * 64 + pt * 16 + l15];
#pragma unroll
      for (int r = 0; r < 4; ++r) { const int jr = (jh * 2 + jl) * 16 + lq * 4 + r;
        const float tot = (ssq4[jr * 4 + 0] + ssq4[jr * 4 + 1]) + (ssq4[jr * 4 + 2] + ssq4[jr * 4 + 3]);
        const float rs = 1.f / sqrtf(tot * (1.f / 256.f) + EPS);
#pragma unroll
        for (int pt = 0; pt < 4; ++pt) { const int c = g * 256 + hh * 64 + pt * 16 + l15;
          OUT[(size_t)(row0 + jr) * 512 + c] = f2bf(bf2f(ov[r][pt]) * rs * nwv[pt]); } }
    }
  }
}

extern __shared__ __attribute__((aligned(16))) unsigned char dyn_lds[];

#define XB_TMO      128
#define XB_XCNT(j)  (256  + 64 * (j))
#define XB_XSUB(j)  (1280 + 64 * (j))
#define XB_XGEN(j)  (2304 + 64 * (j))
#define XB_TOP      3328
#define XB_TOPGEN   3392
#define XCD_BAR_WORDS 3456
#define XB_SPIN_CAP (1u << 18)
DI unsigned xb_ld(unsigned* p)              { return __hip_atomic_load(p, __ATOMIC_RELAXED, __HIP_MEMORY_SCOPE_AGENT); }
DI unsigned xb_add(unsigned* p, unsigned v) { return __hip_atomic_fetch_add(p, v, __ATOMIC_RELAXED, __HIP_MEMORY_SCOPE_AGENT); }
DI unsigned xb_xcc_id() { return (unsigned)__builtin_amdgcn_s_getreg((3 << 11) | 20) & 0xFu; }
#define XB_SPIN(cond, bar) do { unsigned _sp = 0; while (cond) { __builtin_amdgcn_s_sleep(1); \
    if ((++_sp & 255u) == 0u) { if (xb_ld(&(bar)[XB_TMO])) break; if (_sp > XB_SPIN_CAP) { atomicAdd(&(bar)[XB_TMO], 1u); break; } } } } while (0)
DI void xcd_barrier_complete(unsigned* bar, unsigned x, unsigned& nloc, unsigned& nx) {
  const unsigned G = gridDim.x;
  unsigned sum, cnt, mine, sp = 0u;
  for (;;) {
    sum = 0u; cnt = 0u; mine = 0u;
#pragma unroll
    for (unsigned j = 0; j < 16; ++j) { const unsigned c = xb_ld(&bar[XB_XCNT(j)]); sum += c; cnt += (c > 0u) ? 1u : 0u; mine = (j == x) ? c : mine; }
    if (sum == G) break;
    __builtin_amdgcn_s_sleep(1);
    if ((++sp & 255u) == 0u) { if (xb_ld(&bar[XB_TMO])) break; if (sp > XB_SPIN_CAP) { atomicAdd(&bar[XB_TMO], 1u); break; } }
  }
  nloc = mine > 0u ? mine : 1u; nx = cnt > 0u ? cnt : 1u;
}
DI void xcd_barrier(unsigned* bar, volatile LAS unsigned* st) {
  asm volatile("s_waitcnt vmcnt(0)" ::: "memory");
  __syncthreads();
  if (tidx() == 0) {
    const unsigned x = xb_xcc_id();
    __builtin_amdgcn_s_waitcnt(0);
    unsigned nloc = st[0], nx = st[1];
    if (nloc == 0u) { xcd_barrier_complete(bar, x, nloc, nx); st[0] = nloc; st[1] = nx; }
    const unsigned old = xb_add(&bar[XB_XSUB(x)], 1u);
    const unsigned gen = old / nloc;
    if (old + 1u == (gen + 1u) * nloc) {
      __builtin_amdgcn_fence(__ATOMIC_RELEASE, "agent");
      asm volatile("s_waitcnt vmcnt(0)" ::: "memory");
      const unsigned og = xb_add(&bar[XB_TOP], 1u);
      const unsigned tg = og / nx;
      if (og + 1u == (tg + 1u) * nx) xb_add(&bar[XB_TOPGEN], 1u);
      else XB_SPIN(xb_ld(&bar[XB_TOPGEN]) == tg, bar);
      __builtin_amdgcn_fence(__ATOMIC_ACQUIRE, "agent");
      xb_add(&bar[XB_XGEN(x)], 1u);
      asm volatile("s_waitcnt vmcnt(0)" ::: "memory");
    } else {
      XB_SPIN(xb_ld(&bar[XB_XGEN(x)]) == gen, bar);
      __builtin_amdgcn_fence(__ATOMIC_ACQUIRE, "agent");
      asm volatile("s_waitcnt vmcnt(0)" ::: "memory");
    }
  }
  __syncthreads();
}

#ifndef REP_ATTN
#define REP_ATTN 1
#endif
#ifndef REP_SCAN
#define REP_SCAN 1
#endif
#ifndef DBG_STOP
#define DBG_STOP 0
#endif
DI void dbg_dump_br(const Params& p, int mode) {
  const bf16_t* BR = (const bf16_t*)(p.ws + WS_BR);
  for (size_t i = (size_t)blockIdx.x * 512 + tidx(); i < (size_t)TL * 1024; i += (size_t)gridDim.x * 512) {
    const size_t row = i >> 10; const int c = (int)(i & 1023), cc = c & 511, hf = c >> 9;
    float v = 0.f;
    if (mode == 0) v = bf2f(BR[((size_t)(hf * 2) * T + row) * 512 + cc]) + bf2f(BR[((size_t)(hf * 2 + 1) * T + row) * 512 + cc]);
    else if (mode == 1) v = bf2f(BR[((size_t)(hf ? 3 : 1) * T + row) * 512 + cc]);
    else if (mode == 2) v = bf2f(BR[((size_t)(hf ? 2 : 0) * T + row) * 512 + cc]);
    p.out[i] = v;
  }
}

DI void dbg_dump_raw(const Params& p, size_t byte_off, size_t cnt = (size_t)TL * 1024) {
  const bf16_t* src = (const bf16_t*)(p.ws + WS_BIG + byte_off);
  for (size_t i = (size_t)blockIdx.x * 512 + tidx(); i < (size_t)TL * 1024; i += (size_t)gridDim.x * 512) p.out[i] = i < cnt ? bf2f(src[i]) : 0.f;
}
typedef const __attribute__((address_space(4))) Params* KP;
DI const Params* launder(KP kp) { asm volatile("" : "+s"(kp)); return (const Params*)kp; }
#define PL (*launder(kp))
DI void gsync_(KP kp) { xcd_barrier((unsigned*)(PL.ws + WS_BAR), (volatile LAS unsigned*)((LAS unsigned char*)dyn_lds + LDS_PHASE)); }
#define gsync(g) gsync_(kp)
template <int l>
DI bool layer_fwd(KP kp, cg::grid_group& grid) {
  unsigned char* lds = dyn_lds; LAS unsigned char* ldsl = (LAS unsigned char*)dyn_lds;
  const int c = blockIdx.x, G = gridDim.x;
  unsigned char* ws = PL.ws;
  const float* MOD = (const float*)(ws + WS_MOD);
  bf16_t* H = (bf16_t*)(ws + WS_H); float* XC = (float*)(ws + WS_XC);
  const bf16_t* WA = (const bf16_t*)(ws + WS_WA); unsigned char* WB = ws + WS_WB; unsigned char* BIG = ws + WS_BIG;
    const float* mod_l = MOD + (size_t)(l * 2 + 0) * 6144; const float* mod_c = MOD + (size_t)(l * 2 + 1) * 6144;
    const float* xin_l = (l == 0) ? PL.in[0] : PL.out; const float* xin_c = (l == 0) ? PL.in[2] : XC;
    const int Mm = (l == 0) ? T : TL;
    const int ntc = (l == 0) ? NCH : 256;
    { pg8::Sched S{(const char*)H, (size_t)D * 2, (const char*)WA + WA_B, 1024, T / 256, NB_B / 256, G, c};
      pg8::EpiStore E{(bf16_t*)(BIG + BG_PB), NB_B, NB_B}; pg8::gemm_phase(ldsl, S, E); }
    gsync(grid);
    if (DBG_STOP == 7 && l == 0) { dbg_dump_raw(PL, BG_PB); return true; }
    if (DBG_STOP == 8 && l == 0) { dbg_dump_raw(PL, BG_PB + (size_t)TL * 1024 * 2, (size_t)T * NB_B - (size_t)TL * 1024); return true; }
    for (int rep = 0; rep < REP_SCAN; ++rep) {
    phase_ml_s1(PL, l, lds);
    gsync(grid);
    if (DBG_STOP == 4 && l == 0) { dbg_dump_raw(PL, BG_UC); return true; }
    phase_ml_s2(PL);
    convert_layer_rest(PL, l, lds, (8 * (MLROW / 2) + 511) / 512);
    gsync(grid);
    if (DBG_STOP == 5 && l == 0) { dbg_dump_raw(PL, BG_SC); return true; }
    phase_ml_s3(PL, l, lds, ntc);
    gsync(grid);
    }
    if (DBG_STOP == 6 && l == 0) { dbg_dump_br(PL, 1); return true; }
    { pg8::Sched S{(const char*)H, (size_t)D * 2, (const char*)WA + WA_D, 1024, T / 256, NB_D / 256, G, c};
      pg8::EpiStore E{(bf16_t*)(BIG + BG_PD), NB_D, NB_D}; pg8::gemm_phase(ldsl, S, E); }
    gsync(grid);
    for (int rep = 0; rep < REP_SCAN; ++rep) {
    phase_ssd_s1(PL, l, lds);
    gsync(grid);
    phase_ssd_s2(PL);
    gsync(grid);
    phase_ssd_s3(PL, l, lds, ntc);
    gsync(grid);
    }
    { pg8::Sched S{(const char*)H, (size_t)D * 2, (const char*)WA + WA_AC, 1024, T / 256, NB_AC / 256, G, c};
      pg8::EpiStore E{(bf16_t*)(BIG + BG_PAC), NB_AC, NB_AC}; pg8::gemm_phase(ldsl, S, E); }
    gsync(grid);
    phase_attn_prep(PL, l);
    for (int k = 0; k < 4; ++k) transpose_job(PL.in[23] + ((size_t)l * 4 + k) * 1024 * 1024, 1024, 1024, 1024, 1024, (bf16_t*)(ws + WS_WA) + (size_t)k * 1024 * 1024, lds);
    gsync(grid);
    { pg8::Sched S{(const char*)(BIG + BG_PAC) + 1536 * 2, (size_t)NB_AC * 2, (const char*)WB + WB_UQ, 384, T / 256, 2, G, c};
      pg8::EpiStore E{(bf16_t*)(BIG + BG_QUP), 384, 384}; pg8::gemm_phase(ldsl, S, E); }
    { pg8::Sched S{(const char*)(BIG + BG_PAC) + 1920 * 2, (size_t)NB_AC * 2, (const char*)WB + WB_UKV, 256, T / 256, 3, G, c};
      pg8::EpiStore E{(bf16_t*)(BIG + BG_KVUP), 768, 768}; pg8::gemm_phase(ldsl, S, E); }
    gsync(grid);
    for (int rep = 0; rep < REP_ATTN; ++rep) { phase_attention(PL, l, (char*)lds);
    gsync(grid); }
    if (DBG_STOP == 1 && l == 0) { dbg_dump_br(PL, 0); return true; }
    if (DBG_STOP == 2 && l == 0) { dbg_dump_br(PL, 1); return true; }
    if (DBG_STOP == 3 && l == 0) { dbg_dump_br(PL, 2); return true; }
    { pg8::Sched S{(const char*)H, (size_t)D * 2, (const char*)WA, 1024, Mm / 256, 16, G, c};
      pg8::EpiAct<0> E{(bf16_t*)BIG, 4096, PL.in[24] + (size_t)l * 4096}; pg8::gemm_phase(ldsl, S, E); }
    gsync(grid);
    { pg8::HSched S{(const char*)(ws + WS_BR), (size_t)512 * 2, (size_t)T * 512 * 2, (const char*)WB + WB_BR, (size_t)1024 * 512 * 2, 512, Mm / 256, 4, G, c};
      pg8::EpiHorner E{(const bf16_t*)BIG, H}; pg8::gemm_phase(ldsl, S, E); }
    transpose_job(PL.in[29] + (size_t)l * 1024 * 4096, 4096, 1024, 4096, 4096, (bf16_t*)(ws + WS_WA), lds);
    gsync(grid);
    { pg8::Sched S{(const char*)H, (size_t)D * 2, (const char*)WB + WB_WO, 1024, TL / 256, 4, G, c};
      pg8::EpiResid E{xin_l, xin_c, PL.out, XC, mod_l + 2048, mod_c + 2048, nullptr}; pg8::gemm_phase(ldsl, S, E); }
    if (l == 0) {
      pg8::KSched S{(const char*)(H + (size_t)TL * D), (size_t)D * 2, (const char*)WB + WB_WO, 1024, 256, 4, 4, G, (c + G / 2) % G};
      pg8::EpiAtomic E{(float*)(ws + WS_ACC)}; pg8::gemm_phase(ldsl, S, E); }
    gsync(grid);
    if (l == 0) phase_ln_affine_mod(PL.out, XC, PL.in[27] + l * 1024, PL.in[28] + l * 1024, mod_l, mod_c, 3072, 4096, H, Mm, PL.in[2], (const float*)(ws + WS_ACC), mod_c + 2048, nullptr);
    else phase_ln_affine_mod(PL.out, XC, PL.in[27] + l * 1024, PL.in[28] + l * 1024, mod_l, mod_c, 3072, 4096, H, Mm);
    transpose_job(PL.in[31] + (size_t)l * 4096 * 1024, 1024, 4096, 1024, 1024, (bf16_t*)WB, lds);
    gsync(grid);
    { pg8::Sched S{(const char*)H, (size_t)D * 2, (const char*)WA, 1024, Mm / 256, 16, G, c};
      pg8::EpiAct<1> E{(bf16_t*)BIG, 4096, PL.in[30] + (size_t)l * 4096}; pg8::gemm_phase(ldsl, S, E); }
    gsync(grid);
    { pg8::Sched S{(const char*)BIG, (size_t)4096 * 2, (const char*)WB, 4096, TL / 256, 4, G, c};
      pg8::EpiResid E{PL.out, XC, PL.out, XC, mod_l + 5120, mod_c + 5120, PL.in[32] + l * 1024}; pg8::gemm_phase(ldsl, S, E); }
    if (l == 0) {
      pg8::KSched S{(const char*)BIG + (size_t)TL * 4096 * 2, (size_t)4096 * 2, (const char*)WB, 4096, 1024, 4, 4, G, (c + G / 2) % G};
      pg8::EpiAtomic E{(float*)(ws + WS_ACC) + (size_t)TC * D}; pg8::gemm_phase(ldsl, S, E); }
    gsync(grid);
    if (l == 0) {
      const float* m1l = MOD + (size_t)(2 + 0) * 6144; const float* m1c = MOD + (size_t)(2 + 1) * 6144;
      phase_ln_affine_mod(PL.out, XC, PL.in[33], PL.in[34], m1l, m1c, 0, 1024, H, T, XC, (const float*)(ws + WS_ACC) + (size_t)TC * D, mod_c + 5120, PL.in[32]);
      convert_layer_start(PL, 1, lds);
      gsync(grid);
    } else {
      phase_ln_affine_mod(PL.out, XC, PL.in[33] + 1024, PL.in[34] + 1024, mod_l, mod_c, 0, 1024, nullptr, TL);
    }
  return false;
}
__global__ void __launch_bounds__(512) fwd_megakernel(Params p_unused) {
  cg::grid_group grid = cg::this_grid();
  unsigned char* lds = dyn_lds;
  KP kp = (KP)__builtin_amdgcn_kernarg_segment_ptr();
  { volatile LAS unsigned* st = (volatile LAS unsigned*)((LAS unsigned char*)dyn_lds + LDS_PHASE);
    if (tidx() == 0) { st[0] = 0u; st[1] = 0u; (void)xb_add((unsigned*)(PL.ws + WS_BAR) + XB_XCNT(xb_xcc_id()), 1u); }
    __syncthreads();
    if (PL.out == nullptr) grid.sync(); }
  phase_setup(PL, lds);
  __syncthreads();
  convert_layer_start(PL, 0, lds);
  gsync(grid);
  { const Params& p = PL; const float* MOD = (const float*)(p.ws + WS_MOD);
    phase_ln_mod(p.in[0], p.in[2], MOD + 0 * 6144, MOD + 1 * 6144, 0, 1024, (bf16_t*)(p.ws + WS_H), T); }
  gsync(grid);
  if (layer_fwd<0>(kp, grid)) return;
  layer_fwd<1>(kp, grid);
}

extern "C" void kernel_launch(void* const* d_in, const int* in_sizes, int n_in, void* d_out, int out_size, void* d_ws, size_t ws_size, hipStream_t stream) {
  static int grid_blocks = 0;
  if (grid_blocks == 0) {
    if (n_in != 35 || out_size != TL * D || ws_size < WS_END) { fprintf(stderr, "kernel_launch: unexpected shapes: n_in %d out %d ws %zu (need %zu)\n", n_in, out_size, ws_size, (size_t)WS_END); grid_blocks = -1; return; }
    int dev = 0, cus = 0, per_cu = 0;
    (void)hipGetDevice(&dev);
    (void)hipDeviceGetAttribute(&cus, hipDeviceAttributeMultiprocessorCount, dev);
    (void)hipFuncSetAttribute((const void*)fwd_megakernel, hipFuncAttributeMaxDynamicSharedMemorySize, LDS_BYTES);
    (void)hipOccupancyMaxActiveBlocksPerMultiprocessor(&per_cu, (const void*)fwd_megakernel, 512, LDS_BYTES);
    if (per_cu < 1) per_cu = 1;
    grid_blocks = cus * 1;
    fprintf(stderr, "kernel_launch: grid %d (cus %d, occupancy %d), ws %zu need %zu\n", grid_blocks, cus, per_cu, ws_size, (size_t)WS_END);
  }
  if (grid_blocks < 0) return;
  Params p{};
  for (int i = 0; i < 35; ++i) p.in[i] = (const float*)d_in[i];
  p.out = (float*)d_out; p.ws = (unsigned char*)d_ws;
  (void)hipMemsetAsync((unsigned char*)d_ws + WS_BAR, 0, XCD_BAR_WORDS * 4, stream);
  void* args[] = {&p};
  hipError_t e = hipLaunchCooperativeKernel((void*)fwd_megakernel, dim3(grid_blocks), dim3(512), args, LDS_BYTES, stream);
  if (e != hipSuccess) fprintf(stderr, "cooperative launch failed: %s (grid %d)\n", hipGetErrorString(e), grid_blocks);
}
```

```cpp
#include <hip/hip_runtime.h>
#include <hip/hip_cooperative_groups.h>
#include <cstdio>
#include <cstdint>
namespace cg = cooperative_groups;
#define DI __device__ __forceinline__
#define LAS __attribute__((address_space(3)))
typedef unsigned short bf16_t;
typedef short bf16x8 __attribute__((ext_vector_type(8)));
typedef short s16x4 __attribute__((ext_vector_type(4)));
typedef float f32x4 __attribute__((ext_vector_type(4)));
typedef float f32x16 __attribute__((ext_vector_type(16)));
typedef unsigned u32x4 __attribute__((ext_vector_type(4)));
typedef unsigned u32x2 __attribute__((ext_vector_type(2)));

constexpr int TL = 16384, TC = 256, T = TL + TC, D = 1024, FF = 4096;
constexpr int NCH = T / 64;
constexpr float ALPHA = 1.4142135623730951f;
constexpr float EPS = 1e-6f;
constexpr int NB_B = 1792, NB_D = 1536, NB_AC = 2304;
constexpr int LDS_PHASE = 156672;
constexpr int LDS_BYTES = LDS_PHASE + 16;
constexpr int MLROW = 8192 + 64;

constexpr size_t al256(size_t x) { return (x + 255) / 256 * 256; }
constexpr size_t WS_TAB32 = 0;
constexpr size_t WS_TAB16 = WS_TAB32 + 256 * 16 * 2 * 4;
constexpr size_t WS_LAM = WS_TAB16 + 256 * 8 * 2 * 4;
constexpr size_t WS_MOD = WS_LAM + 256;
constexpr size_t WS_BAR = al256(WS_MOD + 2 * 2 * 6144 * 4);
constexpr size_t WS_XC = al256(WS_BAR + 16384);
constexpr size_t WS_ACC = al256(WS_XC + (size_t)TC * D * 4);
constexpr size_t WS_WA = al256(WS_ACC + (size_t)2 * TC * D * 4);
constexpr size_t WS_WB = al256(WS_WA + (size_t)5632 * 1024 * 2);
constexpr size_t WS_H = al256(WS_WB + (size_t)4096 * 1024 * 2);
constexpr size_t WS_BR = al256(WS_H + (size_t)T * D * 2);
constexpr size_t WS_BIG = al256(WS_BR + (size_t)4 * T * 512 * 2);
constexpr size_t BIG_BYTES = (size_t)T * 4096 * 2;
constexpr size_t WS_END = WS_BIG + BIG_BYTES;
constexpr size_t BG_PB = 0;
constexpr size_t BG_UC = al256(BG_PB + (size_t)T * NB_B * 2);
constexpr size_t BG_SC = al256(BG_UC + (size_t)8 * NCH * MLROW * 2);
constexpr size_t BG_MSC = al256(BG_SC + (size_t)8 * NCH * MLROW * 2);
constexpr size_t BG_ML_END = BG_MSC + 3 * 8 * NCH * 4;
static_assert(BG_ML_END <= BIG_BYTES, "mlstm overlay");
constexpr size_t BG_PD = 0;
constexpr size_t BG_UH = al256(BG_PD + (size_t)T * NB_D * 2);
constexpr size_t BG_SH = al256(BG_UH + (size_t)16 * NCH * 4096 * 2);
constexpr size_t BG_DE = al256(BG_SH + (size_t)16 * NCH * 4096 * 2);
constexpr size_t BG_SSD_END = BG_DE + 16 * NCH * 4;
static_assert(BG_SSD_END <= BIG_BYTES, "ssd overlay");
constexpr size_t BG_PAC = 0;
constexpr size_t BG_QUP = al256(BG_PAC + (size_t)T * NB_AC * 2);
constexpr size_t BG_KVUP = al256(BG_QUP + (size_t)T * 384 * 2);
static_assert(BG_KVUP + (size_t)T * 768 * 2 <= BIG_BYTES, "attn overlay");
constexpr size_t WB_UQ = 0, WB_UKV = 512 * 384 * 2, WB_BR = WB_UKV + 768 * 256 * 2, WB_WO = WB_BR + (size_t)4 * 1024 * 512 * 2;
static_assert(WB_WO + 1024 * 1024 * 2 <= (size_t)4096 * 1024 * 2, "slot B");
constexpr size_t WA_B = 0, WA_D = (size_t)NB_B * 1024 * 2, WA_AC = WA_D + (size_t)NB_D * 1024 * 2;

struct Params { const float* in[35]; float* out; unsigned char* ws; };

typedef __bf16 bf16x2_t __attribute__((ext_vector_type(2)));
typedef float f32x2_t __attribute__((ext_vector_type(2)));
DI unsigned cvtpk(float lo, float hi) { f32x2_t v = {lo, hi}; bf16x2_t b = __builtin_convertvector(v, bf16x2_t); return __builtin_bit_cast(unsigned, b); }
DI bf16_t f2bf(float x) { return (bf16_t)(cvtpk(x, 0.f) & 0xffffu); }
DI float bf2f(bf16_t v) { return __uint_as_float((unsigned)v << 16); }
DI float bflo(unsigned w) { return __uint_as_float(w << 16); }
DI float bfhi(unsigned w) { return __uint_as_float(w & 0xffff0000u); }
DI float wave_sum(float v) {
#pragma unroll
  for (int o = 1; o < 64; o <<= 1) v += __shfl_xor(v, o);
  return v;
}
DI float wave_max(float v) {
#pragma unroll
  for (int o = 1; o < 64; o <<= 1) v = fmaxf(v, __shfl_xor(v, o));
  return v;
}
DI float sigmoidf(float x) { return __builtin_amdgcn_rcpf(1.f + __expf(-x)); }
DI float siluf(float x) { return x / (1.f + __expf(-x)); }
DI int tidx() { int t = (int)__builtin_amdgcn_workitem_id_x(); asm volatile("" : "+v"(t)); return t; }
#define LDS_WAIT() asm volatile("s_waitcnt lgkmcnt(0)" ::: "memory")

namespace pg8 {
constexpr int BM = 256, BK = 64, HALF = 128, HTB = HALF * BK * 2, STAGE_BYTES = 8 * HTB, NXCD = 8, WGM = 8;
DI int lds_byte(int r, int c) { const int st = (r >> 4) * 2 + (c >> 5), rr = r & 15, cc = c & 31, ob = rr * 64 + cc * 2; return st * 1024 + (ob ^ (((ob >> 9) & 1) << 5)); }
DI void stage_rc(int b, int& R, int& C) { const int st = b / 1024, sb = b % 1024, swz = sb ^ (((sb >> 9) & 1) << 5); R = (st >> 1) * 16 + swz / 64; C = (st & 1) * 32 + (swz % 64) / 2; }
DI int perm32(int rho) { const int n = rho >> 4, i = rho & 15; return 8 * (i >> 2) + 4 * n + (i & 3); }
struct Unit { int pm, pn, k; };
DI void tile_order(int L, int nM, int nN, int& pm, int& pn) {
  const int nwg = nM * nN; int wgid = L;
  { const int q = nwg / NXCD, r = nwg % NXCD, xcd = wgid % NXCD, off = wgid / NXCD; wgid = (xcd < r ? xcd * (q + 1) : r * (q + 1) + (xcd - r) * q) + off; }
  const int nig = WGM * nN, gid = wgid / nig, fm = gid * WGM, gsz = (nM - fm) < WGM ? (nM - fm) : WGM;
  pm = fm + ((wgid % nig) % gsz); pn = (wgid % nig) / gsz;
}
struct Sched {
  const char* A; size_t lda_b; const char* Bt; int K; int nM, nN, G, c;
  DI bool next(int i, Unit& u) const { const long L = (long)i * G + c; if (L >= (long)nM * nN) return false; tile_order((int)L, nM, nN, u.pm, u.pn); u.k = 0; return true; }
  DI const char* a_ptr(const Unit& u) const { return A + (size_t)u.pm * BM * lda_b; }
  DI const char* b_ptr(const Unit& u) const { return Bt + (size_t)u.pn * BM * K * 2; }
  DI int ldb_e() const { return K; }
};
struct HSched {
  const char* A; size_t lda_b; size_t a_ks; const char* Bt; size_t b_ks; int K; int nM, nN, G, c;
  DI bool next(int i, Unit& u) const { const long L = (long)(i >> 2) * G + c; if (L >= (long)nM * nN) return false; tile_order((int)L, nM, nN, u.pm, u.pn); u.k = i & 3; return true; }
  DI const char* a_ptr(const Unit& u) const { return A + (size_t)u.k * a_ks + (size_t)u.pm * BM * lda_b; }
  DI const char* b_ptr(const Unit& u) const { return Bt + (size_t)u.k * b_ks + (size_t)u.pn * BM * K * 2; }
  DI int ldb_e() const { return K; }
};
struct KSched {
  const char* A; size_t lda_b; const char* Bt; int ldb; int K; int nks, nN, G, c;
  DI bool next(int i, Unit& u) const { const long L = (long)i * G + c; if (L >= (long)nN * nks) return false; u.pm = 0; u.pn = (int)(L % nN); u.k = (int)(L / nN); return true; }
  DI const char* a_ptr(const Unit& u) const { return A + (size_t)u.k * K * 2; }
  DI const char* b_ptr(const Unit& u) const { return Bt + ((size_t)u.pn * BM * ldb + (size_t)u.k * K) * 2; }
  DI int ldb_e() const { return ldb; }
};

template <class Epi, class SchedT>
DI void gemm_phase(LAS unsigned char* lds, const SchedT& S, const Epi& E) {
  const int tid = tidx(), wid = __builtin_amdgcn_readfirstlane(tid >> 6), lane = tid & 63, wr = wid >> 2, wc = wid & 3, fr = lane & 15, fq = lane >> 4;
  const int K = S.K, nt = K / BK, ldb = S.ldb_e();
  unsigned voffA[2], voffB[2];
#pragma unroll
  for (int i = 0; i < 2; ++i) { int R, C; stage_rc(tid * 16 + i * 8192, R, C); const int Rb = Epi::PERM ? ((R & ~31) + perm32(R & 31)) : R;
    voffA[i] = (unsigned)(R * (int)S.lda_b + C * 2); voffB[i] = (unsigned)(Rb * ldb + C) * 2u; }
  const size_t kstep = (size_t)(BK * 2);
  const size_t hsA = (size_t)HALF * S.lda_b, hsB = (size_t)HALF * ldb * 2;
  const unsigned ldsw = (unsigned)wid * 1024u;
  const int aoff = lds_byte(wr * 64 + fr, fq * 8), boff = lds_byte(wc * 32 + fr, fq * 8);
#define PG8_SA(b, h) (((b) * 2 + (h)) * HTB)
#define PG8_SB(b, h) ((4 + (b) * 2 + (h)) * HTB)
#define PG8_STAGE(bufoff, gbase, voff) do { _Pragma("unroll") for (int _i = 0; _i < 2; ++_i) \
    __builtin_amdgcn_global_load_lds((const unsigned*)((const char*)(gbase) + (voff)[_i]), (LAS unsigned*)(lds + (bufoff) + ldsw + _i * 8192), 16, 0, 0); } while (0)
#define PG8_LDA(dst, b, h) do { _Pragma("unroll") for (int m = 0; m < 4; ++m) _Pragma("unroll") for (int k = 0; k < 2; ++k) dst[m][k] = *(const LAS bf16x8*)(lds + PG8_SA(b, h) + aoff + m * 2048 + k * 1024); } while (0)
#define PG8_LDB(dst, b, h) do { _Pragma("unroll") for (int n = 0; n < 2; ++n) _Pragma("unroll") for (int k = 0; k < 2; ++k) dst[n][k] = *(const LAS bf16x8*)(lds + PG8_SB(b, h) + boff + n * 2048 + k * 1024); } while (0)
#define PG8_MMA(ai, bj, At, Bt) do { __builtin_amdgcn_s_setprio(1); _Pragma("unroll") for (int m = 0; m < 4; ++m) _Pragma("unroll") for (int n = 0; n < 2; ++n) _Pragma("unroll") for (int k = 0; k < 2; ++k) \
    acc[ai][bj][m][n] = __builtin_amdgcn_mfma_f32_16x16x32_bf16(Bt[n][k], At[m][k], acc[ai][bj][m][n], 0, 0, 0); __builtin_amdgcn_s_setprio(0); } while (0)
#define PG8_WAIT_V(n) asm volatile("s_waitcnt vmcnt(" #n ")" ::: "memory")
#define PG8_WAIT_L(n) asm volatile("s_waitcnt lgkmcnt(" #n ")" ::: "memory")
#define PG8_BAR __builtin_amdgcn_s_barrier()
#define PG8_SCHED __builtin_amdgcn_sched_barrier(0)
  Unit cur, nxt; int ui = 0;
  if (!S.next(0, cur)) return;
  f32x4 acc[2][2][4][2];
#pragma unroll
  for (int a = 0; a < 2; ++a)
#pragma unroll
    for (int b = 0; b < 2; ++b)
#pragma unroll
      for (int m = 0; m < 4; ++m)
#pragma unroll
        for (int n = 0; n < 2; ++n) acc[a][b][m][n] = (f32x4){0.f, 0.f, 0.f, 0.f};
  bf16x8 At[4][2], B0[2][2], B1[2][2];
  const char* cA = S.a_ptr(cur); const char* cB = S.b_ptr(cur);
  PG8_STAGE(PG8_SB(0, 0), cB, voffB); PG8_STAGE(PG8_SA(0, 0), cA, voffA); PG8_STAGE(PG8_SB(0, 1), cB + hsB, voffB); PG8_STAGE(PG8_SA(0, 1), cA + hsA, voffA);
  if (wr == 1) PG8_BAR;
  PG8_WAIT_V(4); PG8_BAR;
  PG8_STAGE(PG8_SB(1, 0), cB + kstep, voffB); PG8_STAGE(PG8_SA(1, 0), cA + kstep, voffA); PG8_STAGE(PG8_SB(1, 1), cB + hsB + kstep, voffB);
  PG8_WAIT_V(6); PG8_BAR;
  for (;;) {
    const bool has_next = S.next(ui + 1, nxt);
    const char* nA = has_next ? S.a_ptr(nxt) : cA; const char* nB = has_next ? S.b_ptr(nxt) : cB;
    for (int t = 0; t < nt; t += 2) {
      const bool last = (t == nt - 2);
      const char* a1 = cA + (size_t)(t + 1) * kstep;
      const char* a2 = last ? nA : cA + (size_t)(t + 2) * kstep; const char* b2 = last ? nB : cB + (size_t)(t + 2) * kstep;
      const char* a3 = a2 + kstep; const char* b3 = b2 + kstep;
      PG8_LDB(B0, 0, 0); PG8_SCHED; PG8_LDA(At, 0, 0); PG8_STAGE(PG8_SA(1, 1), a1 + hsA, voffA);
      PG8_WAIT_L(8); PG8_BAR; PG8_WAIT_L(0); PG8_MMA(0, 0, At, B0); PG8_BAR; PG8_SCHED;
      PG8_LDB(B1, 0, 1); PG8_STAGE(PG8_SB(0, 0), b2, voffB);
      PG8_BAR; PG8_WAIT_L(0); PG8_MMA(0, 1, At, B1); PG8_BAR;
      PG8_LDA(At, 0, 1); PG8_STAGE(PG8_SA(0, 0), a2, voffA);
      PG8_BAR; PG8_WAIT_L(0); PG8_MMA(1, 0, At, B0); PG8_BAR; PG8_SCHED;
      PG8_STAGE(PG8_SB(0, 1), b2 + hsB, voffB);
      PG8_WAIT_V(6); PG8_BAR; PG8_MMA(1, 1, At, B1); PG8_BAR;
      PG8_LDB(B0, 1, 0); PG8_SCHED; PG8_LDA(At, 1, 0); PG8_STAGE(PG8_SA(0, 1), a2 + hsA, voffA);
      PG8_WAIT_L(8); PG8_BAR; PG8_WAIT_L(0); PG8_MMA(0, 0, At, B0); PG8_BAR; PG8_SCHED;
      PG8_LDB(B1, 1, 1); PG8_STAGE(PG8_SB(1, 0), b3, voffB);
      PG8_BAR; PG8_WAIT_L(0); PG8_MMA(0, 1, At, B1); PG8_BAR;
      PG8_LDA(At, 1, 1); PG8_STAGE(PG8_SA(1, 0), a3, voffA);
      PG8_BAR; PG8_WAIT_L(0); PG8_MMA(1, 0, At, B0); PG8_BAR; PG8_SCHED;
      PG8_STAGE(PG8_SB(1, 1), b3 + hsB, voffB);
      PG8_WAIT_V(6); PG8_BAR; PG8_MMA(1, 1, At, B1); PG8_BAR;
    }
    const bool zero = E(acc, cur, wr, wc, fr, fq);
    if (zero) {
#pragma unroll
      for (int a = 0; a < 2; ++a)
#pragma unroll
        for (int b = 0; b < 2; ++b)
#pragma unroll
          for (int m = 0; m < 4; ++m)
#pragma unroll
            for (int n = 0; n < 2; ++n) acc[a][b][m][n] = (f32x4){0.f, 0.f, 0.f, 0.f};
    }
    if (!has_next) break;
    cur = nxt; cA = nA; cB = nB; ++ui;
  }
  PG8_WAIT_V(0);
  if (wr == 0) PG8_BAR;
  PG8_BAR;
#undef PG8_SA
#undef PG8_SB
#undef PG8_STAGE
#undef PG8_LDA
#undef PG8_LDB
#undef PG8_MMA
#undef PG8_WAIT_V
#undef PG8_WAIT_L
#undef PG8_BAR
#undef PG8_SCHED
}

typedef f32x4 Acc[2][2][4][2];
struct EpiStore {
  static constexpr bool PERM = true;
  bf16_t* O; int ldc; int ncols;
  DI bool operator()(Acc& acc, const Unit& u, int wr, int wc, int fr, int fq) const {
    const int row0 = u.pm * BM + wr * 64 + fr, col0 = u.pn * BM + wc * 32 + 8 * fq;
#pragma unroll
    for (int ai = 0; ai < 2; ++ai)
#pragma unroll
      for (int m = 0; m < 4; ++m) { bf16_t* rowp = O + (size_t)(row0 + ai * HALF + m * 16) * ldc;
#pragma unroll
        for (int bj = 0; bj < 2; ++bj) { const int col = col0 + bj * HALF; const f32x4 v0 = acc[ai][bj][m][0], v1 = acc[ai][bj][m][1];
          u32x4 w; w.x = cvtpk(v0[0], v0[1]); w.y = cvtpk(v0[2], v0[3]); w.z = cvtpk(v1[0], v1[1]); w.w = cvtpk(v1[2], v1[3]);
          if (col < ncols) *(u32x4*)(rowp + col) = w; } }
    return true;
  }
};
template <int ACT> struct EpiAct {
  static constexpr bool PERM = true;
  bf16_t* O; int ldc; const float* bias;
  DI bool operator()(Acc& acc, const Unit& u, int wr, int wc, int fr, int fq) const {
    const int row0 = u.pm * BM + wr * 64 + fr, col0 = u.pn * BM + wc * 32 + 8 * fq;
    f32x4 bv[2][2];
#pragma unroll
    for (int bj = 0; bj < 2; ++bj)
#pragma unroll
      for (int n = 0; n < 2; ++n) bv[bj][n] = *(const f32x4*)(bias + col0 + bj * HALF + 4 * n);
#pragma unroll
    for (int ai = 0; ai < 2; ++ai)
#pragma unroll
      for (int m = 0; m < 4; ++m) { bf16_t* rowp = O + (size_t)(row0 + ai * HALF + m * 16) * ldc + col0;
#pragma unroll
        for (int bj = 0; bj < 2; ++bj) { f32x4 v0 = acc[ai][bj][m][0] + bv[bj][0], v1 = acc[ai][bj][m][1] + bv[bj][1];
#pragma unroll
          for (int j = 0; j < 4; ++j) {
            if (ACT == 0) { v0[j] = sigmoidf(v0[j]); v1[j] = sigmoidf(v1[j]); }
            else { const float a = fmaxf(v0[j], 0.f), b = fmaxf(v1[j], 0.f); v0[j] = a * a; v1[j] = b * b; } }
          u32x4 w; w.x = cvtpk(v0[0], v0[1]); w.y = cvtpk(v0[2], v0[3]); w.z = cvtpk(v1[0], v1[1]); w.w = cvtpk(v1[2], v1[3]);
          *(u32x4*)(rowp + bj * HALF) = w; } }
    return true;
  }
};
struct EpiHorner {
  static constexpr bool PERM = true;
  const bf16_t* G; bf16_t* Z;
  DI bool operator()(Acc& acc, const Unit& u, int wr, int wc, int fr, int fq) const {
    const int row0 = u.pm * BM + wr * 64 + fr, col0 = u.pn * BM + wc * 32 + 8 * fq, k = u.k;
    const int k1 = k < 3 ? k + 1 : k;
#pragma unroll
    for (int ai = 0; ai < 2; ++ai)
#pragma unroll
      for (int m = 0; m < 4; ++m) { const size_t row = (size_t)(row0 + ai * HALF + m * 16);
        u32x4 s0[2], s1[2];
#pragma unroll
        for (int bj = 0; bj < 2; ++bj) { s0[bj] = *(const u32x4*)(G + row * 4096 + k * 1024 + col0 + bj * HALF); s1[bj] = *(const u32x4*)(G + row * 4096 + k1 * 1024 + col0 + bj * HALF); }
#pragma unroll
        for (int bj = 0; bj < 2; ++bj) { const int col = col0 + bj * HALF;
          float f[8] = {bflo(s0[bj].x), bfhi(s0[bj].x), bflo(s0[bj].y), bfhi(s0[bj].y), bflo(s0[bj].z), bfhi(s0[bj].z), bflo(s0[bj].w), bfhi(s0[bj].w)};
          if (k < 3) { const float d[8] = {bflo(s1[bj].x), bfhi(s1[bj].x), bflo(s1[bj].y), bfhi(s1[bj].y), bflo(s1[bj].z), bfhi(s1[bj].z), bflo(s1[bj].w), bfhi(s1[bj].w)};
#pragma unroll
            for (int j = 0; j < 8; ++j) f[j] = f[j] * __builtin_amdgcn_rcpf(d[j]); }
          f32x4 v0 = acc[ai][bj][m][0], v1 = acc[ai][bj][m][1];
#pragma unroll
          for (int j = 0; j < 4; ++j) { v0[j] *= f[j]; v1[j] *= f[4 + j]; }
          acc[ai][bj][m][0] = v0; acc[ai][bj][m][1] = v1;
          if (k == 3) { u32x4 w; w.x = cvtpk(v0[0], v0[1]); w.y = cvtpk(v0[2], v0[3]); w.z = cvtpk(v1[0], v1[1]); w.w = cvtpk(v1[2], v1[3]);
            *(u32x4*)(Z + row * 1024 + col) = w; } } }
    return k == 3;
  }
};
struct EpiResid {
  static constexpr bool PERM = false;
  const float* xin_l; const float* xin_c; float* out_l; float* out_c; const float* g_l; const float* g_c; const float* bias;
  DI bool operator()(Acc& acc, const Unit& u, int wr, int wc, int fr, int fq) const {
    const bool isc = u.pm >= TL / BM;
    const float* xin = isc ? xin_c - (size_t)TL * D : xin_l; float* out = isc ? out_c - (size_t)TL * D : out_l; const float* g = isc ? g_c : g_l;
    const int row0 = u.pm * BM + wr * 64 + fr, col0 = u.pn * BM + wc * 32 + 4 * fq;
    f32x4 gv[2][2], bv[2][2];
#pragma unroll
    for (int bj = 0; bj < 2; ++bj)
#pragma unroll
      for (int n = 0; n < 2; ++n) { gv[bj][n] = *(const f32x4*)(g + col0 + bj * HALF + n * 16); bv[bj][n] = bias ? *(const f32x4*)(bias + col0 + bj * HALF + n * 16) : (f32x4){0.f, 0.f, 0.f, 0.f}; }
#pragma unroll
    for (int ai = 0; ai < 2; ++ai)
#pragma unroll
      for (int m = 0; m < 4; ++m) { const size_t off = (size_t)(row0 + ai * HALF + m * 16) * D + col0;
        f32x4 xv[2][2];
#pragma unroll
        for (int bj = 0; bj < 2; ++bj)
#pragma unroll
          for (int n = 0; n < 2; ++n) xv[bj][n] = *(const f32x4*)(xin + off + bj * HALF + n * 16);
#pragma unroll
        for (int bj = 0; bj < 2; ++bj)
#pragma unroll
          for (int n = 0; n < 2; ++n) *(f32x4*)(out + off + bj * HALF + n * 16) = xv[bj][n] * ALPHA + gv[bj][n] * (acc[ai][bj][m][n] + bv[bj][n]); }
    return true;
  }
};
struct EpiAtomic {
  static constexpr bool PERM = false;
  float* ACC;
  DI bool operator()(Acc& acc, const Unit& u, int wr, int wc, int fr, int fq) const {
    const int row0 = wr * 64 + fr, col0 = u.pn * BM + wc * 32 + 4 * fq;
#pragma unroll
    for (int ai = 0; ai < 2; ++ai)
#pragma unroll
      for (int m = 0; m < 4; ++m) { float* rp = ACC + (size_t)(row0 + ai * HALF + m * 16) * D + col0;
#pragma unroll
        for (int bj = 0; bj < 2; ++bj)
#pragma unroll
          for (int n = 0; n < 2; ++n)
#pragma unroll
            for (int e = 0; e < 4; ++e) (void)__hip_atomic_fetch_add(rp + bj * HALF + n * 16 + e, acc[ai][bj][m][n][e], __ATOMIC_RELAXED, __HIP_MEMORY_SCOPE_AGENT); }
    return true;
  }
};
}

namespace att {
constexpr int QBLK = 32, KVBLK = 64;
constexpr float THR = 8.f;
constexpr size_t SHM_V = KVBLK * 128 * 2;
constexpr size_t OFF_K = 3 * SHM_V, OFF_WS = OFF_K + 3 * 64 * 208, OFF_O1 = OFF_WS + 8 * 64 * 4;
static_assert(OFF_O1 + 65536 <= LDS_PHASE, "attn lds");
#define SBAR() __builtin_amdgcn_sched_barrier(0)
DI int crow(int r, int hi) { return (r & 3) + 8 * (r >> 2) + 4 * hi; }
DI bf16x8 ld8(const bf16_t* p) { return *reinterpret_cast<const bf16x8*>(p); }

DI void partialSM(f32x16& p0, f32x16& p1, float& m_reg, float& mn, float& alpha, const float C, const float thr_raw) {
  float pmax = p0[0];
#pragma unroll
  for (int r = 1; r < 16; ++r) pmax = fmaxf(pmax, p0[r]);
#pragma unroll
  for (int r = 0; r < 16; ++r) pmax = fmaxf(pmax, p1[r]);
  { auto rr = __builtin_amdgcn_permlane32_swap(__float_as_uint(pmax), __float_as_uint(pmax), false, false);
    pmax = fmaxf(__uint_as_float(rr[0]), __uint_as_float(rr[1])); }
  if (__builtin_expect(__all(pmax - m_reg <= thr_raw), 1)) { mn = m_reg; alpha = 1.f; }
  else { mn = fmaxf(m_reg, pmax); alpha = __builtin_amdgcn_exp2f((m_reg - mn) * C); m_reg = mn; }
  const float mnC = -mn * C;
#pragma unroll
  for (int r = 0; r < 16; ++r) p0[r] = fmaf(p0[r], C, mnC);
#pragma unroll
  for (int r = 0; r < 16; ++r) p1[r] = fmaf(p1[r], C, mnC);
#pragma unroll
  for (int r = 0; r < 16; ++r) p0[r] = __builtin_amdgcn_exp2f(p0[r]);
}
DI void finishSM(f32x16& p0, f32x16& p1, float alpha, float& l_reg, bf16x8& pa0, bf16x8& pa1, bf16x8& pa2, bf16x8& pa3) {
#pragma unroll
  for (int r = 0; r < 16; ++r) p1[r] = __builtin_amdgcn_exp2f(p1[r]);
  float ps = 0;
#pragma unroll
  for (int r = 0; r < 16; ++r) ps += p0[r];
#pragma unroll
  for (int r = 0; r < 16; ++r) ps += p1[r];
  { auto rr = __builtin_amdgcn_permlane32_swap(__float_as_uint(ps), __float_as_uint(ps), false, false);
    ps = __uint_as_float(rr[0]) + __uint_as_float(rr[1]); }
  l_reg = l_reg * alpha + ps;
#define PK4(P, BASE, OUT) do { unsigned a0 = cvtpk(P[BASE + 0], P[BASE + 1]), a1 = cvtpk(P[BASE + 2], P[BASE + 3]);   \
    unsigned b0 = cvtpk(P[BASE + 4], P[BASE + 5]), b1 = cvtpk(P[BASE + 6], P[BASE + 7]);                              \
    auto r0 = __builtin_amdgcn_permlane32_swap(a0, b0, false, false); auto r1 = __builtin_amdgcn_permlane32_swap(a1, b1, false, false); \
    u32x4 w = {r0[0], r1[0], r0[1], r1[1]}; OUT = *reinterpret_cast<bf16x8*>(&w); } while (0)
  PK4(p0, 0, pa0); PK4(p0, 8, pa1); PK4(p1, 0, pa2); PK4(p1, 8, pa3);
#undef PK4
}
template <int DQK>
DI void qkt(f32x16& p0, f32x16& p1, const char* Ks, const bf16x8* qr, int r32, int hi) {
  constexpr int KP = DQK * 2 + 16;
  p0 = f32x16{}; p1 = f32x16{};
#pragma unroll
  for (int d0 = 0; d0 < DQK / 16; ++d0) { const int cb = (d0 * 16 + hi * 8) * 2;
    bf16x8 b0 = *reinterpret_cast<const bf16x8*>(Ks + r32 * KP + cb);
    bf16x8 b1 = *reinterpret_cast<const bf16x8*>(Ks + (32 + r32) * KP + cb);
    p0 = __builtin_amdgcn_mfma_f32_32x32x16_bf16(b0, qr[d0], p0, 0, 0, 0);
    p1 = __builtin_amdgcn_mfma_f32_32x32x16_bf16(b1, qr[d0], p1, 0, 0, 0); }
}
DI int v_st(int k, int c) { const int kk = (k & ~0xC) | ((k & 4) << 1) | ((k & 8) >> 1); return ((kk >> 3) * 4 + (c >> 5)) * 512 + ((kk & 7) * 32 + (c & 31)) * 2; }
DI int v_rd_base(int lane) { return ((lane & 3) << 3) | (((lane >> 2) & 3) << 6) | (((lane >> 4) & 1) << 5) | (((lane >> 5) & 1) << 8); }
constexpr int v_rd_off(int d0, int ks, int half) { return d0 * 512 + ks * 4096 + half * 2048; }
template <int OFF> DI s16x4 tr_read(int vb) {
  s16x4 r; asm volatile("ds_read_b64_tr_b16 %0, %1 offset:%2" : "=&v"(r) : "v"(vb), "i"(OFF) : "memory"); return r;
}
template <int D0> DI void pv_one(f32x16& od, int vb, bf16x8 pa0, bf16x8 pa1, bf16x8 pa2, bf16x8 pa3) {
  const s16x4 l0 = tr_read<v_rd_off(D0, 0, 0)>(vb), h0 = tr_read<v_rd_off(D0, 0, 1)>(vb), l1 = tr_read<v_rd_off(D0, 1, 0)>(vb), h1 = tr_read<v_rd_off(D0, 1, 1)>(vb);
  const s16x4 l2 = tr_read<v_rd_off(D0, 2, 0)>(vb), h2 = tr_read<v_rd_off(D0, 2, 1)>(vb), l3 = tr_read<v_rd_off(D0, 3, 0)>(vb), h3 = tr_read<v_rd_off(D0, 3, 1)>(vb);
  asm volatile("s_waitcnt lgkmcnt(0)" ::: "memory"); SBAR();
#define PK(L, H) (bf16x8){L[0], L[1], L[2], L[3], H[0], H[1], H[2], H[3]}
  od = __builtin_amdgcn_mfma_f32_32x32x16_bf16(pa0, PK(l0, h0), od, 0, 0, 0);
  od = __builtin_amdgcn_mfma_f32_32x32x16_bf16(pa1, PK(l1, h1), od, 0, 0, 0);
  od = __builtin_amdgcn_mfma_f32_32x32x16_bf16(pa2, PK(l2, h2), od, 0, 0, 0);
  od = __builtin_amdgcn_mfma_f32_32x32x16_bf16(pa3, PK(l3, h3), od, 0, 0, 0);
#undef PK
}
template <int KS> DI void pv_step(f32x16* o, int vb, bf16x8 pa) {
  const s16x4 l0 = tr_read<v_rd_off(0, KS, 0)>(vb), h0 = tr_read<v_rd_off(0, KS, 1)>(vb), l1 = tr_read<v_rd_off(1, KS, 0)>(vb), h1 = tr_read<v_rd_off(1, KS, 1)>(vb);
  const s16x4 l2 = tr_read<v_rd_off(2, KS, 0)>(vb), h2 = tr_read<v_rd_off(2, KS, 1)>(vb), l3 = tr_read<v_rd_off(3, KS, 0)>(vb), h3 = tr_read<v_rd_off(3, KS, 1)>(vb);
  asm volatile("s_waitcnt lgkmcnt(0)" ::: "memory"); SBAR();
#define PK(L, H) (bf16x8){L[0], L[1], L[2], L[3], H[0], H[1], H[2], H[3]}
  o[0] = __builtin_amdgcn_mfma_f32_32x32x16_bf16(pa, PK(l0, h0), o[0], 0, 0, 0);
  o[1] = __builtin_amdgcn_mfma_f32_32x32x16_bf16(pa, PK(l1, h1), o[1], 0, 0, 0);
  o[2] = __builtin_amdgcn_mfma_f32_32x32x16_bf16(pa, PK(l2, h2), o[2], 0, 0, 0);
  o[3] = __builtin_amdgcn_mfma_f32_32x32x16_bf16(pa, PK(l3, h3), o[3], 0, 0, 0);
#undef PK
}
DI void pv_d0(f32x16* o, int vb, bf16x8 pa0, bf16x8 pa1, bf16x8 pa2, bf16x8 pa3) {
  pv_step<0>(o, vb, pa0); pv_step<1>(o, vb, pa1); pv_step<2>(o, vb, pa2); pv_step<3>(o, vb, pa3);
}

template <int DQK>
DI void attn_body(const bf16_t* __restrict__ Qb, int ldq, const bf16_t* __restrict__ K0, int ldk0, const bf16_t* __restrict__ K1, int ldk1,
                  const bf16_t* __restrict__ Vh, int ldv, int seq, float scale, char* lds, f32x16 (&o)[4], float (&rli)[16]) {
  constexpr int KP = DQK * 2 + 16, SHM_K = 64 * KP, CPR = DQK / 8;
  const float C = scale * 1.4426950408889634f, thr_raw = THR / scale;
  const int tid = tidx(), wid = tid >> 6, lane = tid & 63, r32 = lane & 31, hi = lane >> 5;
  char* V_lds = lds; char* K_lds = lds + OFF_K;
  float* wsl = (float*)(lds + OFF_WS) + wid * 64; float* li_l = wsl; float* al_l = wsl + 32;
  float m_reg = -1e30f, l_reg = 0; bf16x8 qr[DQK / 16];
#pragma unroll
  for (int d = 0; d < 4; ++d) o[d] = f32x16{};
  const bf16_t* Qw = Qb + (long)(wid * QBLK + r32) * ldq + hi * 8;
#pragma unroll
  for (int d0 = 0; d0 < DQK / 16; ++d0) qr[d0] = ld8(Qw + d0 * 16);
  const int sr = tid >> 4, sc = (tid & 15) * 8, vst0 = v_st(sr, sc), vst1 = v_st(32 + sr, sc);
  const int vb0 = (int)(uintptr_t)V_lds + v_rd_base(lane);
  const int kc0 = tid, kc1 = 512 + (tid & 255);
  const int kr0 = kc0 / CPR, kcc0 = kc0 % CPR, kr1 = (DQK == 96) ? kc1 / CPR : 0, kcc1 = (DQK == 96) ? kc1 % CPR : 0;
  const bf16_t* kp0 = (kcc0 < 8) ? K0 + (long)kr0 * ldk0 + kcc0 * 8 : K1 + (long)kr0 * ldk1 + (kcc0 - 8) * 8;
  const long kst0 = (kcc0 < 8) ? (long)64 * ldk0 : (long)64 * ldk1;
  const bf16_t* kp1 = (kcc1 < 8) ? K0 + (long)kr1 * ldk0 + kcc1 * 8 : K1 + (long)kr1 * ldk1 + (kcc1 - 8) * 8;
  const long kst1 = (kcc1 < 8) ? (long)64 * ldk0 : (long)64 * ldk1;
  const int kw0 = kr0 * KP + kcc0 * 16, kw1 = kr1 * KP + kcc1 * 16;
  struct { bf16x8 vs0, vs1, ks0, ks1; } sr_[2];
#define SLOAD(i, t) do { sr_[i].vs0 = ld8(&Vh[(long)((t) * 64 + sr) * ldv + sc]); sr_[i].vs1 = ld8(&Vh[(long)((t) * 64 + 32 + sr) * ldv + sc]); \
    sr_[i].ks0 = ld8(kp0 + (long)(t) * kst0); if (DQK == 96) sr_[i].ks1 = ld8(kp1 + (long)(t) * kst1); } while (0)
#define SWRITE(b, i) do { *(bf16x8*)(V_lds + (b) * SHM_V + vst0) = sr_[i].vs0; *(bf16x8*)(V_lds + (b) * SHM_V + vst1) = sr_[i].vs1; \
    *(bf16x8*)(K_lds + (b) * SHM_K + kw0) = sr_[i].ks0; if (DQK == 96) *(bf16x8*)(K_lds + (b) * SHM_K + kw1) = sr_[i].ks1; } while (0)
#define SWAIT() do { if (DQK == 96) asm volatile("s_waitcnt vmcnt(4)" ::: "memory"); else asm volatile("s_waitcnt vmcnt(3)" ::: "memory"); } while (0)
#define RESC(a) do { if (__any((a) < 1.f)) { if (hi == 0) al_l[r32] = (a); asm volatile("s_waitcnt lgkmcnt(0)" ::: "memory"); \
    _Pragma("unroll") for (int d = 0; d < 4; ++d) _Pragma("unroll") for (int r = 0; r < 16; ++r) o[d][r] *= al_l[crow(r, hi)]; } } while (0)
  f32x16 pA0, pA1, pB0, pB1; float mnA, mnB, alA, alB; bf16x8 pa0, pa1, pa2, pa3; const int NT = seq / KVBLK;
  constexpr int SE = 0, SO = 1;
  SLOAD(SE, 0); asm volatile("s_waitcnt vmcnt(0)" ::: "memory"); SWRITE(0, SE); __syncthreads();
  qkt<DQK>(pA0, pA1, K_lds, qr, r32, hi); partialSM(pA0, pA1, m_reg, mnA, alA, C, thr_raw);
  SLOAD(SO, 1); if (2 < NT) SLOAD(SE, 2);
  SWAIT(); SWRITE(1, SO); __syncthreads();
  int b = 1;
  for (int j = 1; j + 1 < NT; j += 2) {
    const int b1 = (b == 2) ? 0 : b + 1, b2 = (b == 0) ? 2 : b - 1;
    SBAR(); qkt<DQK>(pB0, pB1, K_lds + b * SHM_K, qr, r32, hi);
    finishSM(pA0, pA1, alA, l_reg, pa0, pa1, pa2, pa3); SBAR();
    SLOAD(SO, j + 2); SBAR();
    pv_d0(o, vb0 + b2 * (int)SHM_V, pa0, pa1, pa2, pa3); partialSM(pB0, pB1, m_reg, mnB, alB, C, thr_raw);
    SWAIT(); SWRITE(b1, SE);
    RESC(alB); __syncthreads();
    SBAR(); qkt<DQK>(pA0, pA1, K_lds + b1 * SHM_K, qr, r32, hi);
    finishSM(pB0, pB1, alB, l_reg, pa0, pa1, pa2, pa3); SBAR();
    if (j + 3 < NT) SLOAD(SE, j + 3); SBAR();
    pv_d0(o, vb0 + b * (int)SHM_V, pa0, pa1, pa2, pa3); partialSM(pA0, pA1, m_reg, mnA, alA, C, thr_raw);
    SWAIT(); SWRITE(b2, SO);
    RESC(alA); __syncthreads();
    b = b2;
  }
  { const int b2 = (b == 0) ? 2 : b - 1;
    SBAR(); qkt<DQK>(pB0, pB1, K_lds + b * SHM_K, qr, r32, hi);
    finishSM(pA0, pA1, alA, l_reg, pa0, pa1, pa2, pa3); SBAR();
    pv_d0(o, vb0 + b2 * (int)SHM_V, pa0, pa1, pa2, pa3); partialSM(pB0, pB1, m_reg, mnB, alB, C, thr_raw);
    RESC(alB);
    finishSM(pB0, pB1, alB, l_reg, pa0, pa1, pa2, pa3); SBAR();
    pv_d0(o, vb0 + b * (int)SHM_V, pa0, pa1, pa2, pa3); }
  if (hi == 0) li_l[r32] = l_reg; asm volatile("s_waitcnt lgkmcnt(0)" ::: "memory");
#pragma unroll
  for (int r = 0; r < 16; ++r) rli[r] = 1.f / li_l[crow(r, hi)];
  __syncthreads();
#undef SLOAD
#undef SWRITE
#undef SWAIT
#undef RESC
}

constexpr int D2_KT = 64 * 144, D2_KBUF = 2 * D2_KT, D2_OFF_K = 2 * (int)SHM_V, D2_OFF_Q = D2_OFF_K + 2 * D2_KBUF, D2_QM = 256 * 144, D2_OFF_WS = D2_OFF_Q + 2 * D2_QM;
static_assert(D2_OFF_WS + 8 * 512 <= LDS_PHASE, "diff2 lds");
DI void qkt_l(f32x16& p0, f32x16& p1, const char* Ks, const char* Qrow, int r32, int hi) {
  p0 = f32x16{}; p1 = f32x16{};
#pragma unroll
  for (int d0 = 0; d0 < 4; ++d0) { const int cb = (d0 * 16 + hi * 8) * 2;
    const bf16x8 qf = *reinterpret_cast<const bf16x8*>(Qrow + cb);
    const bf16x8 b0 = *reinterpret_cast<const bf16x8*>(Ks + r32 * 144 + cb);
    const bf16x8 b1 = *reinterpret_cast<const bf16x8*>(Ks + (32 + r32) * 144 + cb);
    p0 = __builtin_amdgcn_mfma_f32_32x32x16_bf16(b0, qf, p0, 0, 0, 0);
    p1 = __builtin_amdgcn_mfma_f32_32x32x16_bf16(b1, qf, p1, 0, 0, 0); }
}
template <int KS> DI void pv2_step(f32x16* o1, f32x16* o2, int vb, bf16x8 pa, bf16x8 pb) {
  const s16x4 l0 = tr_read<v_rd_off(0, KS, 0)>(vb), h0 = tr_read<v_rd_off(0, KS, 1)>(vb), l1 = tr_read<v_rd_off(1, KS, 0)>(vb), h1 = tr_read<v_rd_off(1, KS, 1)>(vb);
  const s16x4 l2 = tr_read<v_rd_off(2, KS, 0)>(vb), h2 = tr_read<v_rd_off(2, KS, 1)>(vb), l3 = tr_read<v_rd_off(3, KS, 0)>(vb), h3 = tr_read<v_rd_off(3, KS, 1)>(vb);
  asm volatile("s_waitcnt lgkmcnt(0)" ::: "memory"); SBAR();
#define PK(L, H) (bf16x8){L[0], L[1], L[2], L[3], H[0], H[1], H[2], H[3]}
  const bf16x8 v0 = PK(l0, h0), v1 = PK(l1, h1), v2 = PK(l2, h2), v3 = PK(l3, h3);
#undef PK
  o1[0] = __builtin_amdgcn_mfma_f32_32x32x16_bf16(pa, v0, o1[0], 0, 0, 0); o2[0] = __builtin_amdgcn_mfma_f32_32x32x16_bf16(pb, v0, o2[0], 0, 0, 0);
  o1[1] = __builtin_amdgcn_mfma_f32_32x32x16_bf16(pa, v1, o1[1], 0, 0, 0); o2[1] = __builtin_amdgcn_mfma_f32_32x32x16_bf16(pb, v1, o2[1], 0, 0, 0);
  o1[2] = __builtin_amdgcn_mfma_f32_32x32x16_bf16(pa, v2, o1[2], 0, 0, 0); o2[2] = __builtin_amdgcn_mfma_f32_32x32x16_bf16(pb, v2, o2[2], 0, 0, 0);
  o1[3] = __builtin_amdgcn_mfma_f32_32x32x16_bf16(pa, v3, o1[3], 0, 0, 0); o2[3] = __builtin_amdgcn_mfma_f32_32x32x16_bf16(pb, v3, o2[3], 0, 0, 0);
}
DI void attn_diff2(const bf16_t* __restrict__ Qg, int ldq, const bf16_t* __restrict__ Kg, int ldk, const bf16_t* __restrict__ Vg, int ldv, int seq, float scale,
                   char* lds, f32x16 (&o1)[4], f32x16 (&o2)[4], float (&rli1)[16], float (&rli2)[16]) {
  const float C = scale * 1.4426950408889634f, thr_raw = THR / scale;
  const int tid = tidx(), wid = tid >> 6, lane = tid & 63, r32 = lane & 31, hi = lane >> 5;
  char* V_lds = lds; char* K_lds = lds + D2_OFF_K; char* Q_lds = lds + D2_OFF_Q;
  float* wsl = (float*)(lds + D2_OFF_WS) + wid * 128; float* li1 = wsl; float* li2 = wsl + 32; float* al_l = wsl + 64;
#pragma unroll
  for (int i = 0; i < 8; ++i) { const int ch = tid + 512 * i, row = ch >> 4, cc = ch & 15;
    *(bf16x8*)(Q_lds + (cc >> 3) * D2_QM + row * 144 + (cc & 7) * 16) = ld8(Qg + (long)row * ldq + cc * 8); }
  const char* Q1row = Q_lds + (wid * 32 + r32) * 144; const char* Q2row = Q1row + D2_QM;
  const int sr = tid >> 4, sc = (tid & 15) * 8, vst0 = v_st(sr, sc), vst1 = v_st(32 + sr, sc);
  const int vb0 = (int)(uintptr_t)V_lds + v_rd_base(lane);
  const int kr = tid >> 3, kc = tid & 7, kw = kr * 144 + kc * 16;
  const bf16_t* kp = Kg + (long)kr * ldk + kc * 8;
  bf16x8 sv0, sv1, sk0, sk1;
#define SLOAD2(t) do { sv0 = ld8(&Vg[(long)((t) * 64 + sr) * ldv + sc]); sv1 = ld8(&Vg[(long)((t) * 64 + 32 + sr) * ldv + sc]); \
    sk0 = ld8(kp + (long)(t) * 64 * ldk); sk1 = ld8(kp + (long)(t) * 64 * ldk + 64); } while (0)
#define SWRITE2(b) do { *(bf16x8*)(V_lds + (b) * SHM_V + vst0) = sv0; *(bf16x8*)(V_lds + (b) * SHM_V + vst1) = sv1; \
    *(bf16x8*)(K_lds + (b) * D2_KBUF + kw) = sk0; *(bf16x8*)(K_lds + (b) * D2_KBUF + D2_KT + kw) = sk1; } while (0)
#define RESC2(o, a) do { if (__any((a) < 1.f)) { if (hi == 0) al_l[r32] = (a); asm volatile("s_waitcnt lgkmcnt(0)" ::: "memory"); \
    _Pragma("unroll") for (int d = 0; d < 4; ++d) _Pragma("unroll") for (int r = 0; r < 16; ++r) o[d][r] *= al_l[crow(r, hi)]; } } while (0)
  float m1 = -1e30f, m2 = -1e30f, l1 = 0.f, l2 = 0.f;
#pragma unroll
  for (int d = 0; d < 4; ++d) { o1[d] = f32x16{}; o2[d] = f32x16{}; }
  const int NT = seq / KVBLK;
  SLOAD2(0); asm volatile("s_waitcnt vmcnt(0)" ::: "memory"); SWRITE2(0); __syncthreads();
  if (1 < NT) SLOAD2(1);
  for (int t = 0; t < NT; ++t) {
    const int cur = t & 1;
    f32x16 p0, p1, q0, q1; float mn, al1, al2; bf16x8 a0, a1, a2, a3, b0, b1, b2, b3;
    qkt_l(p0, p1, K_lds + cur * D2_KBUF, Q1row, r32, hi);
    qkt_l(q0, q1, K_lds + cur * D2_KBUF + D2_KT, Q2row, r32, hi);
    partialSM(p0, p1, m1, mn, al1, C, thr_raw); finishSM(p0, p1, al1, l1, a0, a1, a2, a3);
    partialSM(q0, q1, m2, mn, al2, C, thr_raw); finishSM(q0, q1, al2, l2, b0, b1, b2, b3);
    RESC2(o1, al1); RESC2(o2, al2);
    if (t + 1 < NT) { SWRITE2(cur ^ 1); if (t + 2 < NT) SLOAD2(t + 2); }
    const int vb = vb0 + cur * (int)SHM_V;
    pv2_step<0>(o1, o2, vb, a0, b0); pv2_step<1>(o1, o2, vb, a1, b1); pv2_step<2>(o1, o2, vb, a2, b2); pv2_step<3>(o1, o2, vb, a3, b3);
    __syncthreads();
  }
  if (hi == 0) { li1[r32] = l1; li2[r32] = l2; } asm volatile("s_waitcnt lgkmcnt(0)" ::: "memory");
#pragma unroll
  for (int r = 0; r < 16; ++r) { rli1[r] = 1.f / li1[crow(r, hi)]; rli2[r] = 1.f / li2[crow(r, hi)]; }
  __syncthreads();
#undef SLOAD2
#undef SWRITE2
#undef RESC2
}
}

DI f32x4 mm16(const bf16_t* A, int lda, const bf16_t* Bt, int ldb, int K, f32x4 acc, int lane) {
  const bf16_t* ap = A + (lane & 15) * lda + 8 * (lane >> 4);
  const bf16_t* bp = Bt + (lane & 15) * ldb + 8 * (lane >> 4);
  for (int k0 = 0; k0 < K; k0 += 32) {
    const bf16x8 a = *(const bf16x8*)(ap + k0), b = *(const bf16x8*)(bp + k0);
    acc = __builtin_amdgcn_mfma_f32_16x16x32_bf16(a, b, acc, 0, 0, 0);
  }
  return acc;
}
constexpr int LP = 72;

DI int chunk_row0(int tc) { return tc * 64; }
DI int scan_idx(int tc, int dir) { return tc < 256 ? (dir == 0 ? 4 + tc : 4 + (255 - tc)) : (dir == 0 ? tc - 256 : 3 - (tc - 256)); }
DI void stream_bounds(int row0, int& lo, int& hi) { if (row0 < TL) { lo = 0; hi = TL; } else { lo = TL; hi = T; } }

DI void sincos_d(double a, float& c, float& s) {
  const double TWO_PI = 6.283185307179586476925287;
  const double k = rint(a / TWO_PI); const double r = a - k * TWO_PI; const double r2 = r * r;
  double ss = 1.0, cc = 1.0;
#pragma unroll
  for (int n = 13; n >= 1; --n) { ss = 1.0 - r2 / (double)((2 * n) * (2 * n + 1)) * ss; cc = 1.0 - r2 / (double)((2 * n - 1) * (2 * n)) * cc; }
  s = (float)(r * ss); c = (float)cc;
}
DI void phase_setup(const Params& p, unsigned char* lds) {
  const int tid = tidx();
  float* sx = (float*)lds;
  float* red = sx + 2048;
  float* MOD = (float*)(p.ws + WS_MOD);
  for (int i = tid; i < 1024; i += 512) { sx[i] = siluf(p.in[1][i]); sx[1024 + i] = siluf(p.in[3][i]); }
  __syncthreads();
  for (int item = blockIdx.x; item < 384; item += gridDim.x) {
    const int l = item / 192, cb = item % 192, cl = tid & 31, ks = tid >> 5;
    const float* w = p.in[4] + (size_t)l * 1024 * 6144 + cb * 32 + cl;
    float a0 = 0.f, a1 = 0.f;
    for (int k = ks * 64; k < ks * 64 + 64; ++k) { const float wv = w[(size_t)k * 6144]; a0 += sx[k] * wv; a1 += sx[1024 + k] * wv; }
    red[(0 * 16 + ks) * 32 + cl] = a0; red[(1 * 16 + ks) * 32 + cl] = a1;
    __syncthreads();
    if (tid < 64) { const int s = tid >> 5; float sum = 0.f;
      for (int q = 0; q < 16; ++q) sum += red[(s * 16 + q) * 32 + cl];
      MOD[(size_t)(l * 2 + s) * 6144 + cb * 32 + cl] = sum + p.in[5][l * 6144 + cb * 32 + cl]; }
    __syncthreads();
  }
  { float* acc = (float*)(p.ws + WS_ACC); for (int i = blockIdx.x * 512 + tid; i < 2 * TC * D; i += gridDim.x * 512) acc[i] = 0.f; }
  const int gt = blockIdx.x * 512 + tid;
  if (gt < 256 * 16) { const int pos = gt >> 4, i = gt & 15; const double inv = exp2(-(double)i / 16.0 * 13.287712379549449);
    float c, s; sincos_d((double)pos * inv, c, s); float* t = (float*)(p.ws + WS_TAB32) + gt * 2; t[0] = c; t[1] = s; }
  else if (gt < 256 * 16 + 256 * 8) { const int g2 = gt - 256 * 16; const int pos = g2 >> 3, i = g2 & 7; const double inv = exp2(-(double)i / 8.0 * 13.287712379549449);
    float c, s; sincos_d((double)pos * inv, c, s); float* t = (float*)(p.ws + WS_TAB16) + g2 * 2; t[0] = c; t[1] = s; }
  if (blockIdx.x == gridDim.x - 1 && tid < 128) {
    const int l = tid >> 6, lane = tid & 63; const float* lam = p.in[7] + l * 4 * 64;
    const float s1 = wave_sum(lam[lane] * lam[64 + lane]), s2 = wave_sum(lam[128 + lane] * lam[192 + lane]);
    const float lam_init = 0.8f - 0.6f * expf(-0.3f * (float)l);
    if (lane == 0) ((float*)(p.ws + WS_LAM))[l] = expf(s1) - expf(s2) + lam_init;
  }
}

DI void transpose_job(const float* __restrict__ src, int ld, int K, int nvalid, int npad, bf16_t* __restrict__ dst, unsigned char* lds, int wg0 = 0) {
  const int wave = tidx() >> 6, lane = tidx() & 63;
  float* scr = (float*)lds + wave * (64 * 33);
  if ((int)blockIdx.x < wg0) return;
  const int gw = ((int)blockIdx.x - wg0) * 8 + wave, NGW = ((int)gridDim.x - wg0) * 8;
  const int nblk = npad / 32, nitems = (K / 64) * nblk;
  for (int item = gw; item < nitems; item += NGW) {
    const int kb = item / nblk, nb = item % nblk, k0 = 64 * kb, n0 = 32 * nb;
    const int nn = n0 + (lane & 31); const bool ok = nn < nvalid;
    float tv[32];
#pragma unroll
    for (int i = 0; i < 32; ++i) { const int kk = 2 * i + (lane >> 5); tv[i] = ok ? src[(size_t)(k0 + kk) * ld + nn] : 0.f; }
#pragma unroll
    for (int i = 0; i < 32; ++i) { const int kk = 2 * i + (lane >> 5); scr[kk * 33 + (lane & 31)] = tv[i]; }
    LDS_WAIT();
    const int c = lane & 7;
#pragma unroll
    for (int j = 0; j < 4; ++j) { const int n = (lane >> 3) + 8 * j; const float* s = scr + (8 * c) * 33 + n;
      u32x4 o; o.x = cvtpk(s[0 * 33], s[1 * 33]); o.y = cvtpk(s[2 * 33], s[3 * 33]); o.z = cvtpk(s[4 * 33], s[5 * 33]); o.w = cvtpk(s[6 * 33], s[7 * 33]);
      *(u32x4*)(dst + (size_t)(n0 + n) * K + k0 + 8 * c) = o; }
    LDS_WAIT();
  }
}
DI void convert_layer_start(const Params& p, int l, unsigned char* lds) {
  const float* w_in = p.in[6] + (size_t)l * 1024 * 5056;
  bf16_t* wa = (bf16_t*)(p.ws + WS_WA);
  transpose_job(w_in + 1536, 5056, 1024, 1552, NB_B, (bf16_t*)((unsigned char*)wa + WA_B), lds);
}
DI void convert_layer_rest(const Params& p, int l, unsigned char* lds, int wg0) {
  const float* w_in = p.in[6] + (size_t)l * 1024 * 5056;
  bf16_t* wa = (bf16_t*)(p.ws + WS_WA); unsigned char* wb = p.ws + WS_WB;
  transpose_job(w_in + 3760, 5056, 1024, 1296, NB_D, (bf16_t*)((unsigned char*)wa + WA_D), lds, wg0);
  transpose_job(w_in + 0, 5056, 1024, 1536, 1536, (bf16_t*)((unsigned char*)wa + WA_AC), lds, wg0);
  transpose_job(w_in + 3088, 5056, 1024, 672, 768, (bf16_t*)((unsigned char*)wa + WA_AC) + (size_t)1536 * 1024, lds, wg0);
  transpose_job(p.in[15] + (size_t)l * 384 * 384, 384, 384, 384, 512, (bf16_t*)(wb + WB_UQ), lds, wg0);
  transpose_job(p.in[16] + (size_t)l * 256 * 768, 768, 256, 768, 768, (bf16_t*)(wb + WB_UKV), lds, wg0);
  for (int k = 0; k < 4; ++k) transpose_job(p.in[25] + ((size_t)l * 4 + k) * 512 * 1024, 1024, 512, 1024, 1024, (bf16_t*)(wb + WB_BR) + (size_t)k * 1024 * 512, lds, wg0);
  transpose_job(p.in[26] + (size_t)l * 1024 * 1024, 1024, 1024, 1024, 1024, (bf16_t*)(wb + WB_WO), lds, wg0);
}

DI void ln_stats(const f32x4 (&v)[4], float& mean, float& rstd) {
  float s = 0.f;
#pragma unroll
  for (int j = 0; j < 4; ++j) s += (v[j].x + v[j].y) + (v[j].z + v[j].w);
  mean = wave_sum(s) * (1.f / D); float s2 = 0.f;
#pragma unroll
  for (int j = 0; j < 4; ++j) { const f32x4 d = v[j] - mean; s2 += (d.x * d.x + d.y * d.y) + (d.z * d.z + d.w * d.w); }
  rstd = 1.f / sqrtf(wave_sum(s2) * (1.f / D) + EPS);
}
DI void phase_ln_mod(const float* xl, const float* xc, const float* mod_l, const float* mod_c, int sh_off, int sc_off, bf16_t* H, int nrows) {
  const int wave = tidx() >> 6, lane = tidx() & 63, stride = gridDim.x * 8;
  auto load_row = [&](int row, f32x4 (&v)[4]) { const float* xr = row >= TL ? xc + (size_t)(row - TL) * D : xl + (size_t)row * D;
#pragma unroll
    for (int j = 0; j < 4; ++j) v[j] = *(const f32x4*)(xr + 4 * lane + 256 * j); };
  int row = blockIdx.x * 8 + wave; f32x4 v[4];
  if (row < nrows) load_row(row, v);
  while (row < nrows) {
    const int nrow = row + stride; f32x4 vn[4];
    if (nrow < nrows) load_row(nrow, vn);
    const float* mod = row >= TL ? mod_c : mod_l;
    f32x4 shv[4], scv[4];
#pragma unroll
    for (int j = 0; j < 4; ++j) { const int c = 4 * lane + 256 * j; shv[j] = *(const f32x4*)(mod + sh_off + c); scv[j] = *(const f32x4*)(mod + sc_off + c); }
    float mean, rstd; ln_stats(v, mean, rstd);
#pragma unroll
    for (int j = 0; j < 4; ++j) { const int c = 4 * lane + 256 * j;
      const f32x4 y = (v[j] - mean) * rstd * (scv[j] + 1.f) + shv[j]; u32x2 w; w.x = cvtpk(y.x, y.y); w.y = cvtpk(y.z, y.w);
      *(u32x2*)(H + (size_t)row * D + c) = w; }
#pragma unroll
    for (int j = 0; j < 4; ++j) v[j] = vn[j];
    row = nrow;
  }
}
DI void phase_ln_affine_mod(float* xl, float* xc, const float* g, const float* b, const float* mod_l, const float* mod_c, int sh_off, int sc_off, bf16_t* H, int nrows,
                            const float* cx = nullptr, const float* cacc = nullptr, const float* cg = nullptr, const float* cb = nullptr) {
  const int wave = tidx() >> 6, lane = tidx() & 63, stride = gridDim.x * 8;
  auto load_row = [&](int row, f32x4 (&v)[4]) {
    if (row >= TL && cacc) {
#pragma unroll
      for (int j = 0; j < 4; ++j) { const int c = 4 * lane + 256 * j; const size_t o = (size_t)(row - TL) * D + c;
        const f32x4 bb = cb ? *(const f32x4*)(cb + c) : (f32x4){0.f, 0.f, 0.f, 0.f};
        v[j] = *(const f32x4*)(cx + o) * ALPHA + *(const f32x4*)(cg + c) * (*(const f32x4*)(cacc + o) + bb); }
    } else { const float* xr = row >= TL ? xc + (size_t)(row - TL) * D : xl + (size_t)row * D;
#pragma unroll
      for (int j = 0; j < 4; ++j) v[j] = *(const f32x4*)(xr + 4 * lane + 256 * j); } };
  int row = blockIdx.x * 8 + wave; f32x4 v[4];
  if (row < nrows) load_row(row, v);
  while (row < nrows) {
    const int nrow = row + stride; f32x4 vn[4];
    if (nrow < nrows) load_row(nrow, vn);
    const bool isc = row >= TL; float* xr = isc ? xc + (size_t)(row - TL) * D : xl + (size_t)row * D; const float* mod = isc ? mod_c : mod_l;
    f32x4 gvv[4], bvv[4], shv[4], scv[4];
#pragma unroll
    for (int j = 0; j < 4; ++j) { const int c = 4 * lane + 256 * j; gvv[j] = *(const f32x4*)(g + c); bvv[j] = *(const f32x4*)(b + c);
      if (H) { shv[j] = *(const f32x4*)(mod + sh_off + c); scv[j] = *(const f32x4*)(mod + sc_off + c); } }
    float mean, rstd; ln_stats(v, mean, rstd);
#pragma unroll
    for (int j = 0; j < 4; ++j) { const int c = 4 * lane + 256 * j; v[j] = (v[j] - mean) * rstd * gvv[j] + bvv[j]; *(f32x4*)(xr + c) = v[j]; }
    if (H) {
      ln_stats(v, mean, rstd);
#pragma unroll
      for (int j = 0; j < 4; ++j) { const int c = 4 * lane + 256 * j;
        const f32x4 y = (v[j] - mean) * rstd * (scv[j] + 1.f) + shv[j]; u32x2 w; w.x = cvtpk(y.x, y.y); w.y = cvtpk(y.z, y.w);
        *(u32x2*)(H + (size_t)row * D + c) = w; }
    }
#pragma unroll
    for (int j = 0; j < 4; ++j) v[j] = vn[j];
    row = nrow;
  }
}

DI void phase_attn_prep(const Params& p, int l) {
  const int wave = tidx() >> 6, lane = tidx() & 63;
  bf16_t* PAC = (bf16_t*)(p.ws + WS_BIG + BG_PAC);
  const float* tab32 = (const float*)(p.ws + WS_TAB32); const float* tab16 = (const float*)(p.ws + WS_TAB16);
  const float* qn = p.in[13] + l * 384; const float* kvn = p.in[14] + l * 256;
  for (int row = blockIdx.x * 8 + wave; row < T; row += gridDim.x * 8) {
    bf16_t* pr = PAC + (size_t)row * NB_AC;
    if (row < TL) {
      const int prow = row >> 6, pcol = row & 63;
#pragma unroll
      for (int it = 0; it < 8; ++it) { const int pi = it * 64 + lane;
        const int unit = pi >> 5, q = pi & 31, sec = q >> 4, i = q & 15;
        const int e0 = unit * 64 + sec * 32 + i; const int pos = sec ? pcol : prow;
        const float cs = tab32[(pos * 16 + i) * 2], sn = tab32[(pos * 16 + i) * 2 + 1];
        const float x1 = bf2f(pr[e0]), x2 = bf2f(pr[e0 + 16]);
        pr[e0] = f2bf(x1 * cs - x2 * sn); pr[e0 + 16] = f2bf(x2 * cs + x1 * sn); }
      if (lane < 16) { const int sec = lane >> 3, i = lane & 7; const int e0 = 2176 + sec * 16 + i; const int pos = sec ? pcol : prow;
        const float cs = tab16[(pos * 8 + i) * 2], sn = tab16[(pos * 8 + i) * 2 + 1];
        const float x1 = bf2f(pr[e0]), x2 = bf2f(pr[e0 + 8]);
        pr[e0] = f2bf(x1 * cs - x2 * sn); pr[e0 + 8] = f2bf(x2 * cs + x1 * sn); }
    }
    { float v[6]; float ss = 0.f;
#pragma unroll
      for (int j = 0; j < 6; ++j) { v[j] = bf2f(pr[1536 + lane + 64 * j]); ss += v[j] * v[j]; }
      const float rs = 1.f / sqrtf(wave_sum(ss) * (1.f / 384.f) + EPS);
#pragma unroll
      for (int j = 0; j < 6; ++j) pr[1536 + lane + 64 * j] = f2bf(v[j] * rs * qn[lane + 64 * j]); }
    { float v[4]; float ss = 0.f;
#pragma unroll
      for (int j = 0; j < 4; ++j) { v[j] = bf2f(pr[1920 + lane + 64 * j]); ss += v[j] * v[j]; }
      const float rs = 1.f / sqrtf(wave_sum(ss) * (1.f / 256.f) + EPS);
#pragma unroll
      for (int j = 0; j < 4; ++j) pr[1920 + lane + 64 * j] = f2bf(v[j] * rs * kvn[lane + 64 * j]); }
  }
}
DI void phase_qup_rope(const Params& p) {
  const int wave = tidx() >> 6, lane = tidx() & 63;
  bf16_t* QUP = (bf16_t*)(p.ws + WS_BIG + BG_QUP); const float* tab16 = (const float*)(p.ws + WS_TAB16);
  for (int row = blockIdx.x * 8 + wave; row < TL; row += gridDim.x * 8) {
    const int prow = row >> 6, pcol = row & 63; bf16_t* pr = QUP + (size_t)row * 384;
    const int h = lane >> 4, q = lane & 15, sec = q >> 3, i = q & 7; const int e0 = h * 96 + 64 + sec * 16 + i; const int pos = sec ? pcol : prow;
    const float cs = tab16[(pos * 8 + i) * 2], sn = tab16[(pos * 8 + i) * 2 + 1];
    const float x1 = bf2f(pr[e0]), x2 = bf2f(pr[e0 + 8]);
    pr[e0] = f2bf(x1 * cs - x2 * sn); pr[e0 + 8] = f2bf(x2 * cs + x1 * sn);
  }
}

DI void attn_item_diff(const Params& p, int l, int q0, int h, int key0, int nkeys, char* lds) {
  const bf16_t* PAC = (const bf16_t*)(p.ws + WS_BIG + BG_PAC);
  bf16_t* OUT = (bf16_t*)(p.ws + WS_BR);
  const int tid = tidx(), wid = tid >> 6, lane = tid & 63, r32 = lane & 31, hi = lane >> 5;
  const float lam = ((const float*)(p.ws + WS_LAM))[l]; const float lam_init = 0.8f - 0.6f * expf(-0.3f * (float)l);
  f32x16 o1[4], o2[4]; float rli1[16], rli2[16];
  att::attn_diff2(PAC + (size_t)q0 * NB_AC + h * 128, NB_AC, PAC + (size_t)key0 * NB_AC + 512 + h * 128, NB_AC, PAC + (size_t)key0 * NB_AC + 1024 + h * 128, NB_AC,
                  nkeys, 0.125f, lds, o1, o2, rli1, rli2);
  const float* sw = p.in[8] + l * 128; const float og = 1.f - lam_init;
  float swv[4];
#pragma unroll
  for (int d0 = 0; d0 < 4; ++d0) swv[d0] = sw[d0 * 32 + r32] * og;
#pragma unroll
  for (int r = 0; r < 16; ++r) { float ss = 0.f; const float c1 = rli1[r], c2 = lam * rli2[r];
#pragma unroll
    for (int d0 = 0; d0 < 4; ++d0) { const float v = o1[d0][r] * c1 - o2[d0][r] * c2; o1[d0][r] = v; ss += v * v; }
#pragma unroll
    for (int off = 1; off < 32; off <<= 1) ss += __shfl_xor(ss, off);
    const float rs = 1.f / sqrtf(ss * (1.f / 128.f) + EPS);
    bf16_t* orow = OUT + (size_t)(q0 + wid * 32 + att::crow(r, hi)) * 512 + h * 128 + r32;
#pragma unroll
    for (int d0 = 0; d0 < 4; ++d0) orow[d0 * 32] = f2bf(o1[d0][r] * rs * swv[d0]); }
}
DI void attn_item_mla(const Params& p, int q0, int h, int key0, int nkeys, char* lds) {
  const bf16_t* PAC = (const bf16_t*)(p.ws + WS_BIG + BG_PAC);
  const bf16_t* QUP = (const bf16_t*)(p.ws + WS_BIG + BG_QUP); const bf16_t* KVUP = (const bf16_t*)(p.ws + WS_BIG + BG_KVUP);
  bf16_t* OUT = (bf16_t*)(p.ws + WS_BR) + (size_t)2 * T * 512;
  const int tid = tidx(), wid = tid >> 6, lane = tid & 63, r32 = lane & 31, hi = lane >> 5;
  f32x16 o[4]; float rli[16];
  if (q0 < TL) {
    bf16_t* QW = (bf16_t*)(p.ws + WS_BIG + BG_QUP); const float* tab16 = (const float*)(p.ws + WS_TAB16);
    bf16_t qa[8], qb[8];
#pragma unroll
    for (int k = 0; k < 8; ++k) { const int u = tid + 512 * k, row = q0 + (u >> 4), q = u & 15, sec = q >> 3, i = q & 7;
      const bf16_t* pr = QW + (size_t)row * 384 + h * 96 + 64 + sec * 16 + i; qa[k] = pr[0]; qb[k] = pr[8]; }
#pragma unroll
    for (int k = 0; k < 8; ++k) { const int u = tid + 512 * k, row = q0 + (u >> 4), q = u & 15, sec = q >> 3, i = q & 7;
      const int prow = row >> 6, pcol = row & 63, pos = sec ? pcol : prow; bf16_t* pr = QW + (size_t)row * 384 + h * 96 + 64 + sec * 16 + i;
      const float cs = tab16[(pos * 8 + i) * 2], sn = tab16[(pos * 8 + i) * 2 + 1];
      const float x1 = bf2f(qa[k]), x2 = bf2f(qb[k]);
      pr[0] = f2bf(x1 * cs - x2 * sn); pr[8] = f2bf(x2 * cs + x1 * sn); }
    __syncthreads();
  }
  att::attn_body<96>(QUP + (size_t)q0 * 384 + h * 96, 384, KVUP + (size_t)key0 * 768 + h * 192, 768, PAC + (size_t)key0 * NB_AC + 2176, NB_AC,
                     KVUP + (size_t)key0 * 768 + h * 192 + 64, 768, nkeys, 0.10206207261596575f, lds, o, rli);
#pragma unroll
  for (int r = 0; r < 16; ++r) { bf16_t* orow = OUT + (size_t)(q0 + wid * 32 + att::crow(r, hi)) * 512 + h * 128 + r32;
#pragma unroll
    for (int d0 = 0; d0 < 4; ++d0) orow[d0 * 32] = f2bf(o[d0][r] * rli[r]); }
}
DI void phase_attention(const Params& p, int l, char* lds) {
  const int c = blockIdx.x, G = gridDim.x;
  for (int it = c; it < 256; it += G) attn_item_diff(p, l, (it >> 2) * 256, it & 3, 0, T, lds);
  for (int it = c; it < 256; it += G) attn_item_mla(p, (it >> 2) * 256, it & 3, 0, T, lds);
  if (l == 0) {
    for (int it = c; it < 4; it += G) attn_item_mla(p, TL, it, TL, TC, lds);
  }
}

DI float log_sigmoid(float x) { return fminf(x, 0.f) - log1pf(__expf(-fabsf(x))); }
DI float wave_scan_sum(float v, int lane, int dir) {
#pragma unroll
  for (int o = 1; o < 64; o <<= 1) { const float t = dir ? __shfl_down(v, o) : __shfl_up(v, o); const bool ok = dir ? (lane + o < 64) : (lane >= o); v += ok ? t : 0.f; }
  return v;
}
DI float wave_scan_max(float v, int lane, int dir) {
#pragma unroll
  for (int o = 1; o < 64; o <<= 1) { const float t = dir ? __shfl_down(v, o) : __shfl_up(v, o); const bool ok = dir ? (lane + o < 64) : (lane >= o); v = ok ? fmaxf(v, t) : v; }
  return v;
}
template <int NR, class F>
DI void conv_tile(const bf16_t* P, int ldp, int row0, int lo, int hi, const float* cw, int cw_ld, const float* cb, int gcol, int r0, int  , F&& out) {
  float w[5];
#pragma unroll
  for (int t = 0; t < 5; ++t) w[t] = cw[t * cw_ld];
  const float b = cb[0];
  float x[NR + 4];
#pragma unroll
  for (int i = 0; i < NR + 4; ++i) { const int row = row0 + r0 - 2 + i; const int rc = row < lo ? lo : (row >= hi ? hi - 1 : row);
    const float v = bf2f(P[(size_t)rc * ldp + gcol]); x[i] = (row >= lo && row < hi) ? v : 0.f; }
#pragma unroll
  for (int i = 0; i < NR; ++i) { const float y = b + w[0] * x[i] + w[1] * x[i + 1] + w[2] * x[i + 2] + w[3] * x[i + 3] + w[4] * x[i + 4]; out(r0 + i, siluf(y)); }
}
DI void phase_ml_s1(const Params& p, int l, unsigned char* lds) {
  const int tid = tidx(), wave = tid >> 6, lane = tid & 63;
  const bf16_t* PB = (const bf16_t*)(p.ws + WS_BIG + BG_PB);
  bf16_t* UC = (bf16_t*)(p.ws + WS_BIG + BG_UC); float* MSC = (float*)(p.ws + WS_BIG + BG_MSC);
  bf16_t* Vt = (bf16_t*)lds;
  bf16_t* Kt = Vt + 128 * LP;
  bf16_t* Kts = Kt + 64 * LP;
  float* wsv = (float*)(Kts + 64 * LP);
  const float* cw = p.in[9] + (size_t)l * 5 * 512; const float* cb = p.in[10] + l * 512; const float* gb = p.in[11] + l * 16;
  for (int item = blockIdx.x; item < 4 * NCH; item += gridDim.x) {
    const int h = item & 3, tc = item >> 2, row0 = chunk_row0(tc); int lo, hi; stream_bounds(row0, lo, hi);
    __syncthreads();
    {
      const int d = tid & 63, r0 = (tid >> 6) * 8; const int gc = 256 + h * 64 + d;
      conv_tile<8>(PB, NB_B, row0, lo, hi, cw + gc, 512, cb + gc, gc, r0, 8, [&](int r, float v) { Kt[d * LP + r] = f2bf(v * 0.125f); }); }
    {
      const int j = tid >> 3, e0 = (tid & 7) * 16; const bf16_t* src = PB + (size_t)(row0 + j) * NB_B + 512 + h * 128 + e0;
      const bf16x8 a = *(const bf16x8*)src, b = *(const bf16x8*)(src + 8);
#pragma unroll
      for (int i = 0; i < 8; ++i) { Vt[(e0 + i) * LP + j] = (bf16_t)a[i]; Vt[(e0 + 8 + i) * LP + j] = (bf16_t)b[i]; } }
    if (wave < 2) { const int dir = wave; const bf16_t* gr = PB + (size_t)(row0 + lane) * NB_B + 1536;
      const float ig = bf2f(gr[(2 * dir) * 4 + h]) + gb[(2 * dir) * 4 + h];
      const float lf = log_sigmoid(bf2f(gr[(2 * dir + 1) * 4 + h]) + gb[(2 * dir + 1) * 4 + h]);
      const float g = wave_scan_sum(lf, lane, dir); const float g_end = wave_sum(lf);
      const float ls = g_end - g + ig; const float m_loc = wave_max(ls);
      wsv[dir * 64 + lane] = __expf(ls - m_loc);
      if (lane == 0) { const int ch = h * 2 + dir, s = scan_idx(tc, dir); MSC[(0 * 8 + ch) * NCH + s] = g_end; MSC[(1 * 8 + ch) * NCH + s] = m_loc; } }
    __syncthreads();
    for (int dir = 0; dir < 2; ++dir) {
      const int ch = h * 2 + dir, s = scan_idx(tc, dir); bf16_t* urow = UC + ((size_t)ch * NCH + s) * MLROW;
      { const int d = tid >> 3, j0 = (tid & 7) * 8; float sum = 0.f;
#pragma unroll
        for (int i = 0; i < 8; ++i) { const bf16_t v = f2bf(bf2f(Kt[d * LP + j0 + i]) * wsv[dir * 64 + j0 + i]); Kts[d * LP + j0 + i] = v; sum += bf2f(v); }
        sum += __shfl_xor(sum, 1); sum += __shfl_xor(sum, 2); sum += __shfl_xor(sum, 4);
        if ((tid & 7) == 0) urow[8192 + d] = f2bf(sum); }
      __syncthreads();
#pragma unroll
      for (int dt = 0; dt < 4; ++dt) { f32x4 acc = {0.f, 0.f, 0.f, 0.f};
        acc = mm16(Vt + wave * 16 * LP, LP, Kts + dt * 16 * LP, LP, 64, acc, lane);
#pragma unroll
        for (int r = 0; r < 4; ++r) urow[(wave * 16 + (lane >> 4) * 4 + r) * 64 + dt * 16 + (lane & 15)] = f2bf(acc[r]); }
      __syncthreads();
    }
  }
}
DI void phase_ml_s2(const Params& p) {
  const bf16_t* __restrict__ UC = (const bf16_t*)(p.ws + WS_BIG + BG_UC); bf16_t* __restrict__ SC = (bf16_t*)(p.ws + WS_BIG + BG_SC);
  float* MSC = (float*)(p.ws + WS_BIG + BG_MSC);
  const int npairs = 8 * (MLROW / 2);
  for (int e = blockIdx.x * 512 + tidx(); e < npairs; e += gridDim.x * 512) {
    const int ch = e / (MLROW / 2), off = (e % (MLROW / 2)) * 2;
    const float* GE = MSC + (0 * 8 + ch) * NCH; const float* ML = MSC + (1 * 8 + ch) * NCH; float* MS = MSC + (2 * 8 + ch) * NCH;
    float m = 0.f, c0 = 0.f, c1 = 0.f;
    for (int s0 = 0; s0 < NCH; s0 += 26) {
      unsigned u[26];
#pragma unroll
      for (int q = 0; q < 26; ++q) u[q] = *(const unsigned*)(UC + ((size_t)ch * NCH + s0 + q) * MLROW + off);
      float gev[26], mlv[26];
#pragma unroll
      for (int q = 0; q < 26; ++q) { gev[q] = GE[s0 + q]; mlv[q] = ML[s0 + q]; }
#pragma unroll
      for (int q = 0; q < 26; ++q) { const int s = s0 + q;
        *(unsigned*)(SC + ((size_t)ch * NCH + s) * MLROW + off) = cvtpk(c0, c1);
        if (off == 0) MS[s] = m;
        const float ge = gev[q], ml = mlv[q]; const float mn = fmaxf(ge + m, ml); const float dec = __expf(ge + m - mn), sc = __expf(ml - mn);
        c0 = dec * c0 + sc * bflo(u[q]); c1 = dec * c1 + sc * bfhi(u[q]); m = mn; }
    }
  }
}
DI void phase_ml_s3(const Params& p, int l, unsigned char* lds, int ntc) {
  const int tid = tidx(), wave = tid >> 6, lane = tid & 63;
  const bf16_t* PB = (const bf16_t*)(p.ws + WS_BIG + BG_PB);
  const bf16_t* SC = (const bf16_t*)(p.ws + WS_BIG + BG_SC); const float* MSC = (const float*)(p.ws + WS_BIG + BG_MSC);
  bf16_t* OUT = (bf16_t*)(p.ws + WS_BR) + (size_t)1 * T * 512;
  bf16_t* Q = (bf16_t*)lds;
  bf16_t* Kk = Q + 64 * LP;
  bf16_t* W = Kk + 64 * LP;
  bf16_t* Vt = W + 64 * LP;
  bf16_t* Ct = Vt + 128 * LP;
  float* fa = (float*)(Ct + 128 * LP);
  float* gS = fa;
  float* bS = fa + 128;
  float* mjS = fa + 256;
  float* aiS = fa + 384;
  float* rdS = fa + 448;
  float* nS = fa + 512;
  float* ssS = fa + 576;
  const float* cw = p.in[9] + (size_t)l * 5 * 512; const float* cb = p.in[10] + l * 512; const float* gb = p.in[11] + l * 16;
  const float* nw = p.in[12] + l * 512;
  const int js = wave >> 1, eh = wave & 1;
  for (int item = blockIdx.x; item < 4 * ntc; item += gridDim.x) {
    const int h = item & 3, tc = item >> 2, row0 = chunk_row0(tc); int lo, hi; stream_bounds(row0, lo, hi);
    __syncthreads();
    { const int c = tid & 127, r0 = (tid >> 7) * 16; const int gc = (c < 64) ? h * 64 + c : 256 + h * 64 + (c - 64);
      bf16_t* dst = (c < 64) ? Q + c : Kk + (c - 64); const float scl = (c < 64) ? 1.f : 0.125f;
      conv_tile<16>(PB, NB_B, row0, lo, hi, cw + gc, 512, cb + gc, gc, r0, 16, [&](int r, float v) { dst[r * LP] = f2bf(v * scl); }); }
    { const int j = tid >> 3, e0 = (tid & 7) * 16; const bf16_t* src = PB + (size_t)(row0 + j) * NB_B + 512 + h * 128 + e0;
      const bf16x8 a = *(const bf16x8*)src, b = *(const bf16x8*)(src + 8);
#pragma unroll
      for (int i = 0; i < 8; ++i) { Vt[(e0 + i) * LP + j] = (bf16_t)a[i]; Vt[(e0 + 8 + i) * LP + j] = (bf16_t)b[i]; } }
    float mdir[2];
#pragma unroll
    for (int dir = 0; dir < 2; ++dir) mdir[dir] = MSC[(2 * 8 + h * 2 + dir) * NCH + scan_idx(tc, dir)];
    if (wave < 2) { const int dir = wave; const bf16_t* gr = PB + (size_t)(row0 + lane) * NB_B + 1536;
      const float ig = bf2f(gr[(2 * dir) * 4 + h]) + gb[(2 * dir) * 4 + h];
      const float lf = log_sigmoid(bf2f(gr[(2 * dir + 1) * 4 + h]) + gb[(2 * dir + 1) * 4 + h]);
      const float g = wave_scan_sum(lf, lane, dir); const float b = ig - g; const float bm = wave_scan_max(b, lane, dir);
      gS[dir * 64 + lane] = g; bS[dir * 64 + lane] = b; mjS[dir * 64 + lane] = g + fmaxf(dir ? mdir[1] : mdir[0], bm); }
    f32x4 hs[4];
#pragma unroll
    for (int t = 0; t < 4; ++t) hs[t] = (f32x4){0.f, 0.f, 0.f, 0.f};
#pragma unroll
    for (int dir = 0; dir < 2; ++dir) {
      const int ch = h * 2 + dir, s = scan_idx(tc, dir); const bf16_t* srow = SC + ((size_t)ch * NCH + s) * MLROW; const float m = mdir[dir];
      __syncthreads();
      for (int i = tid; i < 1024; i += 512) { const int e = i >> 3, d0 = (i & 7) * 8; *(bf16x8*)(Ct + e * LP + d0) = *(const bf16x8*)(srow + e * 64 + d0); }
      if (tid < 64) { nS[tid] = bf2f(srow[8192 + tid]); aiS[tid] = __expf(gS[dir * 64 + tid] + m - mjS[dir * 64 + tid]); }
#pragma unroll
      for (int tt = 0; tt < 2; ++tt) { const int it = eh * 2 + tt; f32x4 acc = {0.f, 0.f, 0.f, 0.f};
        acc = mm16(Q + js * 16 * LP, LP, Kk + it * 16 * LP, LP, 64, acc, lane);
        const int i = it * 16 + (lane & 15); const float bi = bS[dir * 64 + i];
#pragma unroll
        for (int r = 0; r < 4; ++r) { const int j = js * 16 + (lane >> 4) * 4 + r; const bool ok = dir ? (i >= j) : (i <= j);
          const float wv = ok ? __expf(gS[dir * 64 + j] + bi - mjS[dir * 64 + j]) * acc[r] : 0.f; W[j * LP + i] = f2bf(wv); } }
      __syncthreads();
      { const int j = tid >> 3, i0 = (tid & 7) * 8; float sw = 0.f, sq = 0.f;
#pragma unroll
        for (int i = 0; i < 8; ++i) { sw += bf2f(W[j * LP + i0 + i]); sq += bf2f(Q[j * LP + i0 + i]) * nS[i0 + i]; }
        sw += __shfl_xor(sw, 1); sw += __shfl_xor(sw, 2); sw += __shfl_xor(sw, 4); sq += __shfl_xor(sq, 1); sq += __shfl_xor(sq, 2); sq += __shfl_xor(sq, 4);
        if ((tid & 7) == 0) { const float den = sw + aiS[j] * sq; rdS[j] = 1.f / fmaxf(fabsf(den), __expf(-mjS[dir * 64 + j])); } }
      __syncthreads();
#pragma unroll
      for (int t = 0; t < 4; ++t) { const int et = eh * 4 + t; f32x4 a1 = {0.f, 0.f, 0.f, 0.f}, a2 = {0.f, 0.f, 0.f, 0.f};
        a1 = mm16(W + js * 16 * LP, LP, Vt + et * 16 * LP, LP, 64, a1, lane);
        a2 = mm16(Q + js * 16 * LP, LP, Ct + et * 16 * LP, LP, 64, a2, lane);
#pragma unroll
        for (int r = 0; r < 4; ++r) { const int j = js * 16 + (lane >> 4) * 4 + r; hs[t][r] += (a1[r] + aiS[j] * a2[r]) * rdS[j]; } }
    }
    { float ssq[4] = {0.f, 0.f, 0.f, 0.f};
#pragma unroll
      for (int t = 0; t < 4; ++t)
#pragma unroll
        for (int r = 0; r < 4; ++r) ssq[r] += hs[t][r] * hs[t][r];
#pragma unroll
      for (int r = 0; r < 4; ++r) { float s = ssq[r]; s += __shfl_xor(s, 1); s += __shfl_xor(s, 2); s += __shfl_xor(s, 4); s += __shfl_xor(s, 8);
        if ((lane & 15) == 0) ssS[(js * 16 + (lane >> 4) * 4 + r) * 2 + eh] = s; }
      __syncthreads();
      float nwv[4];
#pragma unroll
      for (int t = 0; t < 4; ++t) nwv[t] = nw[h * 128 + (eh * 4 + t) * 16 + (lane & 15)];
      bf16_t ogr[4][4];
#pragma unroll
      for (int r = 0; r < 4; ++r)
#pragma unroll
        for (int t = 0; t < 4; ++t) ogr[r][t] = PB[(size_t)(row0 + js * 16 + (lane >> 4) * 4 + r) * NB_B + 1024 + h * 128 + (eh * 4 + t) * 16 + (lane & 15)];
#pragma unroll
      for (int r = 0; r < 4; ++r) { const int j = js * 16 + (lane >> 4) * 4 + r; const float rs = 1.f / sqrtf((ssS[j * 2] + ssS[j * 2 + 1]) * (1.f / 128.f) + EPS);
        const size_t row = (size_t)(row0 + j);
#pragma unroll
        for (int t = 0; t < 4; ++t) { const int e = (eh * 4 + t) * 16 + (lane & 15); const float og = sigmoidf(bf2f(ogr[r][t]));
          OUT[row * 512 + h * 128 + e] = f2bf(hs[t][r] * rs * nwv[t] * og); } }
    }
  }
}

DI float softplusf(float x) { return fmaxf(x, 0.f) + log1pf(__expf(-fabsf(x))); }
struct SsdLds { bf16_t* Xt; bf16_t* Cm; bf16_t* Bm; bf16_t* Bmt; bf16_t* Sc; bf16_t* Hs; float* CB; float* sS; float* dtS; float* seS; float* ssS; };
DI SsdLds ssd_lds(unsigned char* lds) {
  SsdLds L; L.Xt = (bf16_t*)lds;
  L.Cm = L.Xt + 4 * 64 * LP;
  L.Bm = L.Cm + 64 * LP;
  L.Bmt = L.Bm + 64 * LP;
  L.Sc = L.Bmt + 64 * LP;
  L.Hs = L.Sc + 64 * LP;
  L.CB = (float*)(L.Hs + 64 * LP);
  L.sS = L.CB + 64 * 65;
  L.dtS = L.sS + 512;
  L.seS = L.dtS + 512;
  L.ssS = L.seS + 8;
  return L;
}
DI void ssd_load(const Params& p, int l, int g, int tc, const SsdLds& L) {
  const int tid = tidx(), wave = tid >> 6, lane = tid & 63;
  const bf16_t* PD = (const bf16_t*)(p.ws + WS_BIG + BG_PD);
  const float* cw = p.in[17] + (size_t)l * 5 * 768; const float* cb = p.in[18] + l * 768;
  const int row0 = chunk_row0(tc); int lo, hi; stream_bounds(row0, lo, hi);
  float xr[3][20], wr[3][5], br[3]; int cc[3], rr0[3];
#pragma unroll
  for (int k = 0; k < 3; ++k) { const int u = tid + 512 * k, c = u % 384, r0 = (u / 384) * 16; cc[k] = c; rr0[k] = r0;
    const int gc = c < 256 ? g * 256 + c : (c < 320 ? 512 + g * 64 + (c - 256) : 640 + g * 64 + (c - 320));
#pragma unroll
    for (int t = 0; t < 5; ++t) wr[k][t] = cw[t * 768 + gc];
    br[k] = cb[gc];
#pragma unroll
    for (int i = 0; i < 20; ++i) { const int row = row0 + r0 - 2 + i; const int rc = row < lo ? lo : (row >= hi ? hi - 1 : row);
      const float v = bf2f(PD[(size_t)rc * NB_D + 512 + gc]); xr[k][i] = (row >= lo && row < hi) ? v : 0.f; } }
#pragma unroll
  for (int k = 0; k < 3; ++k) { const int c = cc[k], r0 = rr0[k];
#pragma unroll
    for (int i = 0; i < 16; ++i) { const float y = br[k] + wr[k][0] * xr[k][i] + wr[k][1] * xr[k][i + 1] + wr[k][2] * xr[k][i + 2] + wr[k][3] * xr[k][i + 3] + wr[k][4] * xr[k][i + 4];
      const bf16_t vb = f2bf(siluf(y)); const int r = r0 + i;
      if (c < 256) L.Xt[c * LP + r] = vb;
      else if (c < 320) { L.Bm[r * LP + (c - 256)] = vb; L.Bmt[(c - 256) * LP + r] = vb; }
      else L.Cm[r * LP + (c - 320)] = vb; } }
  { const int hh = wave >> 1, dir = wave & 1, h = g * 4 + hh;
    const float dtb = p.in[19][l * 16 + dir * 8 + h], am = -__expf(p.in[20][l * 16 + dir * 8 + h]);
    const float dt = softplusf(bf2f(PD[(size_t)(row0 + lane) * NB_D + 1280 + dir * 8 + h]) + dtb); const float a = dt * am;
    const float s = wave_scan_sum(a, lane, dir); const float se = wave_sum(a);
    L.sS[wave * 64 + lane] = s; L.dtS[wave * 64 + lane] = dt; if (lane == 0) L.seS[wave] = se; }
}
DI bf16x8 pack8(const float (&v)[8]) { u32x4 w; w.x = cvtpk(v[0], v[1]); w.y = cvtpk(v[2], v[3]); w.z = cvtpk(v[4], v[5]); w.w = cvtpk(v[6], v[7]); return __builtin_bit_cast(bf16x8, w); }
DI void unpack8(const bf16x8 b, float (&v)[8]) { const u32x4 w = __builtin_bit_cast(u32x4, b); v[0] = bflo(w.x); v[1] = bfhi(w.x); v[2] = bflo(w.y); v[3] = bfhi(w.y); v[4] = bflo(w.z); v[5] = bfhi(w.z); v[6] = bflo(w.w); v[7] = bfhi(w.w); }
DI void phase_ssd_s1(const Params& p, int l, unsigned char* lds) {
  const int tid = tidx(), wave = tid >> 6, lane = tid & 63, l15 = lane & 15, lq = lane >> 4;
  const SsdLds L = ssd_lds(lds);
  bf16_t* UH = (bf16_t*)(p.ws + WS_BIG + BG_UH); float* DE = (float*)(p.ws + WS_BIG + BG_DE);
  for (int item = blockIdx.x; item < 2 * NCH; item += gridDim.x) {
    const int g = item & 1, tc = item >> 1;
    __syncthreads();
    ssd_load(p, l, g, tc, L);
    __syncthreads();
    const int hd = wave, hh = hd >> 1, dir = hd & 1, h = g * 4 + hh, ch = h * 2 + dir, s = scan_idx(tc, dir);
    const float se = L.seS[hd];
    if (lane == 0) DE[ch * NCH + s] = __expf(se);
    float cf[2][8];
#pragma unroll
    for (int ks = 0; ks < 2; ++ks)
#pragma unroll
      for (int e = 0; e < 8; ++e) { const int i = ks * 32 + 8 * lq + e; cf[ks][e] = __expf(se - L.sS[hd * 64 + i]) * L.dtS[hd * 64 + i]; }
    bf16x8 bfr[4][2];
#pragma unroll
    for (int nt = 0; nt < 4; ++nt)
#pragma unroll
      for (int ks = 0; ks < 2; ++ks) { float v[8]; unpack8(*(const bf16x8*)(L.Bmt + (nt * 16 + l15) * LP + ks * 32 + 8 * lq), v);
#pragma unroll
        for (int e = 0; e < 8; ++e) v[e] *= cf[ks][e];
        bfr[nt][ks] = pack8(v); }
    bf16_t* urow = UH + ((size_t)ch * NCH + s) * 4096;
#pragma unroll
    for (int pt = 0; pt < 4; ++pt) { const bf16_t* ap = L.Xt + (hh * 64 + pt * 16 + l15) * LP + 8 * lq;
      const bf16x8 a0 = *(const bf16x8*)ap, a1 = *(const bf16x8*)(ap + 32);
#pragma unroll
      for (int nt = 0; nt < 4; ++nt) { f32x4 acc = {0.f, 0.f, 0.f, 0.f};
        acc = __builtin_amdgcn_mfma_f32_16x16x32_bf16(a0, bfr[nt][0], acc, 0, 0, 0);
        acc = __builtin_amdgcn_mfma_f32_16x16x32_bf16(a1, bfr[nt][1], acc, 0, 0, 0);
#pragma unroll
        for (int r = 0; r < 4; ++r) urow[(pt * 16 + lq * 4 + r) * 64 + nt * 16 + l15] = f2bf(acc[r]); } }
  }
}
DI void phase_ssd_s2(const Params& p) {
  const bf16_t* __restrict__ UH = (const bf16_t*)(p.ws + WS_BIG + BG_UH); bf16_t* __restrict__ SH = (bf16_t*)(p.ws + WS_BIG + BG_SH);
  const float* DE = (const float*)(p.ws + WS_BIG + BG_DE);
  const int npairs = 16 * 2048;
  for (int e = blockIdx.x * 512 + tidx(); e < npairs; e += gridDim.x * 512) {
    const int ch = e >> 11, off = (e & 2047) * 2; float c0 = 0.f, c1 = 0.f;
    for (int s0 = 0; s0 < NCH; s0 += 26) {
      unsigned u[26];
#pragma unroll
      for (int q = 0; q < 26; ++q) u[q] = *(const unsigned*)(UH + ((size_t)ch * NCH + s0 + q) * 4096 + off);
      float dev[26];
#pragma unroll
      for (int q = 0; q < 26; ++q) dev[q] = DE[ch * NCH + s0 + q];
#pragma unroll
      for (int q = 0; q < 26; ++q) { const int s = s0 + q;
        *(unsigned*)(SH + ((size_t)ch * NCH + s) * 4096 + off) = cvtpk(c0, c1);
        const float dec = dev[q]; c0 = dec * c0 + bflo(u[q]); c1 = dec * c1 + bfhi(u[q]); }
    }
  }
}
DI void phase_ssd_s3(const Params& p, int l, unsigned char* lds, int ntc) {
  const int tid = tidx(), wave = tid >> 6, lane = tid & 63, l15 = lane & 15, lq = lane >> 4;
  const SsdLds L = ssd_lds(lds);
  const bf16_t* PD = (const bf16_t*)(p.ws + WS_BIG + BG_PD);
  const bf16_t* SH = (const bf16_t*)(p.ws + WS_BIG + BG_SH);
  bf16_t* OUT = (bf16_t*)(p.ws + WS_BR) + (size_t)3 * T * 512;
  const float* dsk = p.in[21] + l * 8; const float* nw = p.in[22] + l * 512;
  float* ssq4 = L.CB + 64 * 65;
  ssq4 = L.ssS + 128;
  const int hh = wave >> 1, jh = wave & 1;
  for (int item = blockIdx.x; item < 2 * ntc; item += gridDim.x) {
    const int g = item & 1, tc = item >> 1, row0 = chunk_row0(tc), h = g * 4 + hh;
    __syncthreads();
    ssd_load(p, l, g, tc, L);
    __syncthreads();
#pragma unroll
    for (int tt = 0; tt < 2; ++tt) { const int t = wave * 2 + tt, jt = t >> 2, it = t & 3; f32x4 acc = {0.f, 0.f, 0.f, 0.f};
      acc = mm16(L.Cm + jt * 16 * LP, LP, L.Bm + it * 16 * LP, LP, 64, acc, lane);
#pragma unroll
      for (int r = 0; r < 4; ++r) L.CB[(jt * 16 + lq * 4 + r) * 65 + it * 16 + l15] = acc[r]; }
    __syncthreads();
    const float dk = dsk[h];
#pragma unroll 1
    for (int jl = 0; jl < 2; ++jl) { const int jt = jh * 2 + jl, j = jt * 16 + l15;
      f32x4 ys[4];
#pragma unroll
      for (int b = 0; b < 4; ++b) ys[b] = (f32x4){0.f, 0.f, 0.f, 0.f};
#pragma unroll 1
      for (int dir = 0; dir < 2; ++dir) { const int hd = hh * 2 + dir, ch = h * 2 + dir, s = scan_idx(tc, dir);
        const bf16_t* srow = SH + ((size_t)ch * NCH + s) * 4096;
        bf16x8 bh[4][2];
#pragma unroll
        for (int pt = 0; pt < 4; ++pt) { bh[pt][0] = *(const bf16x8*)(srow + (pt * 16 + l15) * 64 + 8 * lq); bh[pt][1] = *(const bf16x8*)(srow + (pt * 16 + l15) * 64 + 32 + 8 * lq); }
        const float sj = L.sS[hd * 64 + j];
        bf16x8 asc[2], acm[2];
#pragma unroll
        for (int ks = 0; ks < 2; ++ks) { float v[8];
#pragma unroll
          for (int e = 0; e < 8; ++e) { const int ii = ks * 32 + 8 * lq + e; const bool ok = dir ? (ii >= j) : (ii <= j);
            v[e] = ok ? __expf(sj - L.sS[hd * 64 + ii]) * L.CB[j * 65 + ii] * L.dtS[hd * 64 + ii] : 0.f; }
          asc[ks] = pack8(v); acm[ks] = *(const bf16x8*)(L.Cm + j * LP + ks * 32 + 8 * lq); }
        float ej[4];
#pragma unroll
        for (int r = 0; r < 4; ++r) ej[r] = __expf(L.sS[hd * 64 + jt * 16 + lq * 4 + r]);
#pragma unroll
        for (int pt = 0; pt < 4; ++pt) { const bf16_t* xp = L.Xt + (hh * 64 + pt * 16 + l15) * LP + 8 * lq;
          f32x4 a1 = {0.f, 0.f, 0.f, 0.f}, a2 = {0.f, 0.f, 0.f, 0.f};
          a1 = __builtin_amdgcn_mfma_f32_16x16x32_bf16(asc[0], *(const bf16x8*)xp, a1, 0, 0, 0);
          a1 = __builtin_amdgcn_mfma_f32_16x16x32_bf16(asc[1], *(const bf16x8*)(xp + 32), a1, 0, 0, 0);
          a2 = __builtin_amdgcn_mfma_f32_16x16x32_bf16(acm[0], bh[pt][0], a2, 0, 0, 0);
          a2 = __builtin_amdgcn_mfma_f32_16x16x32_bf16(acm[1], bh[pt][1], a2, 0, 0, 0);
#pragma unroll
          for (int r = 0; r < 4; ++r) ys[pt][r] += a1[r] + ej[r] * a2[r]; }
      }
      bf16_t zr[4][4];
#pragma unroll
      for (int r = 0; r < 4; ++r)
#pragma unroll
        for (int pt = 0; pt < 4; ++pt) zr[r][pt] = PD[(size_t)(row0 + jt * 16 + lq * 4 + r) * NB_D + h * 64 + pt * 16 + l15];
#pragma unroll
      for (int r = 0; r < 4; ++r) { const int jr = jt * 16 + lq * 4 + r; float sq = 0.f;
#pragma unroll
        for (int pt = 0; pt < 4; ++pt) { const int pp = pt * 16 + l15;
          const float z = bf2f(zr[r][pt]);
          const float v = (ys[pt][r] + dk * bf2f(L.Xt[(hh * 64 + pp) * LP + jr])) * siluf(z);
          const bf16_t vb = f2bf(v); const float vr = bf2f(vb); sq += vr * vr;
          OUT[(size_t)(row0 + jr) * 512 + g * 256 + hh * 64 + pp] = vb; }
        sq += __shfl_xor(sq, 1); sq += __shfl_xor(sq, 2); sq += __shfl_xor(sq, 4); sq += __shfl_xor(sq, 8);
        if (l15 == 0) ssq4[jr * 4 + hh] = sq; }
    }
    __syncthreads();
#pragma unroll 1
    for (int jl = 0; jl < 2; ++jl) {
      float nwv[4];
#pragma unroll
      for (int pt = 0; pt < 4; ++pt) nwv[pt] = nw[g * 256 + hh * 64 + pt * 16 + l15];
      bf16_t ov[4][4];
#pragma unroll
      for (int r = 0; r < 4; ++r)
#pragma unroll
        for (int pt = 0; pt < 4; ++pt) ov[r][pt] = OUT[(size_t)(row0 + (jh * 2 + jl) * 16 + lq * 4 + r) * 512 + g * 256 + hh * 64 + pt * 16 + l15];
#pragma unroll
      for (int r = 0; r < 4; ++r) { const int jr = (jh * 2 + jl) * 16 + lq * 4 + r;
        const float tot = (ssq4[jr * 4 + 0] + ssq4[jr * 4 + 1]) + (ssq4[jr * 4 + 2] + ssq4[jr * 4 + 3]);
        const float rs = 1.f / sqrtf(tot * (1.f / 256.f) + EPS);
#pragma unroll
        for (int pt = 0; pt < 4; ++pt) { const int c = g * 256 + hh * 64 + pt * 16 + l15;
          OUT[(size_t)(row0 + jr) * 512 + c] = f2bf(bf2f(ov[r][pt]) * rs * nwv[pt]); } }
    }
  }
}

extern __shared__ __attribute__((aligned(16))) unsigned char dyn_lds[];

#define XB_TMO      128
#define XB_XCNT(j)  (256  + 64 * (j))
#define XB_XSUB(j)  (1280 + 64 * (j))
#define XB_XGEN(j)  (2304 + 64 * (j))
#define XB_TOP      3328
#define XB_TOPGEN   3392
#define XCD_BAR_WORDS 3456
#define XB_SPIN_CAP (1u << 18)
DI unsigned xb_ld(unsigned* p)              { return __hip_atomic_load(p, __ATOMIC_RELAXED, __HIP_MEMORY_SCOPE_AGENT); }
DI unsigned xb_add(unsigned* p, unsigned v) { return __hip_atomic_fetch_add(p, v, __ATOMIC_RELAXED, __HIP_MEMORY_SCOPE_AGENT); }
DI unsigned xb_xcc_id() { return (unsigned)__builtin_amdgcn_s_getreg((3 << 11) | 20) & 0xFu; }
#define XB_SPIN(cond, bar) do { unsigned _sp = 0; while (cond) { __builtin_amdgcn_s_sleep(1); \
    if ((++_sp & 255u) == 0u) { if (xb_ld(&(bar)[XB_TMO])) break; if (_sp > XB_SPIN_CAP) { atomicAdd(&(bar)[XB_TMO], 1u); break; } } } } while (0)
DI void xcd_barrier_complete(unsigned* bar, unsigned x, unsigned& nloc, unsigned& nx) {
  const unsigned G = gridDim.x;
  unsigned sum, cnt, mine, sp = 0u;
  for (;;) {
    sum = 0u; cnt = 0u; mine = 0u;
#pragma unroll
    for (unsigned j = 0; j < 16; ++j) { const unsigned c = xb_ld(&bar[XB_XCNT(j)]); sum += c; cnt += (c > 0u) ? 1u : 0u; mine = (j == x) ? c : mine; }
    if (sum == G) break;
    __builtin_amdgcn_s_sleep(1);
    if ((++sp & 255u) == 0u) { if (xb_ld(&bar[XB_TMO])) break; if (sp > XB_SPIN_CAP) { atomicAdd(&bar[XB_TMO], 1u); break; } }
  }
  nloc = mine > 0u ? mine : 1u; nx = cnt > 0u ? cnt : 1u;
}
DI void xcd_barrier(unsigned* bar, volatile LAS unsigned* st) {
  asm volatile("s_waitcnt vmcnt(0)" ::: "memory");
  __syncthreads();
  if (tidx() == 0) {
    const unsigned x = xb_xcc_id();
    __builtin_amdgcn_s_waitcnt(0);
    unsigned nloc = st[0], nx = st[1];
    if (nloc == 0u) { xcd_barrier_complete(bar, x, nloc, nx); st[0] = nloc; st[1] = nx; }
    const unsigned old = xb_add(&bar[XB_XSUB(x)], 1u);
    const unsigned gen = old / nloc;
    if (old + 1u == (gen + 1u) * nloc) {
      __builtin_amdgcn_fence(__ATOMIC_RELEASE, "agent");
      asm volatile("s_waitcnt vmcnt(0)" ::: "memory");
      const unsigned og = xb_add(&bar[XB_TOP], 1u);
      const unsigned tg = og / nx;
      if (og + 1u == (tg + 1u) * nx) xb_add(&bar[XB_TOPGEN], 1u);
      else XB_SPIN(xb_ld(&bar[XB_TOPGEN]) == tg, bar);
      __builtin_amdgcn_fence(__ATOMIC_ACQUIRE, "agent");
      xb_add(&bar[XB_XGEN(x)], 1u);
      asm volatile("s_waitcnt vmcnt(0)" ::: "memory");
    } else {
      XB_SPIN(xb_ld(&bar[XB_XGEN(x)]) == gen, bar);
      __builtin_amdgcn_fence(__ATOMIC_ACQUIRE, "agent");
      asm volatile("s_waitcnt vmcnt(0)" ::: "memory");
    }
  }
  __syncthreads();
}

#ifndef REP_ATTN
#define REP_ATTN 1
#endif
#ifndef REP_SCAN
#define REP_SCAN 1
#endif
#ifndef DBG_STOP
#define DBG_STOP 0
#endif
DI void dbg_dump_br(const Params& p, int mode) {
  const bf16_t* BR = (const bf16_t*)(p.ws + WS_BR);
  for (size_t i = (size_t)blockIdx.x * 512 + tidx(); i < (size_t)TL * 1024; i += (size_t)gridDim.x * 512) {
    const size_t row = i >> 10; const int c = (int)(i & 1023), cc = c & 511, hf = c >> 9;
    float v = 0.f;
    if (mode == 0) v = bf2f(BR[((size_t)(hf * 2) * T + row) * 512 + cc]) + bf2f(BR[((size_t)(hf * 2 + 1) * T + row) * 512 + cc]);
    else if (mode == 1) v = bf2f(BR[((size_t)(hf ? 3 : 1) * T + row) * 512 + cc]);
    else if (mode == 2) v = bf2f(BR[((size_t)(hf ? 2 : 0) * T + row) * 512 + cc]);
    p.out[i] = v;
  }
}

DI void dbg_dump_raw(const Params& p, size_t byte_off, size_t cnt = (size_t)TL * 1024) {
  const bf16_t* src = (const bf16_t*)(p.ws + WS_BIG + byte_off);
  for (size_t i = (size_t)blockIdx.x * 512 + tidx(); i < (size_t)TL * 1024; i += (size_t)gridDim.x * 512) p.out[i] = i < cnt ? bf2f(src[i]) : 0.f;
}
typedef const __attribute__((address_space(4))) Params* KP;
DI const Params* launder(KP kp) { asm volatile("" : "+s"(kp)); return (const Params*)kp; }
#define PL (*launder(kp))
DI void gsync_(KP kp) { xcd_barrier((unsigned*)(PL.ws + WS_BAR), (volatile LAS unsigned*)((LAS unsigned char*)dyn_lds + LDS_PHASE)); }
#define gsync(g) gsync_(kp)
template <int l>
DI bool layer_fwd(KP kp, cg::grid_group& grid) {
  unsigned char* lds = dyn_lds; LAS unsigned char* ldsl = (LAS unsigned char*)dyn_lds;
  const int c = blockIdx.x, G = gridDim.x;
  unsigned char* ws = PL.ws;
  const float* MOD = (const float*)(ws + WS_MOD);
  bf16_t* H = (bf16_t*)(ws + WS_H); float* XC = (float*)(ws + WS_XC);
  const bf16_t* WA = (const bf16_t*)(ws + WS_WA); unsigned char* WB = ws + WS_WB; unsigned char* BIG = ws + WS_BIG;
    const float* mod_l = MOD + (size_t)(l * 2 + 0) * 6144; const float* mod_c = MOD + (size_t)(l * 2 + 1) * 6144;
    const float* xin_l = (l == 0) ? PL.in[0] : PL.out; const float* xin_c = (l == 0) ? PL.in[2] : XC;
    const int Mm = (l == 0) ? T : TL;
    const int ntc = (l == 0) ? NCH : 256;
    { pg8::Sched S{(const char*)H, (size_t)D * 2, (const char*)WA + WA_B, 1024, T / 256, NB_B / 256, G, c};
      pg8::EpiStore E{(bf16_t*)(BIG + BG_PB), NB_B, NB_B}; pg8::gemm_phase(ldsl, S, E); }
    gsync(grid);
    if (DBG_STOP == 7 && l == 0) { dbg_dump_raw(PL, BG_PB); return true; }
    if (DBG_STOP == 8 && l == 0) { dbg_dump_raw(PL, BG_PB + (size_t)TL * 1024 * 2, (size_t)T * NB_B - (size_t)TL * 1024); return true; }
    for (int rep = 0; rep < REP_SCAN; ++rep) {
    phase_ml_s1(PL, l, lds);
    gsync(grid);
    if (DBG_STOP == 4 && l == 0) { dbg_dump_raw(PL, BG_UC); return true; }
    phase_ml_s2(PL);
    convert_layer_rest(PL, l, lds, (8 * (MLROW / 2) + 511) / 512);
    gsync(grid);
    if (DBG_STOP == 5 && l == 0) { dbg_dump_raw(PL, BG_SC); return true; }
    phase_ml_s3(PL, l, lds, ntc);
    gsync(grid);
    }
    if (DBG_STOP == 6 && l == 0) { dbg_dump_br(PL, 1); return true; }
    { pg8::Sched S{(const char*)H, (size_t)D * 2, (const char*)WA + WA_D, 1024, T / 256, NB_D / 256, G, c};
      pg8::EpiStore E{(bf16_t*)(BIG + BG_PD), NB_D, NB_D}; pg8::gemm_phase(ldsl, S, E); }
    gsync(grid);
    for (int rep = 0; rep < REP_SCAN; ++rep) {
    phase_ssd_s1(PL, l, lds);
    gsync(grid);
    phase_ssd_s2(PL);
    gsync(grid);
    phase_ssd_s3(PL, l, lds, ntc);
    gsync(grid);
    }
    { pg8::Sched S{(const char*)H, (size_t)D * 2, (const char*)WA + WA_AC, 1024, T / 256, NB_AC / 256, G, c};
      pg8::EpiStore E{(bf16_t*)(BIG + BG_PAC), NB_AC, NB_AC}; pg8::gemm_phase(ldsl, S, E); }
    gsync(grid);
    phase_attn_prep(PL, l);
    for (int k = 0; k < 4; ++k) transpose_job(PL.in[23] + ((size_t)l * 4 + k) * 1024 * 1024, 1024, 1024, 1024, 1024, (bf16_t*)(ws + WS_WA) + (size_t)k * 1024 * 1024, lds);
    gsync(grid);
    { pg8::Sched S{(const char*)(BIG + BG_PAC) + 1536 * 2, (size_t)NB_AC * 2, (const char*)WB + WB_UQ, 384, T / 256, 2, G, c};
      pg8::EpiStore E{(bf16_t*)(BIG + BG_QUP), 384, 384}; pg8::gemm_phase(ldsl, S, E); }
    { pg8::Sched S{(const char*)(BIG + BG_PAC) + 1920 * 2, (size_t)NB_AC * 2, (const char*)WB + WB_UKV, 256, T / 256, 3, G, c};
      pg8::EpiStore E{(bf16_t*)(BIG + BG_KVUP), 768, 768}; pg8::gemm_phase(ldsl, S, E); }
    if (l == 0 && c >= G - 4) attn_item_diff(PL, l, TL, c - (G - 4), TL, TC, (char*)lds);
    gsync(grid);
    for (int rep = 0; rep < REP_ATTN; ++rep) { phase_attention(PL, l, (char*)lds);
    gsync(grid); }
    if (DBG_STOP == 1 && l == 0) { dbg_dump_br(PL, 0); return true; }
    if (DBG_STOP == 2 && l == 0) { dbg_dump_br(PL, 1); return true; }
    if (DBG_STOP == 3 && l == 0) { dbg_dump_br(PL, 2); return true; }
    { pg8::Sched S{(const char*)H, (size_t)D * 2, (const char*)WA, 1024, Mm / 256, 16, G, c};
      pg8::EpiAct<0> E{(bf16_t*)BIG, 4096, PL.in[24] + (size_t)l * 4096}; pg8::gemm_phase(ldsl, S, E); }
    gsync(grid);
    { pg8::HSched S{(const char*)(ws + WS_BR), (size_t)512 * 2, (size_t)T * 512 * 2, (const char*)WB + WB_BR, (size_t)1024 * 512 * 2, 512, Mm / 256, 4, G, c};
      pg8::EpiHorner E{(const bf16_t*)BIG, H}; pg8::gemm_phase(ldsl, S, E); }
    transpose_job(PL.in[29] + (size_t)l * 1024 * 4096, 4096, 1024, 4096, 4096, (bf16_t*)(ws + WS_WA), lds);
    gsync(grid);
    { pg8::Sched S{(const char*)H, (size_t)D * 2, (const char*)WB + WB_WO, 1024, TL / 256, 4, G, c};
      pg8::EpiResid E{xin_l, xin_c, PL.out, XC, mod_l + 2048, mod_c + 2048, nullptr}; pg8::gemm_phase(ldsl, S, E); }
    if (l == 0) {
      pg8::KSched S{(const char*)(H + (size_t)TL * D), (size_t)D * 2, (const char*)WB + WB_WO, 1024, 256, 4, 4, G, (c + G / 2) % G};
      pg8::EpiAtomic E{(float*)(ws + WS_ACC)}; pg8::gemm_phase(ldsl, S, E); }
    gsync(grid);
    if (l == 0) phase_ln_affine_mod(PL.out, XC, PL.in[27] + l * 1024, PL.in[28] + l * 1024, mod_l, mod_c, 3072, 4096, H, Mm, PL.in[2], (const float*)(ws + WS_ACC), mod_c + 2048, nullptr);
    else phase_ln_affine_mod(PL.out, XC, PL.in[27] + l * 1024, PL.in[28] + l * 1024, mod_l, mod_c, 3072, 4096, H, Mm);
    transpose_job(PL.in[31] + (size_t)l * 4096 * 1024, 1024, 4096, 1024, 1024, (bf16_t*)WB, lds);
    gsync(grid);
    { pg8::Sched S{(const char*)H, (size_t)D * 2, (const char*)WA, 1024, Mm / 256, 16, G, c};
      pg8::EpiAct<1> E{(bf16_t*)BIG, 4096, PL.in[30] + (size_t)l * 4096}; pg8::gemm_phase(ldsl, S, E); }
    gsync(grid);
    { pg8::Sched S{(const char*)BIG, (size_t)4096 * 2, (const char*)WB, 4096, TL / 256, 4, G, c};
      pg8::EpiResid E{PL.out, XC, PL.out, XC, mod_l + 5120, mod_c + 5120, PL.in[32] + l * 1024}; pg8::gemm_phase(ldsl, S, E); }
    if (l == 0) {
      pg8::KSched S{(const char*)BIG + (size_t)TL * 4096 * 2, (size_t)4096 * 2, (const char*)WB, 4096, 1024, 4, 4, G, (c + G / 2) % G};
      pg8::EpiAtomic E{(float*)(ws + WS_ACC) + (size_t)TC * D}; pg8::gemm_phase(ldsl, S, E); }
    gsync(grid);
    if (l == 0) {
      const float* m1l = MOD + (size_t)(2 + 0) * 6144; const float* m1c = MOD + (size_t)(2 + 1) * 6144;
      phase_ln_affine_mod(PL.out, XC, PL.in[33], PL.in[34], m1l, m1c, 0, 1024, H, T, XC, (const float*)(ws + WS_ACC) + (size_t)TC * D, mod_c + 5120, PL.in[32]);
      convert_layer_start(PL, 1, lds);
      gsync(grid);
    } else {
      phase_ln_affine_mod(PL.out, XC, PL.in[33] + 1024, PL.in[34] + 1024, mod_l, mod_c, 0, 1024, nullptr, TL);
    }
  return false;
}
__global__ void __launch_bounds__(512) fwd_megakernel(Params p_unused) {
  cg::grid_group grid = cg::this_grid();
  unsigned char* lds = dyn_lds;
  KP kp = (KP)__builtin_amdgcn_kernarg_segment_ptr();
  { volatile LAS unsigned* st = (volatile LAS unsigned*)((LAS unsigned char*)dyn_lds + LDS_PHASE);
    if (tidx() == 0) { st[0] = 0u; st[1] = 0u; (void)xb_add((unsigned*)(PL.ws + WS_BAR) + XB_XCNT(xb_xcc_id()), 1u); }
    __syncthreads();
    if (PL.out == nullptr) grid.sync(); }
  phase_setup(PL, lds);
  __syncthreads();
  convert_layer_start(PL, 0, lds);
  gsync(grid);
  { const Params& p = PL; const float* MOD = (const float*)(p.ws + WS_MOD);
    phase_ln_mod(p.in[0], p.in[2], MOD + 0 * 6144, MOD + 1 * 6144, 0, 1024, (bf16_t*)(p.ws + WS_H), T); }
  gsync(grid);
  if (layer_fwd<0>(kp, grid)) return;
  layer_fwd<1>(kp, grid);
}

extern "C" void kernel_launch(void* const* d_in, const int* in_sizes, int n_in, void* d_out, int out_size, void* d_ws, size_t ws_size, hipStream_t stream) {
  static int grid_blocks = 0;
  if (grid_blocks == 0) {
    if (n_in != 35 || out_size != TL * D || ws_size < WS_END) { fprintf(stderr, "kernel_launch: unexpected shapes: n_in %d out %d ws %zu (need %zu)\n", n_in, out_size, ws_size, (size_t)WS_END); grid_blocks = -1; return; }
    int dev = 0, cus = 0, per_cu = 0;
    (void)hipGetDevice(&dev);
    (void)hipDeviceGetAttribute(&cus, hipDeviceAttributeMultiprocessorCount, dev);
    (void)hipFuncSetAttribute((const void*)fwd_megakernel, hipFuncAttributeMaxDynamicSharedMemorySize, LDS_BYTES);
    (void)hipOccupancyMaxActiveBlocksPerMultiprocessor(&per_cu, (const void*)fwd_megakernel, 512, LDS_BYTES);
    if (per_cu < 1) per_cu = 1;
    grid_blocks = cus * 1;
    fprintf(stderr, "kernel_launch: grid %d (cus %d, occupancy %d), ws %zu need %zu\n", grid_blocks, cus, per_cu, ws_size, (size_t)WS_END);
  }
  if (grid_blocks < 0) return;
  Params p{};
  for (int i = 0; i < 35; ++i) p.in[i] = (const float*)d_in[i];
  p.out = (float*)d_out; p.ws = (unsigned char*)d_ws;
  (void)hipMemsetAsync((unsigned char*)d_ws + WS_BAR, 0, XCD_BAR_WORDS * 4, stream);
  void* args[] = {&p};
  hipError_t e = hipLaunchCooperativeKernel((void*)fwd_megakernel, dim3(grid_blocks), dim3(512), args, LDS_BYTES, stream);
  if (e != hipSuccess) fprintf(stderr, "cooperative launch failed: %s (grid %d)\n", hipGetErrorString(e), grid_blocks);
}
```
